# Optimizing an MI355X kernel written in HIP

```python
import math
import jax
import jax.numpy as jnp
from jax import lax
import numpy as np

D_MODEL = 1024
BATCH = 2
SEQ = 8192
DEPTH = 2

CTX_LEN = 256
GRID_W = 64
BR_W = D_MODEL // 2
N_BRANCH = 3
EPS = 1e-6
DA_DH = 64
DA_DV = 2 * DA_DH
DA_HEADS = BR_W // DA_DV
ROPE_BASE = 10000.0
Q_BLOCK = 128
ML_DH = 128
ML_HEADS = BR_W // ML_DH
ML_CHUNK = 64
ML_CONV = 3
NA_DH = 64
NA_HEADS = BR_W // NA_DH
NA_KH_MAX = 8
NA_KW = 16
NA_QB = 16
NA_KBW = NA_QB + NA_KW
PROJ_SIZES = (BR_W,) * 4 + (BR_W,) * 5 + (4 * ML_HEADS,) + (BR_W,) * 4 + (N_BRANCH * D_MODEL,)
D_IN = sum(PROJ_SIZES)

kernel_name = 'hybrid_diffattn_mlstm_natten_prefix_block'


def rms_norm(x, g):
    xf = x.astype(jnp.float32)
    y = xf * lax.rsqrt(jnp.mean(xf * xf, axis=-1, keepdims=True) + EPS)
    return (y * g).astype(x.dtype)


def split_proj(p):
    idx = [int(i) for i in np.cumsum(PROJ_SIZES)[:-1]]
    return jnp.split(p, idx, axis=-1)


def axial_rope_tables(n_tok, dh):
    t = jnp.arange(n_tok, dtype=jnp.int32)
    row = (t // GRID_W).astype(jnp.float32)
    col = (t % GRID_W).astype(jnp.float32)
    inv = ROPE_BASE ** (-jnp.arange(0, dh // 2, 2, dtype=jnp.float32) / (dh // 2))
    ang = jnp.concatenate([row[:, None] * inv, col[:, None] * inv], axis=-1)
    return jnp.cos(ang), jnp.sin(ang)


def apply_rope(x, cos, sin):
    xp = x.reshape(x.shape[:-1] + (x.shape[-1] // 2, 2))
    x1, x2 = xp[..., 0], xp[..., 1]
    shp = (1, cos.shape[0]) + (1,) * (x.ndim - 3) + (cos.shape[1],)
    cs = cos.reshape(shp).astype(x.dtype)
    sn = sin.reshape(shp).astype(x.dtype)
    return jnp.stack([x1 * cs - x2 * sn, x1 * sn + x2 * cs], axis=-1).reshape(x.shape)


def softmax_attn(q, k, v):
    s = jnp.einsum('bqhd,bkhd->bhqk', q, k).astype(jnp.float32) * (q.shape[-1] ** -0.5)
    p = jax.nn.softmax(s, axis=-1).astype(v.dtype)
    return jnp.einsum('bhqk,bkhd->bqhd', p, v)


def diff_attn_dense(q, k, v, lam):
    s = jnp.einsum('bqhcd,bkhcd->bhcqk', q, k).astype(jnp.float32) * (q.shape[-1] ** -0.5)
    p = jax.nn.softmax(s, axis=-1)
    a = (p[:, :, 0] - lam * p[:, :, 1]).astype(v.dtype)
    return jnp.einsum('bhqk,bkhv->bqhv', a, v)


def diff_attn_blocks(q, k, v, lam):
    B, S = q.shape[:2]
    nb = S // Q_BLOCK
    qb = jnp.moveaxis(q.reshape((B, nb, Q_BLOCK) + q.shape[2:]), 1, 0)
    o = lax.map(lambda qq: diff_attn_dense(qq, k, v, lam), qb)
    return jnp.moveaxis(o, 0, 1).reshape((B, S) + o.shape[3:])


def diff_head_norm(o, g, lam_init):
    y = rms_norm(o, g) * (1.0 - lam_init)
    return y.reshape(o.shape[:2] + (-1,))


def dwconv_centred(x, w, b):
    K = w.shape[0]
    y = lax.conv_general_dilated(x, w[:, None, :].astype(x.dtype), window_strides=(1,),
                                 padding=[((K - 1) // 2, K // 2)],
                                 dimension_numbers=('NWC', 'WIO', 'NWC'),
                                 feature_group_count=x.shape[-1])
    return y + b


def mlstm_inputs(q, k, v, g, conv_w, conv_b, gate_b):
    B, T, _ = q.shape
    qk = jax.nn.silu(dwconv_centred(jnp.concatenate([q, k], axis=-1), conv_w, conv_b))
    qq, kk = jnp.split(qk, 2, axis=-1)
    shp = (B, T, ML_HEADS, ML_DH)
    gates = g.reshape(B, T, 2, 2, ML_HEADS).astype(jnp.float32) + gate_b.astype(jnp.float32)
    log_i = gates[:, :, :, 0]
    log_f = jax.nn.log_sigmoid(gates[:, :, :, 1])
    return qq.reshape(shp), kk.reshape(shp) * (ML_DH ** -0.5), v.reshape(shp), log_i, log_f


def mlstm_chunkwise(q, k, v, log_i, log_f, state, with_out):
    B, T, H, d = q.shape
    L = ML_CHUNK
    nc = T // L
    to_chunks = lambda a: jnp.moveaxis(a.reshape((B, nc, L) + a.shape[2:]), 1, 0)
    xs = (to_chunks(q), to_chunks(k), to_chunks(v), to_chunks(log_i), to_chunks(log_f))
    causal = jnp.tril(jnp.ones((L, L), dtype=bool))

    def step(carry, xc):
        C, n, m = carry
        qc, kc, vc, lic, lfc = xc
        qc = qc.astype(jnp.float32)
        kc = kc.astype(jnp.float32)
        vc = vc.astype(jnp.float32)
        b = jnp.moveaxis(jnp.cumsum(lfc.astype(jnp.float32), axis=1), 1, 2)
        li = jnp.moveaxis(lic.astype(jnp.float32), 1, 2)
        bL = b[..., -1]
        g_s = bL[..., None] - b + li
        m_new = jnp.maximum(bL + m, jnp.max(g_s, axis=-1))
        w_s = jnp.exp(g_s - m_new[..., None])
        decay = jnp.exp(bL + m - m_new)
        C_new = decay[..., None, None] * C + jnp.einsum('bhs,bshk,bshv->bhkv', w_s, kc, vc)
        n_new = decay[..., None] * n + jnp.einsum('bhs,bshk->bhk', w_s, kc)
        if with_out:
            dmat = jnp.where(causal, b[..., :, None] - b[..., None, :] + li[..., None, :], -jnp.inf)
            m_inter = b + m[..., None]
            m_t = jnp.maximum(m_inter, jnp.max(dmat, axis=-1))
            a_inter = jnp.exp(m_inter - m_t)
            qk = jnp.einsum('bthd,bshd->bhts', qc, kc) * jnp.exp(dmat - m_t[..., None])
            num = a_inter[..., None] * jnp.einsum('bthk,bhkv->bhtv', qc, C) + jnp.einsum('bhts,bshv->bhtv', qk, vc)
            den = a_inter * jnp.einsum('bthk,bhk->bht', qc, n) + jnp.sum(qk, axis=-1)
            h = num / jnp.maximum(jnp.abs(den), jnp.exp(-m_t))[..., None]
            h = jnp.moveaxis(h, 1, 2)
        else:
            h = None
        return (C_new, n_new, m_new), h

    final, hs = lax.scan(step, state, xs)
    if with_out:
        hs = jnp.moveaxis(hs, 0, 1).reshape(B, T, H, d).astype(q.dtype)
    return final, hs


def mlstm_bidirectional(lat, ctx, with_ctx_out):
    ql, kl, vl, lil, lfl = lat
    qc, kc, vc, lic, lfc = ctx
    B, _, H, d = ql.shape
    zero = (jnp.zeros((B, H, d, d), jnp.float32), jnp.zeros((B, H, d), jnp.float32), jnp.zeros((B, H), jnp.float32))
    flip = lambda a: jnp.flip(a, axis=1)
    st_f, hc_f = mlstm_chunkwise(qc, kc, vc, lic[:, :, 0], lfc[:, :, 0], zero, with_ctx_out)
    _, hl_f = mlstm_chunkwise(ql, kl, vl, lil[:, :, 0], lfl[:, :, 0], st_f, True)
    st_b, hc_b = mlstm_chunkwise(flip(qc), flip(kc), flip(vc), flip(lic[:, :, 1]), flip(lfc[:, :, 1]), zero, with_ctx_out)
    _, hl_b = mlstm_chunkwise(flip(ql), flip(kl), flip(vl), flip(lil[:, :, 1]), flip(lfl[:, :, 1]), st_b, True)
    h_lat = hl_f + flip(hl_b)
    h_ctx = hc_f + flip(hc_b) if with_ctx_out else None
    return h_lat, h_ctx


def mlstm_out(h, o_pre, z, g):
    hn = rms_norm(h, g).reshape(h.shape[:2] + (-1,))
    return jax.nn.sigmoid(o_pre) * hn * jax.nn.silu(z)


def neighbourhood_attn(q, k, v, kc, vc, rpb):
    B, S, H, d = q.shape
    rows = S // GRID_W
    kh = min(NA_KH_MAX, rows)
    ncb = GRID_W // NA_QB
    qcol = np.arange(GRID_W).reshape(ncb, NA_QB)
    kc0 = np.clip(np.arange(ncb) * NA_QB - NA_KW // 2, 0, GRID_W - NA_KBW)
    kcol = kc0[:, None] + np.arange(NA_KBW)[None, :]
    cs = np.clip(qcol - NA_KW // 2, 0, GRID_W - NA_KW)
    col_ok = (kcol[:, None, :] >= cs[:, :, None]) & (kcol[:, None, :] < cs[:, :, None] + NA_KW)
    col_idx = np.clip(kcol[:, None, :] - qcol[:, :, None] + NA_KW - 1, 0, 2 * NA_KW - 2)
    mask = jnp.asarray(col_ok[:, :, None, :])
    qb = q.reshape(B, rows, ncb, NA_QB, H, d)
    kb = k.reshape(B, rows, GRID_W, H, d)[:, :, kcol]
    vb = v.reshape(B, rows, GRID_W, H, d)[:, :, kcol]
    scale = d ** -0.5
    n_loc = kh * NA_KBW

    def row_block(r):
        rs = jnp.clip(r - kh // 2, 0, rows - kh)
        kr = lax.dynamic_slice_in_dim(kb, rs, kh, axis=1)
        vr = lax.dynamic_slice_in_dim(vb, rs, kh, axis=1)
        qr = lax.dynamic_index_in_dim(qb, r, axis=1, keepdims=False)
        row_idx = rs + jnp.arange(kh) - r + NA_KH_MAX - 1
        bias = rpb[:, row_idx[None, None, :, None], col_idx[:, :, None, :]]
        s_loc = jnp.einsum('bnqhd,binkhd->bhnqik', qr, kr).astype(jnp.float32) * scale + bias.astype(jnp.float32)
        s_loc = jnp.where(mask, s_loc, -jnp.inf)
        s_ctx = jnp.einsum('bnqhd,bjhd->bhnqj', qr, kc).astype(jnp.float32) * scale
        s_all = jnp.concatenate([s_loc.reshape(s_loc.shape[:4] + (n_loc,)), s_ctx], axis=-1)
        p = jax.nn.softmax(s_all, axis=-1).astype(v.dtype)
        p_loc = p[..., :n_loc].reshape(s_loc.shape)
        p_ctx = p[..., n_loc:]
        return jnp.einsum('bhnqik,binkhd->bnqhd', p_loc, vr) + jnp.einsum('bhnqj,bjhd->bnqhd', p_ctx, vc)

    o = lax.map(row_block, jnp.arange(rows))
    return jnp.moveaxis(o, 0, 1).reshape(B, S, H, d)


def merge_branches(ys, gm, w_br, w_out):
    y = jnp.stack(ys, axis=2)
    proj = jnp.einsum('btnw,nwd->btnd', y, w_br)
    g = jax.nn.sigmoid(gm.reshape(gm.shape[:2] + (N_BRANCH, -1)))
    return jnp.sum(g * proj, axis=2) @ w_out


def hybrid_layer(l, x, xc, sc, scc, cos, sin, w_mod, b_mod, norm_g, w_in, lam_q, lam_k, da_g,
                 conv_w, conv_b, gate_b, ml_g, rpb, w_br, w_out, update_ctx):
    B, S, _ = x.shape
    L = xc.shape[1]
    shift, scale, gate = jnp.split(sc @ w_mod + b_mod, 3, axis=-1)
    shift_c, scale_c, gate_c = jnp.split(scc @ w_mod + b_mod, 3, axis=-1)
    h = rms_norm(x, norm_g) * (1 + scale[:, None]) + shift[:, None]
    hc = rms_norm(xc, norm_g) * (1 + scale_c) + shift_c
    aq, ak, av, az, bq, bk, bv, bo, bz, bg, cq, ck, cv, cz, gm = split_proj(h @ w_in)
    aqc, akc, avc, azc, bqc, bkc, bvc, boc, bzc, bgc, cqc, ckc, cvc, czc, gmc = split_proj(hc @ w_in)

    lam_init = 0.8 - 0.6 * math.exp(-0.3 * l)
    lam = (jnp.exp(jnp.sum(lam_q[0] * lam_k[0])) - jnp.exp(jnp.sum(lam_q[1] * lam_k[1]))).astype(jnp.float32) + lam_init
    da_qk = lambda t: t.reshape(t.shape[:2] + (DA_HEADS, 2, DA_DH))
    da_v = lambda t: t.reshape(t.shape[:2] + (DA_HEADS, DA_DV))
    k_all = jnp.concatenate([apply_rope(da_qk(ak), cos, sin), da_qk(akc)], axis=1)
    v_all = jnp.concatenate([da_v(av), da_v(avc)], axis=1)
    o_a = diff_attn_blocks(apply_rope(da_qk(aq), cos, sin), k_all, v_all, lam)
    y_a = diff_head_norm(o_a, da_g, lam_init) * jax.nn.silu(az)

    lat_b = mlstm_inputs(bq, bk, bv, bg, conv_w, conv_b, gate_b)
    ctx_b = mlstm_inputs(bqc, bkc, bvc, bgc, conv_w, conv_b, gate_b)
    h_b, h_bc = mlstm_bidirectional(lat_b, ctx_b, update_ctx)
    y_b = mlstm_out(h_b, bo, bz, ml_g)

    na_h = lambda t: t.reshape(t.shape[:2] + (NA_HEADS, NA_DH))
    o_c = neighbourhood_attn(na_h(cq), na_h(ck), na_h(cv), na_h(ckc), na_h(cvc), rpb)
    y_c = o_c.reshape(B, S, BR_W) * jax.nn.silu(cz)

    x = x + gate[:, None] * merge_branches((y_a, y_b, y_c), gm, w_br, w_out)
    if update_ctx:
        o_ac = diff_attn_dense(da_qk(aqc), da_qk(akc), da_v(avc), lam)
        y_ac = diff_head_norm(o_ac, da_g, lam_init) * jax.nn.silu(azc)
        y_bc = mlstm_out(h_bc, boc, bzc, ml_g)
        y_cc = softmax_attn(na_h(cqc), na_h(ckc), na_h(cvc)).reshape(B, L, BR_W) * jax.nn.silu(czc)
        xc = xc + gate_c * merge_branches((y_ac, y_bc, y_cc), gmc, w_br, w_out)
    return x, xc


def setup_inputs(seed: int = 0) -> dict:
    key = jax.random.key(seed)
    ks = jax.random.split(key, 20)
    f32 = jnp.float32
    nrm = lambda k, shape, s: jax.random.normal(k, shape, f32) * s
    f_base = jnp.linspace(3.0, 6.0, ML_HEADS, dtype=f32)
    gate_base = jnp.stack([jnp.zeros((ML_HEADS,), f32), f_base])[None, None]
    return {
        'x': nrm(ks[0], (BATCH, SEQ, D_MODEL), 1.0),
        'c': nrm(ks[1], (BATCH, D_MODEL), 1.0),
        'ctx': nrm(ks[2], (BATCH, CTX_LEN, D_MODEL), 1.0),
        'c_ctx': nrm(ks[3], (D_MODEL,), 1.0),
        'w_mod': nrm(ks[4], (DEPTH, D_MODEL, 3 * D_MODEL), 0.5 * D_MODEL ** -0.5),
        'b_mod': nrm(ks[5], (DEPTH, 3 * D_MODEL), 0.02),
        'norm_g': 1.0 + nrm(ks[6], (DEPTH, D_MODEL), 0.02),
        'w_in': nrm(ks[7], (DEPTH, D_MODEL, D_IN), D_MODEL ** -0.5),
        'da_lam_q': nrm(ks[8], (DEPTH, 2, DA_DH), 0.1),
        'da_lam_k': nrm(ks[9], (DEPTH, 2, DA_DH), 0.1),
        'da_norm_g': 1.0 + nrm(ks[10], (DEPTH, DA_DV), 0.02),
        'ml_conv_w': nrm(ks[11], (DEPTH, ML_CONV, 2 * BR_W), ML_CONV ** -0.5),
        'ml_conv_b': nrm(ks[12], (DEPTH, 2 * BR_W), 0.02),
        'ml_gate_b': gate_base + nrm(ks[13], (DEPTH, 2, 2, ML_HEADS), 0.1),
        'ml_norm_g': 1.0 + nrm(ks[14], (DEPTH, ML_DH), 0.02),
        'na_rpb': nrm(ks[15], (DEPTH, NA_HEADS, 2 * NA_KH_MAX - 1, 2 * NA_KW - 1), 0.05),
        'w_br': nrm(ks[16], (DEPTH, N_BRANCH, BR_W, D_MODEL), BR_W ** -0.5),
        'w_out': nrm(ks[17], (DEPTH, D_MODEL, D_MODEL), D_MODEL ** -0.5),
        'final_g': 1.0 + nrm(ks[18], (D_MODEL,), 0.02),
    }


def reference(x, c, ctx, c_ctx, w_mod, b_mod, norm_g, w_in, da_lam_q, da_lam_k, da_norm_g,
              ml_conv_w, ml_conv_b, ml_gate_b, ml_norm_g, na_rpb, w_br, w_out, final_g):
    cos, sin = axial_rope_tables(x.shape[1], DA_DH)
    sc = jax.nn.silu(c)
    scc = jax.nn.silu(c_ctx)
    xc = ctx
    for l in range(DEPTH):
        x, xc = hybrid_layer(l, x, xc, sc, scc, cos, sin, w_mod[l], b_mod[l], norm_g[l], w_in[l],
                             da_lam_q[l], da_lam_k[l], da_norm_g[l], ml_conv_w[l], ml_conv_b[l],
                             ml_gate_b[l], ml_norm_g[l], na_rpb[l], w_br[l], w_out[l],
                             l < DEPTH - 1)
    return rms_norm(x, final_g)
```

```cpp
#include <hip/hip_runtime.h>
#include <hip/hip_cooperative_groups.h>
#include <cstdio>
namespace cg = cooperative_groups;

#ifndef MULTI_LAUNCH
#define MULTI_LAUNCH 0
#endif

typedef unsigned short u16;
typedef __attribute__((ext_vector_type(8))) short bf16x8;
typedef __attribute__((ext_vector_type(16))) float f32x16;
typedef __attribute__((ext_vector_type(4))) unsigned int v4u;
typedef __attribute__((ext_vector_type(2))) unsigned int v2u;
typedef __attribute__((ext_vector_type(4))) float v4f;

#define R_TOT 16896
#define NKEY 8448
#define NPAD 9856
#define NTHR 512
#define LDS_BYTES 147456
#define NPHASE 18

#define WS_WT_IN 0ull
#define WS_WT_BR 20185088ull
#define WS_WT_OUT 23330816ull
#define WS_H 25427968ull
#define WS_PIECE 60030976ull
#define PIECE_SZ 17301504ull
#define WS_XC 284950528ull
#define WS_G 287047680ull
#define WS_MOD 288129024ull
#define WS_ROPE 288202752ull
#define WS_RSTD 288219136ull
#define WS_DN 288286720ull
#define WS_NPREV 288827392ull
#define WS_BL 289368064ull
#define WS_GS 289372416ull
#define WS_SH 289384704ull
#define WS_BAR 289396992ull
#define WS_END 289412096ull

enum { P_QA = 0, P_KA, P_VTA, P_ZA, P_QB, P_KB, P_VTB, P_OB, P_ZB, P_QC, P_KC, P_VTC, P_ZC };

struct Params {
  const float *x, *c, *ctx, *c_ctx, *w_mod, *b_mod, *norm_g, *w_in, *lam_q, *lam_k, *da_g,
      *conv_w, *conv_b, *gate_b, *ml_g, *rpb, *w_br, *w_out, *final_g;
  float* out;
  unsigned char* ws;
  int ph_lo, ph_hi;
};

__device__ __forceinline__ int opaque_tid() { int t = threadIdx.x; asm volatile("" : "+v"(t)); return t; }
__device__ __forceinline__ u16 f2bf(float f) {
  unsigned u = __float_as_uint(f);
  u += 0x7fffu + ((u >> 16) & 1u);
  return (u16)(u >> 16);
}
__device__ __forceinline__ float bf2f(u16 h) { return __uint_as_float(((unsigned)h) << 16); }
typedef __attribute__((ext_vector_type(2))) __bf16 bf16x2_t;
typedef __attribute__((ext_vector_type(2))) float f32x2_t;
__device__ __forceinline__ unsigned pk2(float a, float b) { f32x2_t v = {a, b}; bf16x2_t r = __builtin_convertvector(v, bf16x2_t); return __builtin_bit_cast(unsigned, r); }
__device__ __forceinline__ float bflo(unsigned u) { return __uint_as_float(u << 16); }
__device__ __forceinline__ float bfhi(unsigned u) { return __uint_as_float(u & 0xffff0000u); }
__device__ __forceinline__ float silu_f(float x) { return x / (1.f + __expf(-x)); }
__device__ __forceinline__ float sigmoid_f(float x) { return 1.f / (1.f + __expf(-x)); }
__device__ __forceinline__ float ex2(float x) { return __builtin_amdgcn_exp2f(x); }
__device__ __forceinline__ float wave_sum(float v) {
#pragma unroll
  for (int o = 32; o > 0; o >>= 1) v += __shfl_xor(v, o, 64);
  return v;
}
__device__ __forceinline__ f32x16 mfma32(bf16x8 a, bf16x8 b, f32x16 c) {
  return __builtin_amdgcn_mfma_f32_32x32x16_bf16(a, b, c, 0, 0, 0);
}
__device__ __forceinline__ f32x16 zero16() {
  f32x16 z;
#pragma unroll
  for (int i = 0; i < 16; ++i) z[i] = 0.f;
  return z;
}
__device__ __forceinline__ int pslot(int i) { return (int)((0xCBA2918765430ull >> (4 * i)) & 15ull); }
__device__ __forceinline__ u16* piece(const Params& p, int i) { return (u16*)(p.ws + WS_PIECE + (size_t)pslot(i) * PIECE_SZ); }
__device__ __forceinline__ u16* slotp(const Params& p, int sl) { return (u16*)(p.ws + WS_PIECE + (size_t)sl * PIECE_SZ); }
__device__ __forceinline__ const float* xrow(const Params& p, int l, int grow) {
  if (grow < 16384) return (l == 0 ? p.x : (const float*)p.out) + (size_t)grow * 1024;
  return (l == 0 ? p.ctx : (const float*)(p.ws + WS_XC)) + (size_t)(grow - 16384) * 1024;
}
__device__ __forceinline__ int which_of(int grow) { return grow < 8192 ? 0 : (grow < 16384 ? 1 : 2); }
__device__ __forceinline__ int perm16(int s) { return (s & ~15) | (((s >> 2) & 1) << 3) | (((s >> 3) & 1) << 2) | (s & 3); }

__device__ __attribute__((always_inline)) void phase_s0(const Params& p) {
  const int tid = threadIdx.x;
  float* mod = (float*)(p.ws + WS_MOD);
  for (int it = blockIdx.x; it < 2 * 12 * 16; it += gridDim.x) {
    const int l = it / 192, rem = it % 192, nch = rem / 16, kch = rem % 16;
    const int kh = tid >> 8, n = nch * 256 + (tid & 255);
    const int k0 = kch * 64 + kh * 32;
    const float* W = p.w_mod + (size_t)l * 1024 * 3072;
    float a0 = 0.f, a1 = 0.f, a2 = 0.f;
#pragma unroll 8
    for (int k = k0; k < k0 + 32; ++k) {
      const float w = W[(size_t)k * 3072 + n];
      a0 += silu_f(p.c[k]) * w;
      a1 += silu_f(p.c[1024 + k]) * w;
      a2 += silu_f(p.c_ctx[k]) * w;
    }
    if (kch == 0 && kh == 0) {
      const float bb = p.b_mod[l * 3072 + n];
      a0 += bb; a1 += bb; a2 += bb;
    }
    atomicAdd(&mod[(l * 3 + 0) * 3072 + n], a0);
    atomicAdd(&mod[(l * 3 + 1) * 3072 + n], a1);
    atomicAdd(&mod[(l * 3 + 2) * 3072 + n], a2);
  }
  const int gi = blockIdx.x * NTHR + tid;
  if (gi < 2048) {
    const int v = gi >> 4, f = gi & 15;
    const float inv = (float)exp(-(double)f * (9.210340371976184 / 16.0));
    const float angf = (float)v * inv;
    double a = (double)angf;
    const double twopi = 6.283185307179586476925;
    a -= twopi * floor(a / twopi + 0.5);
    const double a2 = a * a;
    double ts = a, tc = 1.0, sn = a, cs = 1.0;
    for (int i = 1; i <= 14; ++i) {
      tc = -tc * a2 / (double)((2 * i - 1) * (2 * i));
      ts = -ts * a2 / (double)((2 * i) * (2 * i + 1));
      cs += tc; sn += ts;
    }
    float* rt = (float*)(p.ws + WS_ROPE);
    rt[gi * 2] = (float)cs;
    rt[gi * 2 + 1] = (float)sn;
  }
}

__device__ __attribute__((always_inline)) void conv_tile(const float* __restrict__ src, int ld, int k0, int col0, int nvalid, bool perm,
                          u16* __restrict__ dst, int ldd, int n0, unsigned char* smem) {
  u16* t = (u16*)smem;
  const int tid = opaque_tid();
#pragma unroll
  for (int i = 0; i < 2; ++i) {
    const int idx = tid + NTHR * i;
    const int kk = idx >> 4, c4 = idx & 15;
    v4f v = {0.f, 0.f, 0.f, 0.f};
    if (4 * c4 < nvalid) v = *(const v4f*)(src + (size_t)(k0 + kk) * ld + col0 + 4 * c4);
#pragma unroll
    for (int e = 0; e < 4; ++e) {
      const int j = 4 * c4 + e;
      const int jp = perm ? ((j & 1) ? 32 + (j >> 1) : (j >> 1)) : j;
      t[jp * 72 + kk] = f2bf(v[e]);
    }
  }
  __syncthreads();
  {
    const int n = tid >> 3, ch = tid & 7;
    const v4u v = *(const v4u*)(t + n * 72 + ch * 8);
    *(v4u*)(dst + (size_t)(n0 + n) * ldd + k0 + ch * 8) = v;
  }
  __syncthreads();
}

__device__ __attribute__((always_inline)) void phase_s1(const Params& p, int l, unsigned char* smem) {
  const int tid = threadIdx.x, lane = tid & 63, wave = tid >> 6;
  const float* mod = (const float*)(p.ws + WS_MOD) + (size_t)l * 3 * 3072;
  const float* g = p.norm_g + l * 1024;
  u16* H = (u16*)(p.ws + WS_H);
  float* rstd = (float*)(p.ws + WS_RSTD);
  if (blockIdx.x == 0) {
    float* gs = (float*)(p.ws + WS_GS);
    float* sh = (float*)(p.ws + WS_SH);
    for (int i = tid; i < 3072; i += NTHR) {
      const int w = i >> 10, k = i & 1023;
      gs[i] = g[k] * (1.f + mod[w * 3072 + 1024 + k]);
      sh[i] = mod[w * 3072 + k];
    }
  }
  for (int row = blockIdx.x * 8 + wave; row < R_TOT; row += gridDim.x * 8) {
    const float* xr = xrow(p, l, row);
    const int w = which_of(row);
    v4f v[4];
    float ss = 0.f;
#pragma unroll
    for (int j = 0; j < 4; ++j) {
      v[j] = *(const v4f*)(xr + lane * 4 + 256 * j);
      ss += v[j][0] * v[j][0] + v[j][1] * v[j][1] + v[j][2] * v[j][2] + v[j][3] * v[j][3];
    }
    ss = wave_sum(ss);
    const float rs = rsqrtf(ss * (1.f / 1024.f) + 1e-6f);
    if (lane == 0) rstd[row] = rs;
#pragma unroll
    for (int j = 0; j < 4; ++j) {
      const int k = lane * 4 + 256 * j;
      const v4f gg = *(const v4f*)(g + k);
      const v4f sc = *(const v4f*)(mod + w * 3072 + 1024 + k);
      const v4f sf = *(const v4f*)(mod + w * 3072 + k);
      float o[4];
#pragma unroll
      for (int e = 0; e < 4; ++e) o[e] = v[j][e] * rs * gg[e] * (1.f + sc[e]) + sf[e];
      v2u pk;
      pk[0] = pk2(o[0], o[1]);
      pk[1] = pk2(o[2], o[3]);
      *(v2u*)(H + (size_t)row * 1024 + k) = pk;
    }
  }
  u16* WTI = (u16*)(p.ws + WS_WT_IN);
  u16* WTB = (u16*)(p.ws + WS_WT_BR);
  u16* WTO = (u16*)(p.ws + WS_WT_OUT);
  const float* win = p.w_in + (size_t)l * 1024 * 9744;
  for (int it = blockIdx.x; it < 2464 + 384 + 256; it += gridDim.x) {
    if (it < 2464) {
      const int nb = it % 154, kb = it / 154;
      const int n0 = nb * 64;
      int col0 = n0, nvalid = 64;
      bool perm = n0 < 1024;
      if (n0 >= 4608 && n0 < 9728) col0 = n0 + 16;
      else if (n0 == 9728) { col0 = 4608; nvalid = 16; }
      else if (n0 > 9728) { col0 = 0; nvalid = 0; }
      conv_tile(win, 9744, kb * 64, col0, nvalid, perm, WTI, 1024, n0, smem);
    } else if (it < 2464 + 384) {
      const int j = it - 2464;
      const int n = j / 128, r = j % 128, db = r / 8, wb = r % 8;
      conv_tile(p.w_br + ((size_t)l * 3 + n) * 512 * 1024, 1024, wb * 64, db * 64, 64, false,
                WTB + (size_t)n * 1024 * 512, 512, db * 64, smem);
    } else {
      const int j = it - 2464 - 384;
      const int db = j / 16, kb = j % 16;
      conv_tile(p.w_out + (size_t)l * 1024 * 1024, 1024, kb * 64, db * 64, 64, false, WTO, 1024, db * 64, smem);
    }
  }
}

template <int AMODE, int MI>
__device__ __forceinline__ void gemm_core(f32x16 (&acc)[MI][2], const u16* __restrict__ A, int lda,
                                          const float* __restrict__ Ax, const float* __restrict__ rstd,
                                          const float* __restrict__ gs, const float* __restrict__ sh,
                                          const u16* __restrict__ B, int K, unsigned char* smem) {
  constexpr int AROWS = 128 * MI;
  u16* As = (u16*)smem;
  u16* Bs = (u16*)(smem + 73728);
  const int tid = opaque_tid(), lane = tid & 63, wave = tid >> 6;
  const int wm = wave >> 1, wn = wave & 1, r = lane & 31, hh = lane >> 5;
  const int lrow = tid >> 3, c8 = tid & 7;
  v4u ra[2][2 * MI], rb[2][2];
  float rs4[2 * MI];
  if (AMODE == 1) {
#pragma unroll
    for (int i = 0; i < 2 * MI; ++i) rs4[i] = rstd[lrow + 64 * i];
  }
  const int KT = K >> 6;
#define GEMM_LOAD(set, k0)                                                                        \
  {                                                                                               \
    if (AMODE == 0) {                                                                             \
      _Pragma("unroll") for (int i = 0; i < 2 * MI; ++i)                                          \
        ra[set][i] = *(const v4u*)(A + (size_t)(lrow + 64 * i) * lda + (k0) + c8 * 8);            \
    } else {                                                                                      \
      const v4f g0 = *(const v4f*)(gs + (k0) + c8 * 8), g1 = *(const v4f*)(gs + (k0) + c8 * 8 + 4); \
      const v4f s0 = *(const v4f*)(sh + (k0) + c8 * 8), s1 = *(const v4f*)(sh + (k0) + c8 * 8 + 4); \
      _Pragma("unroll") for (int i = 0; i < 2 * MI; ++i) {                                        \
        const float* xp = Ax + (size_t)(lrow + 64 * i) * 1024 + (k0) + c8 * 8;                    \
        const v4f x0 = *(const v4f*)xp, x1 = *(const v4f*)(xp + 4);                               \
        const float rr = rs4[i];                                                                  \
        ra[set][i][0] = pk2(x0[0] * rr * g0[0] + s0[0], x0[1] * rr * g0[1] + s0[1]);              \
        ra[set][i][1] = pk2(x0[2] * rr * g0[2] + s0[2], x0[3] * rr * g0[3] + s0[3]);              \
        ra[set][i][2] = pk2(x1[0] * rr * g1[0] + s1[0], x1[1] * rr * g1[1] + s1[1]);              \
        ra[set][i][3] = pk2(x1[2] * rr * g1[2] + s1[2], x1[3] * rr * g1[3] + s1[3]);              \
      }                                                                                           \
    }                                                                                             \
    _Pragma("unroll") for (int i = 0; i < 2; ++i)                                                 \
        rb[set][i] = *(const v4u*)(B + (size_t)(lrow + 64 * i) * K + (k0) + c8 * 8);              \
  }
#define GEMM_STORE(set, buf)                                                                      \
  {                                                                                               \
    _Pragma("unroll") for (int i = 0; i < 2 * MI; ++i)                                            \
        *(v4u*)(As + (buf) * AROWS * 72 + (lrow + 64 * i) * 72 + c8 * 8) = ra[set][i];            \
    _Pragma("unroll") for (int i = 0; i < 2; ++i)                                                 \
        *(v4u*)(Bs + (buf) * 128 * 72 + (lrow + 64 * i) * 72 + c8 * 8) = rb[set][i];              \
  }
#define GEMM_COMPUTE(cur)                                                                         \
  {                                                                                               \
    const u16* Ab = As + (cur) * AROWS * 72 + (32 * MI * wm + r) * 72 + 8 * hh;                   \
    const u16* Bb = Bs + (cur) * 128 * 72 + (64 * wn + r) * 72 + 8 * hh;                          \
    _Pragma("unroll") for (int ks = 0; ks < 4; ++ks) {                                            \
      const bf16x8 b0 = *(const bf16x8*)(Bb + ks * 16);                                           \
      const bf16x8 b1 = *(const bf16x8*)(Bb + 32 * 72 + ks * 16);                                 \
      _Pragma("unroll") for (int i = 0; i < MI; ++i) {                                            \
        const bf16x8 a0 = *(const bf16x8*)(Ab + i * 32 * 72 + ks * 16);                           \
        acc[i][0] = mfma32(a0, b0, acc[i][0]);                                                    \
        acc[i][1] = mfma32(a0, b1, acc[i][1]);                                                    \
      }                                                                                           \
    }                                                                                             \
  }
  GEMM_LOAD(0, 0);
  GEMM_LOAD(1, 64);
  GEMM_STORE(0, 0);
  __syncthreads();
  for (int kt = 0; kt < KT; kt += 2) {
    if (kt + 2 < KT) GEMM_LOAD(0, (kt + 2) * 64);
    GEMM_COMPUTE(0);
    GEMM_STORE(1, 1);
    __syncthreads();
    if (kt + 3 < KT) GEMM_LOAD(1, (kt + 3) * 64);
    GEMM_COMPUTE(1);
    if (kt + 2 < KT) GEMM_STORE(0, 0);
    __syncthreads();
  }
#undef GEMM_COMPUTE
#undef GEMM_LOAD
#undef GEMM_STORE
}

template <int LEAN>
__device__ __forceinline__ void gemm_core256(f32x16 (&acc)[2][4], const u16* __restrict__ A, int lda,
                                             const u16* __restrict__ B, int K, unsigned char* smem) {
  u16* As = (u16*)smem;
  u16* Bs = (u16*)(smem + 73728);
  const int tid = opaque_tid(), lane = tid & 63, wave = tid >> 6;
  const int wm = wave >> 1, wn = wave & 1, r = lane & 31, hh = lane >> 5;
  const int lrow = tid >> 3, c8 = tid & 7;
  v4u ra[4], rb[4];
  const int KT = K >> 6;
#define G2_LOAD(k0)                                                                               \
  {                                                                                               \
    _Pragma("unroll") for (int i = 0; i < 4; ++i) {                                               \
      ra[i] = *(const v4u*)(A + (size_t)(lrow + 64 * i) * lda + (k0) + c8 * 8);                   \
      rb[i] = *(const v4u*)(B + (size_t)(lrow + 64 * i) * K + (k0) + c8 * 8);                     \
    }                                                                                             \
  }
#define G2_STORE(buf)                                                                             \
  {                                                                                               \
    _Pragma("unroll") for (int i = 0; i < 4; ++i) {                                               \
      *(v4u*)(As + (buf) * 256 * 72 + (lrow + 64 * i) * 72 + c8 * 8) = ra[i];                     \
      *(v4u*)(Bs + (buf) * 256 * 72 + (lrow + 64 * i) * 72 + c8 * 8) = rb[i];                     \
    }                                                                                             \
  }
  G2_LOAD(0);
  G2_STORE(0);
  __syncthreads();
  if (KT > 1) G2_LOAD(64);
  for (int kt = 0; kt < KT; ++kt) {
    const int cur = kt & 1;
    const u16* Ab = As + cur * 256 * 72 + (64 * wm + r) * 72 + 8 * hh;
    const u16* Bb = Bs + cur * 256 * 72 + (128 * wn + r) * 72 + 8 * hh;
#pragma unroll
    for (int ks = 0; ks < 4; ++ks) {
      if (LEAN) __builtin_amdgcn_sched_barrier(0);
      const bf16x8 a0 = *(const bf16x8*)(Ab + ks * 16);
      const bf16x8 a1 = *(const bf16x8*)(Ab + 32 * 72 + ks * 16);
#pragma unroll
      for (int j = 0; j < 4; ++j) {
        const bf16x8 b0 = *(const bf16x8*)(Bb + j * 32 * 72 + ks * 16);
        acc[0][j] = mfma32(a0, b0, acc[0][j]);
        acc[1][j] = mfma32(a1, b0, acc[1][j]);
      }
    }
    if (kt + 1 < KT) {
      G2_STORE(cur ^ 1);
      if (kt + 2 < KT) G2_LOAD((kt + 2) * 64);
    }
    __syncthreads();
  }
#undef G2_LOAD
#undef G2_STORE
}

__device__ __forceinline__ void s2_store64(const Params& p, int grp, const f32x16& a0, const f32x16& a1, int rowbase, int fb64,
                                           bool latent, int b, int keyb, int r, int hh, const float* __restrict__ rope) {
  if (grp == P_VTA || grp == P_VTB || grp == P_VTC) {
    u16* VT = piece(p, grp);
#pragma unroll
    for (int j = 0; j < 2; ++j) {
      const int f = fb64 + 32 * j + r;
#pragma unroll
      for (int q = 0; q < 4; ++q) {
        const int key = keyb + 16 * (q >> 1) + 4 * (hh * 2 + (q & 1));
        v2u pk;
        if (j == 0) { pk[0] = pk2(a0[4 * q], a0[4 * q + 1]); pk[1] = pk2(a0[4 * q + 2], a0[4 * q + 3]); }
        else { pk[0] = pk2(a1[4 * q], a1[4 * q + 1]); pk[1] = pk2(a1[4 * q + 2], a1[4 * q + 3]); }
        *(v2u*)(VT + ((size_t)(b * 512 + f)) * NKEY + key) = pk;
      }
    }
  } else {
    u16* D = piece(p, grp);
    const bool rot = latent && (grp == P_QA || grp == P_KA);
    const float qs = (grp == P_QA || grp == P_QC) ? 0.18033688011112042f : 1.f;
#pragma unroll
    for (int e = 0; e < 16; ++e) {
      const int row = rowbase + (e & 3) + 8 * (e >> 2) + 4 * hh;
      float v0 = a0[e], v1 = a1[e];
      if (rot) {
        const int t = row & 8191;
        const int vv = (r < 16) ? (t >> 6) : (t & 63);
        const float cs = rope[(vv * 16 + (r & 15)) * 2], sn = rope[(vv * 16 + (r & 15)) * 2 + 1];
        const float o0 = v0 * cs - v1 * sn, o1 = v0 * sn + v1 * cs;
        v0 = o0; v1 = o1;
      }
      D[(size_t)row * 512 + fb64 + r] = f2bf(v0 * qs);
      D[(size_t)row * 512 + fb64 + 32 + r] = f2bf(v1 * qs);
    }
  }
}

__device__ __attribute__((always_inline)) void phase_s2(const Params& p, int l, unsigned char* smem) {
  const int tid = opaque_tid(), lane = tid & 63, wave = tid >> 6;
  const int wm = wave >> 1, wn = wave & 1, r = lane & 31, hh = lane >> 5;
  const u16* H = (const u16*)(p.ws + WS_H);
  const u16* WTI = (const u16*)(p.ws + WS_WT_IN);
  const float* rope = (const float*)(p.ws + WS_ROPE);
  float* G = (float*)(p.ws + WS_G);
  {
    const bool xs = (gridDim.x & 7) == 0;
    const int nb = xs ? (gridDim.x >> 3) : gridDim.x;
    const int xcd = xs ? (blockIdx.x & 7) : 0, slot = xs ? (blockIdx.x >> 3) : blockIdx.x;
    const int nx = xs ? 8 : 1;
    const int seg0 = (1716 * xcd) / nx, seg1 = (1716 * (xcd + 1)) / nx;
#pragma unroll 1
    for (int L = seg0 + slot; L < seg1; L += nb) {
      int rt, ct;
      if (L < 1664) { const int g = L / 208, rem = L % 208; ct = rem >> 3; rt = 8 * g + (rem & 7); }
      else { const int rem = L - 1664; ct = rem >> 1; rt = 64 + (rem & 1); }
      const int row0 = rt * 256, n0 = ct * 256;
      f32x16 acc[2][4];
#pragma unroll
      for (int i = 0; i < 2; ++i)
#pragma unroll
        for (int j = 0; j < 4; ++j) acc[i][j] = zero16();
      gemm_core256<0>(acc, H + (size_t)row0 * 1024, 1024, WTI + (size_t)n0 * 1024, 1024, smem);
      const bool latent = row0 < 16384;
      const int b = latent ? (row0 >> 13) : ((row0 - 16384) >> 8);
      const int keybase = latent ? (row0 & 8191) : 8192;
      const int grp = n0 >> 9;
      const int fbase = (n0 & 511) + 128 * wn;
#pragma unroll
      for (int i = 0; i < 2; ++i)
#pragma unroll
        for (int g2 = 0; g2 < 2; ++g2)
          s2_store64(p, grp, acc[i][2 * g2], acc[i][2 * g2 + 1], row0 + 64 * wm + 32 * i, fbase + 64 * g2, latent, b,
                     keybase + 64 * wm + 32 * i, r, hh, rope);
    }
  }
#pragma unroll 1
  for (int rt = blockIdx.x; rt < 66; rt += gridDim.x) {
    const int row0 = rt * 256;
    f32x16 acc[2][2];
    acc[0][0] = zero16(); acc[0][1] = zero16(); acc[1][0] = zero16(); acc[1][1] = zero16();
    gemm_core<0, 2>(acc, H + (size_t)row0 * 1024, 1024, nullptr, nullptr, nullptr, nullptr, WTI + (size_t)9728 * 1024, 1024, smem);
    if (wn == 0) {
#pragma unroll
      for (int i = 0; i < 2; ++i)
#pragma unroll
        for (int e = 0; e < 16; ++e) {
          const int row = row0 + 64 * wm + 32 * i + (e & 3) + 8 * (e >> 2) + 4 * hh;
          if (r < 16) G[(size_t)row * 16 + r] = acc[i][0][e];
        }
    }
  }
}

__device__ __attribute__((always_inline)) void attn_item(const Params& p, int l, int b, int h, int qgrow0, int kt0, int kt1, unsigned char* smem) {
  u16* Ks = (u16*)smem;
  u16* Vs = (u16*)(smem + 34816);
  const int tid = opaque_tid(), lane = tid & 63, wave = tid >> 6;
  const int c = wave & 1, qg = wave >> 1, r = lane & 31, hh = lane >> 5;
  u16* QA = piece(p, P_QA);
  const u16* KA = piece(p, P_KA);
  const u16* VT = piece(p, P_VTA);
  const u16* ZA = piece(p, P_ZA);
  const float lam_init = 0.8f - 0.6f * expf(-0.3f * (float)l);
  float lam;
  {
    const float* lq = p.lam_q + l * 128;
    const float* lk = p.lam_k + l * 128;
    const float s0 = wave_sum(lq[lane] * lk[lane]);
    const float s1 = wave_sum(lq[64 + lane] * lk[64 + lane]);
    lam = expf(s0) - expf(s1) + lam_init;
  }
  const int qrow = qgrow0 + qg * 32 + r;
  bf16x8 qf[4];
#pragma unroll
  for (int ks = 0; ks < 4; ++ks) qf[ks] = *(const bf16x8*)(QA + (size_t)qrow * 512 + h * 128 + c * 64 + ks * 16 + hh * 8);
  f32x16 O[4];
#pragma unroll
  for (int i = 0; i < 4; ++i) O[i] = zero16();
  float m = -1e30f, lsum = 0.f;
  const int krow_l = tid >> 4, kc16 = tid & 15;
  const int vrow_l = tid >> 3, vc8 = tid & 7;
  v4u rk[2], rv[2];
#define ATT_LOADK(kt)                                                                             \
  {                                                                                               \
    const int key0 = (kt) * 64;                                                                   \
    const int gbase = (key0 < 8192) ? (b * 8192 + key0) : (16384 + b * 256 + key0 - 8192);        \
    _Pragma("unroll") for (int i = 0; i < 2; ++i)                                                 \
      rk[i] = *(const v4u*)(KA + (size_t)(gbase + krow_l + 32 * i) * 512 + h * 128 + kc16 * 8);   \
  }
#define ATT_LOADV(kt)                                                                             \
  {                                                                                               \
    const int key0 = (kt) * 64;                                                                   \
    _Pragma("unroll") for (int i = 0; i < 2; ++i)                                                 \
      rv[i] = *(const v4u*)(VT + ((size_t)(b * 512 + h * 128 + vrow_l + 64 * i)) * NKEY + key0 + vc8 * 8); \
  }
#define ATT_STOREK(buf)                                                                           \
  {                                                                                               \
    _Pragma("unroll") for (int i = 0; i < 2; ++i)                                                 \
      *(v4u*)(Ks + (buf) * 64 * 136 + (krow_l + 32 * i) * 136 + kc16 * 8) = rk[i];                \
  }
#define ATT_STOREV(buf)                                                                           \
  {                                                                                               \
    _Pragma("unroll") for (int i = 0; i < 2; ++i)                                                 \
      *(v4u*)(Vs + (buf) * 128 * 72 + (vrow_l + 64 * i) * 72 + vc8 * 8) = rv[i];                  \
  }
#define ATT_QK(Sx, buf)                                                                           \
  {                                                                                               \
    _Pragma("unroll") for (int kk = 0; kk < 2; ++kk) {                                            \
      Sx[kk] = zero16();                                                                          \
      _Pragma("unroll") for (int ks = 0; ks < 4; ++ks) {                                          \
        const bf16x8 kf = *(const bf16x8*)(Ks + (buf) * 64 * 136 + (32 * kk + r) * 136 + c * 64 + ks * 16 + hh * 8); \
        Sx[kk] = mfma32(kf, qf[ks], Sx[kk]);                                                      \
      }                                                                                           \
    }                                                                                             \
  }
  ATT_LOADK(kt0);
  ATT_LOADV(kt0);
  ATT_STOREK(0);
  ATT_STOREV(0);
  if (kt0 + 1 < kt1) { ATT_LOADK(kt0 + 1); ATT_STOREK(1); }
  __syncthreads();
  f32x16 S[2], Sn[2];
  ATT_QK(S, 0);
  if (kt0 + 2 < kt1) ATT_LOADK(kt0 + 2);
  if (kt0 + 1 < kt1) ATT_LOADV(kt0 + 1);
  for (int kt = kt0; kt < kt1; ++kt) {
    const int cur = (kt - kt0) & 1;
    if (kt + 1 < kt1) ATT_QK(Sn, cur ^ 1);
    float mx = -1e30f;
#pragma unroll
    for (int kk = 0; kk < 2; ++kk)
#pragma unroll
      for (int e = 0; e < 16; ++e) mx = fmaxf(mx, S[kk][e]);
    mx = fmaxf(mx, __shfl_xor(mx, 32, 64));
    const float mnew = fmaxf(m, mx);
    if (__builtin_amdgcn_ballot_w64(mnew > m) != 0ull) {
      const float alpha = ex2(m - mnew);
      lsum *= alpha;
#pragma unroll
      for (int i = 0; i < 4; ++i)
#pragma unroll
        for (int e = 0; e < 16; ++e) O[i][e] *= alpha;
    }
    m = mnew;
    bf16x8 pf[4];
#pragma unroll
    for (int kk = 0; kk < 2; ++kk)
#pragma unroll
      for (int s2 = 0; s2 < 2; ++s2) {
        v4u pkd;
#pragma unroll
        for (int jj = 0; jj < 4; ++jj) {
          const float p0 = ex2(S[kk][8 * s2 + 2 * jj] - mnew);
          const float p1 = ex2(S[kk][8 * s2 + 2 * jj + 1] - mnew);
          lsum += p0 + p1;
          pkd[jj] = pk2(p0, p1);
        }
        pf[2 * kk + s2] = (bf16x8)pkd;
      }
#pragma unroll
    for (int dvt = 0; dvt < 4; ++dvt)
#pragma unroll
      for (int s = 0; s < 4; ++s) {
        const bf16x8 vf = *(const bf16x8*)(Vs + cur * 128 * 72 + (32 * dvt + r) * 72 + 16 * s + 8 * hh);
        O[dvt] = mfma32(vf, pf[s], O[dvt]);
      }
    if (kt + 2 < kt1) ATT_STOREK(cur);
    if (kt + 1 < kt1) ATT_STOREV(cur ^ 1);
    if (kt + 3 < kt1) ATT_LOADK(kt + 3);
    if (kt + 2 < kt1) ATT_LOADV(kt + 2);
    __syncthreads();
    S[0] = Sn[0];
    S[1] = Sn[1];
  }
#undef ATT_LOADK
#undef ATT_LOADV
#undef ATT_STOREK
#undef ATT_STOREV
#undef ATT_QK
  const float ltot = lsum + __shfl_xor(lsum, 32, 64);
  const float inv = 1.f / ltot;
  float* X = (float*)smem;
  if (c == 1) {
#pragma unroll
    for (int dvt = 0; dvt < 4; ++dvt)
#pragma unroll
      for (int e = 0; e < 16; ++e) X[(qg * 128 + 32 * dvt + (e & 3) + 8 * (e >> 2) + 4 * hh) * 32 + r] = O[dvt][e] * inv;
  }
  __syncthreads();
  if (c == 0) {
    float ss = 0.f;
#pragma unroll
    for (int dvt = 0; dvt < 4; ++dvt)
#pragma unroll
      for (int e = 0; e < 16; ++e) {
        const float o = O[dvt][e] * inv - lam * X[(qg * 128 + 32 * dvt + (e & 3) + 8 * (e >> 2) + 4 * hh) * 32 + r];
        O[dvt][e] = o;
        ss += o * o;
      }
    ss += __shfl_xor(ss, 32, 64);
    const float rinv = rsqrtf(ss * (1.f / 128.f) + 1e-6f) * (1.f - lam_init);
    const float* dg = p.da_g + l * 128;
#pragma unroll
    for (int dvt = 0; dvt < 4; ++dvt)
#pragma unroll
      for (int g = 0; g < 4; ++g) {
        const int dv0 = 32 * dvt + 8 * g + 4 * hh;
        const size_t off = (size_t)qrow * 512 + h * 128 + dv0;
        const v2u z = *(const v2u*)(ZA + off);
        const float y0 = O[dvt][4 * g] * rinv * dg[dv0] * silu_f(bflo(z[0]));
        const float y1 = O[dvt][4 * g + 1] * rinv * dg[dv0 + 1] * silu_f(bfhi(z[0]));
        const float y2 = O[dvt][4 * g + 2] * rinv * dg[dv0 + 2] * silu_f(bflo(z[1]));
        const float y3 = O[dvt][4 * g + 3] * rinv * dg[dv0 + 3] * silu_f(bfhi(z[1]));
        v2u o;
        o[0] = pk2(y0, y1);
        o[1] = pk2(y2, y3);
        *(v2u*)(QA + off) = o;
      }
  }
  __syncthreads();
}

__device__ __attribute__((always_inline)) void natten_item(const Params& p, int l, int b, int rr, int qgrow, int i0, unsigned char* smem) {
  float* rp = (float*)smem;
  const int tid = opaque_tid(), lane = tid & 63, head = tid >> 6;
  const int r = lane & 31, hh = lane >> 5;
  for (int i = tid; i < 3720; i += NTHR) rp[i] = p.rpb[(size_t)l * 3720 + i];
  __syncthreads();
  u16* QC = piece(p, P_QC);
  const u16* KC = piece(p, P_KC);
  const u16* VT = piece(p, P_VTC);
  const u16* ZC = piece(p, P_ZC);
  const int rs = min(max(rr - 4, 0), 120);
  bf16x8 qf[2][4];
#pragma unroll
  for (int qt = 0; qt < 2; ++qt)
#pragma unroll
    for (int ks = 0; ks < 4; ++ks)
      qf[qt][ks] = *(const bf16x8*)(QC + (size_t)(qgrow + 32 * qt + r) * 512 + head * 64 + ks * 16 + hh * 8);
  f32x16 O[2][2];
  O[0][0] = zero16(); O[0][1] = zero16(); O[1][0] = zero16(); O[1][1] = zero16();
  float m[2] = {-1e30f, -1e30f}, lsum[2] = {0.f, 0.f};
  const float L2E = 1.4426950408889634f;
  for (int i = i0; i < 12; ++i) {
    const bool local = i < 8;
    const int krow = rs + i;
    const int kg0 = local ? (b * 8192 + krow * 64) : (16384 + b * 256 + (i - 8) * 64);
    const int key0 = local ? krow * 64 : 8192 + (i - 8) * 64;
    f32x16 S[2][2];
    S[0][0] = zero16(); S[0][1] = zero16(); S[1][0] = zero16(); S[1][1] = zero16();
#pragma unroll
    for (int kk = 0; kk < 2; ++kk)
#pragma unroll
      for (int ks = 0; ks < 4; ++ks) {
        const bf16x8 kf = *(const bf16x8*)(KC + (size_t)(kg0 + 32 * kk + r) * 512 + head * 64 + ks * 16 + hh * 8);
        S[kk][0] = mfma32(kf, qf[0][ks], S[kk][0]);
        S[kk][1] = mfma32(kf, qf[1][ks], S[kk][1]);
      }
    bf16x8 pf[2][4];
#pragma unroll
    for (int qt = 0; qt < 2; ++qt) {
      const int qcol = 32 * qt + r;
      const int cs = min(max(qcol - 8, 0), 48);
      const float* rprow = rp + (head * 15 + (local ? (krow - rr + 7) : 0)) * 31 + 15 - qcol;
      float mx = -1e30f;
#pragma unroll
      for (int kk = 0; kk < 2; ++kk)
#pragma unroll
        for (int e = 0; e < 16; ++e) {
          const int kcol = 32 * kk + (e & 3) + 8 * (e >> 2) + 4 * hh;
          float s = S[kk][qt][e];
          if (local) {
            const bool valid = (kcol >= cs) && (kcol < cs + 16);
            const int ci = min(max(kcol, cs), cs + 15);
            s = valid ? (s + rprow[ci] * L2E) : -1e30f;
          }
          S[kk][qt][e] = s;
          mx = fmaxf(mx, s);
        }
      mx = fmaxf(mx, __shfl_xor(mx, 32, 64));
      const float mnew = fmaxf(m[qt], mx);
      if (__builtin_amdgcn_ballot_w64(mnew > m[qt]) != 0ull) {
        const float alpha = ex2(m[qt] - mnew);
        lsum[qt] *= alpha;
#pragma unroll
        for (int dvt = 0; dvt < 2; ++dvt)
#pragma unroll
          for (int e = 0; e < 16; ++e) O[dvt][qt][e] *= alpha;
      }
      m[qt] = mnew;
#pragma unroll
      for (int kk = 0; kk < 2; ++kk)
#pragma unroll
        for (int s2 = 0; s2 < 2; ++s2) {
          v4u pkd;
#pragma unroll
          for (int jj = 0; jj < 4; ++jj) {
            const float p0 = ex2(S[kk][qt][8 * s2 + 2 * jj] - mnew);
            const float p1 = ex2(S[kk][qt][8 * s2 + 2 * jj + 1] - mnew);
            lsum[qt] += p0 + p1;
            pkd[jj] = pk2(p0, p1);
          }
          pf[qt][2 * kk + s2] = (bf16x8)pkd;
        }
    }
#pragma unroll
    for (int dvt = 0; dvt < 2; ++dvt)
#pragma unroll
      for (int s = 0; s < 4; ++s) {
        const bf16x8 vf = *(const bf16x8*)(VT + ((size_t)(b * 512 + head * 64 + 32 * dvt + r)) * NKEY + key0 + 16 * s + 8 * hh);
        O[dvt][0] = mfma32(vf, pf[0][s], O[dvt][0]);
        O[dvt][1] = mfma32(vf, pf[1][s], O[dvt][1]);
      }
  }
#pragma unroll
  for (int qt = 0; qt < 2; ++qt) {
    const float inv = 1.f / (lsum[qt] + __shfl_xor(lsum[qt], 32, 64));
    const int qrow = qgrow + 32 * qt + r;
#pragma unroll
    for (int dvt = 0; dvt < 2; ++dvt)
#pragma unroll
      for (int g = 0; g < 4; ++g) {
        const int dv0 = 32 * dvt + 8 * g + 4 * hh;
        const size_t off = (size_t)qrow * 512 + head * 64 + dv0;
        const v2u z = *(const v2u*)(ZC + off);
        v2u o;
        o[0] = pk2(O[dvt][qt][4 * g] * inv * silu_f(bflo(z[0])), O[dvt][qt][4 * g + 1] * inv * silu_f(bfhi(z[0])));
        o[1] = pk2(O[dvt][qt][4 * g + 2] * inv * silu_f(bflo(z[1])), O[dvt][qt][4 * g + 3] * inv * silu_f(bfhi(z[1])));
        *(v2u*)(QC + off) = o;
      }
  }
  __syncthreads();
}

__device__ __forceinline__ float logsigmoid_f(float x) { return fminf(x, 0.f) - log1pf(__expf(-fabsf(x))); }
__device__ __forceinline__ int chunk_grow0(int b, int P) { return P < 2 ? 16384 + b * 256 + 128 * P : b * 8192 + 128 * (P - 2); }
__device__ __forceinline__ int chunk_key0(int P) { return P < 2 ? 8192 + 128 * P : 128 * (P - 2); }

__device__ __forceinline__ void mlstm_gates(const Params& p, int l, int head, int grow0, float* lf, float* li) {
  const int tid = opaque_tid();
  if (tid < 256) {
    const int d = tid >> 7, s = tid & 127;
    const float* G = (const float*)(p.ws + WS_G) + (size_t)(grow0 + s) * 16;
    const float gi = G[d * 8 + head] + p.gate_b[l * 16 + d * 8 + head];
    const float gf = G[d * 8 + 4 + head] + p.gate_b[l * 16 + d * 8 + 4 + head];
    li[d * 128 + s] = gi;
    lf[d * 128 + s] = logsigmoid_f(gf);
  }
}

__device__ __forceinline__ void conv8(const Params& p, int l, const u16* src, int grow, int fcol, int ch0, bool hasprev,
                                      bool hasnext, float scale, float (&o)[8]) {
  const v4u zero = {0u, 0u, 0u, 0u};
  const v4u xm = hasprev ? *(const v4u*)(src + (size_t)(grow - 1) * 512 + fcol) : zero;
  const v4u x0 = *(const v4u*)(src + (size_t)grow * 512 + fcol);
  const v4u xp = hasnext ? *(const v4u*)(src + (size_t)(grow + 1) * 512 + fcol) : zero;
  const float* cw = p.conv_w + (size_t)l * 3 * 1024 + ch0;
  const float* cb = p.conv_b + (size_t)l * 1024 + ch0;
#pragma unroll
  for (int e = 0; e < 8; ++e) {
    const float a = (e & 1) ? bfhi(xm[e >> 1]) : bflo(xm[e >> 1]);
    const float bq = (e & 1) ? bfhi(x0[e >> 1]) : bflo(x0[e >> 1]);
    const float cq = (e & 1) ? bfhi(xp[e >> 1]) : bflo(xp[e >> 1]);
    const float y = a * cw[e] + bq * cw[1024 + e] + cq * cw[2048 + e] + cb[e];
    o[e] = silu_f(y) * scale;
  }
}

__device__ __attribute__((always_inline)) void mlstm_b1_item(const Params& p, int l, int b, int head, int P, unsigned char* smem) {
  u16* kwT = (u16*)smem;
  float* lf = (float*)(smem + 69632);
  float* li = lf + 256;
  float* wS = li + 256;
  const int tid = opaque_tid(), lane = tid & 63, wave = tid >> 6;
  const int r = lane & 31, hh = lane >> 5;
  const int grow0 = chunk_grow0(b, P), key0 = chunk_key0(P);
  float* BL = (float*)(p.ws + WS_BL);
  float* DN = (float*)(p.ws + WS_DN);
  u16* CST = (u16*)(p.ws + WS_H);
  mlstm_gates(p, l, head, grow0, lf, li);
  __syncthreads();
  if (tid < 256) {
    const int d = tid >> 7, s = tid & 127;
    float tot = 0.f, bs = 0.f;
    for (int j = 0; j < 128; ++j) {
      const float v = lf[d * 128 + j];
      tot += v;
      if (d == 0 ? (j <= s) : (j >= s)) bs += v;
    }
    wS[d * 128 + s] = __expf(tot - bs + li[d * 128 + s]);
    if (s == 0) BL[((b * 4 + head) * 2 + d) * 66 + P] = tot;
  }
  __syncthreads();
  const u16* KB = piece(p, P_KB);
#pragma unroll 1
  for (int i = 0; i < 4; ++i) {
    const int u = tid + NTHR * i;
    const int s = u >> 4, dg = u & 15;
    const bool hasprev = !((P == 0 || P == 2) && s == 0);
    const bool hasnext = !((P == 1 || P == 65) && s == 127);
    float kc[8];
    conv8(p, l, KB, grow0 + s, head * 128 + dg * 8, 512 + head * 128 + dg * 8, hasprev, hasnext, 0.08838834764831845f, kc);
    const int ps = perm16(s);
    const float w0 = wS[s], w1 = wS[128 + s];
#pragma unroll
    for (int e = 0; e < 8; ++e) {
      kwT[(dg * 8 + e) * 136 + ps] = f2bf(kc[e] * w0);
      kwT[(128 + dg * 8 + e) * 136 + ps] = f2bf(kc[e] * w1);
    }
  }
  __syncthreads();
  {
    const int d = wave >> 2, dvt = wave & 3;
    const u16* VT = piece(p, P_VTB);
    bf16x8 vf[8];
#pragma unroll
    for (int s8 = 0; s8 < 8; ++s8)
      vf[s8] = *(const bf16x8*)(VT + ((size_t)(b * 512 + head * 128 + 32 * dvt + r)) * NKEY + key0 + 16 * s8 + 8 * hh);
    const int chain = (b * 4 + head) * 2 + d;
    u16* dst = CST + ((size_t)(chain * 66 + P)) * 16384;
#pragma unroll
    for (int dkt = 0; dkt < 4; ++dkt) {
      f32x16 acc = zero16();
#pragma unroll
      for (int s8 = 0; s8 < 8; ++s8) {
        const bf16x8 kf = *(const bf16x8*)(kwT + (d * 128 + 32 * dkt + r) * 136 + 16 * s8 + 8 * hh);
        acc = mfma32(vf[s8], kf, acc);
      }
#pragma unroll
      for (int e = 0; e < 16; ++e) {
        const int dv = 32 * dvt + (e & 3) + 8 * (e >> 2) + 4 * hh;
        dst[dv * 128 + 32 * dkt + r] = f2bf(acc[e]);
      }
    }
  }
  if (tid < 256) {
    const int d = tid >> 7, dk = tid & 127;
    float s = 0.f;
    for (int j = 0; j < 128; ++j) s += bf2f(kwT[(d * 128 + dk) * 136 + j]);
    DN[(((b * 4 + head) * 2 + d) * 66 + P) * 128 + dk] = s;
  }
  __syncthreads();
}

__device__ __attribute__((always_inline)) void phase_b2(const Params& p) {
  const int gid = blockIdx.x * NTHR + threadIdx.x;
  const float* BL = (const float*)(p.ws + WS_BL);
  if (gid < 131072) {
    const int chain = gid >> 13, e2 = gid & 8191;
    const int d = chain & 1;
    unsigned* base = (unsigned*)(p.ws + WS_H) + (size_t)chain * 66 * 8192 + e2;
    float c0 = 0.f, c1 = 0.f;
    for (int i0 = 0; i0 < 66; i0 += 6) {
      unsigned v[6];
      float a[6];
#pragma unroll
      for (int j = 0; j < 6; ++j) {
        const int i = i0 + j;
        const int P = d == 0 ? i : (i < 2 ? 1 - i : 67 - i);
        v[j] = base[(size_t)P * 8192];
        a[j] = __expf(BL[chain * 66 + P]);
      }
#pragma unroll
      for (int j = 0; j < 6; ++j) {
        const int i = i0 + j;
        const int P = d == 0 ? i : (i < 2 ? 1 - i : 67 - i);
        base[(size_t)P * 8192] = pk2(c0, c1);
        c0 = a[j] * c0 + bflo(v[j]);
        c1 = a[j] * c1 + bfhi(v[j]);
      }
    }
  }
  if (gid < 2048) {
    const int chain = gid >> 7, dk = gid & 127;
    const int d = chain & 1;
    const float* DN = (const float*)(p.ws + WS_DN);
    float* NP = (float*)(p.ws + WS_NPREV);
    float run = 0.f;
    for (int i = 0; i < 66; ++i) {
      const int P = d == 0 ? i : (i < 2 ? 1 - i : 67 - i);
      NP[(chain * 66 + P) * 128 + dk] = run;
      run = __expf(BL[chain * 66 + P]) * run + DN[(chain * 66 + P) * 128 + dk];
    }
  }
}

__device__ __attribute__((always_inline)) void mlstm_b3_item(const Params& p, int l, int b, int head, int P, unsigned char* smem) {
  u16* qS = (u16*)smem;
  u16* kS = (u16*)(smem + 34816);
  u16* pS = (u16*)(smem + 69632);
  float* fb = (float*)(smem + 104448);
  float* lf = fb;
  float* li = fb + 256;
  float* bc = fb + 512;
  float* colsum = fb + 768;
  float* nS = fb + 1280;
  float* nq = fb + 1536;
  float* cfs = fb + 1792;
  float* hsq = fb + 2048;
  const int tid = opaque_tid(), lane = tid & 63, wave = tid >> 6;
  const int r = lane & 31, hh = lane >> 5;
  const int grow0 = chunk_grow0(b, P), key0 = chunk_key0(P);
  const int chainF = (b * 4 + head) * 2, chainB = chainF + 1;
  mlstm_gates(p, l, head, grow0, lf, li);
  __syncthreads();
  if (tid < 256) {
    const int d = tid >> 7, s = tid & 127;
    float bs = 0.f;
    for (int j = 0; j < 128; ++j) {
      const float v = lf[d * 128 + j];
      if (d == 0 ? (j <= s) : (j >= s)) bs += v;
    }
    bc[d * 128 + s] = bs;
    nS[d * 128 + s] = ((const float*)(p.ws + WS_NPREV))[((chainF + d) * 66 + P) * 128 + s];
  }
  {
    const u16* QB = piece(p, P_QB);
    const u16* KB = piece(p, P_KB);
#pragma unroll 1
    for (int i = 0; i < 4; ++i) {
      const int u = tid + NTHR * i;
      const int s = u >> 4, dg = u & 15;
      const bool hasprev = !((P == 0 || P == 2) && s == 0);
      const bool hasnext = !((P == 1 || P == 65) && s == 127);
      float o[8];
      conv8(p, l, QB, grow0 + s, head * 128 + dg * 8, head * 128 + dg * 8, hasprev, hasnext, 1.f, o);
      v4u pk;
      pk[0] = pk2(o[0], o[1]); pk[1] = pk2(o[2], o[3]); pk[2] = pk2(o[4], o[5]); pk[3] = pk2(o[6], o[7]);
      *(v4u*)(qS + s * 136 + dg * 8) = pk;
      conv8(p, l, KB, grow0 + s, head * 128 + dg * 8, 512 + head * 128 + dg * 8, hasprev, hasnext, 0.08838834764831845f, o);
      pk[0] = pk2(o[0], o[1]); pk[1] = pk2(o[2], o[3]); pk[2] = pk2(o[4], o[5]); pk[3] = pk2(o[6], o[7]);
      *(v4u*)(kS + s * 136 + dg * 8) = pk;
    }
  }
  __syncthreads();
  if (tid < 256) {
    const int d = tid >> 7, t = tid & 127;
    float s = 0.f;
    for (int k = 0; k < 128; ++k) s += nS[d * 128 + k] * bf2f(qS[t * 136 + k]);
    nq[d * 128 + t] = s;
  }
  f32x16 Pf[2], Pb[2];
  {
    const int tt = wave & 3, sh = wave >> 2;
    const int t = 32 * tt + r;
    bf16x8 qf[8];
#pragma unroll
    for (int ks = 0; ks < 8; ++ks) qf[ks] = *(const bf16x8*)(qS + t * 136 + 16 * ks + 8 * hh);
    const float bFt = bc[t], bBt = bc[128 + t];
    float csf = 0.f, csb = 0.f;
#pragma unroll
    for (int st2 = 0; st2 < 2; ++st2) {
      const int stile = 2 * sh + st2;
      f32x16 S = zero16();
#pragma unroll
      for (int ks = 0; ks < 8; ++ks) {
        const bf16x8 kf = *(const bf16x8*)(kS + (32 * stile + r) * 136 + 16 * ks + 8 * hh);
        S = mfma32(kf, qf[ks], S);
      }
#pragma unroll
      for (int e = 0; e < 16; ++e) {
        const int s = 32 * stile + (e & 3) + 8 * (e >> 2) + 4 * hh;
        const float raw = S[e];
        const float pf_ = (s <= t) ? raw * __expf(bFt - bc[s] + li[s]) : 0.f;
        const float pb_ = (s >= t) ? raw * __expf(bBt - bc[128 + s] + li[128 + s]) : 0.f;
        Pf[st2][e] = pf_;
        Pb[st2][e] = pb_;
        csf += pf_;
        csb += pb_;
      }
    }
    csf += __shfl_xor(csf, 32, 64);
    csb += __shfl_xor(csb, 32, 64);
    if (hh == 0) {
      colsum[(0 * 2 + sh) * 128 + t] = csf;
      colsum[(1 * 2 + sh) * 128 + t] = csb;
    }
  }
  __syncthreads();
  {
    const int tt = wave & 3, sh = wave >> 2;
    const int t = 32 * tt + r;
    const float eF = __expf(bc[t]), eB = __expf(bc[128 + t]);
    const float denF = eF * nq[t] + colsum[0 * 128 + t] + colsum[1 * 128 + t];
    const float denB = eB * nq[128 + t] + colsum[2 * 128 + t] + colsum[3 * 128 + t];
    const float invF = 1.f / fmaxf(fabsf(denF), 1.f);
    const float invB = 1.f / fmaxf(fabsf(denB), 1.f);
    if (sh == 0 && hh == 0) {
      cfs[t] = eF * invF;
      cfs[128 + t] = eB * invB;
    }
#pragma unroll
    for (int st2 = 0; st2 < 2; ++st2) {
      const int stile = 2 * sh + st2;
#pragma unroll
      for (int g = 0; g < 4; ++g) {
        v2u pk;
        pk[0] = pk2(Pf[st2][4 * g] * invF + Pb[st2][4 * g] * invB, Pf[st2][4 * g + 1] * invF + Pb[st2][4 * g + 1] * invB);
        pk[1] = pk2(Pf[st2][4 * g + 2] * invF + Pb[st2][4 * g + 2] * invB, Pf[st2][4 * g + 3] * invF + Pb[st2][4 * g + 3] * invB);
        const int pos = 32 * stile + 16 * (g >> 1) + 4 * (hh * 2 + (g & 1));
        *(v2u*)(pS + t * 136 + pos) = pk;
      }
    }
  }
  __syncthreads();
  const int dvt = wave & 3, tp = wave >> 2;
  f32x16 hacc[2];
  {
    const u16* VT = piece(p, P_VTB);
    const u16* CST = (const u16*)(p.ws + WS_H);
    f32x16 aP[2], aF[2], aB[2];
#pragma unroll
    for (int t2 = 0; t2 < 2; ++t2) { aP[t2] = zero16(); aF[t2] = zero16(); aB[t2] = zero16(); }
#pragma unroll
    for (int s8 = 0; s8 < 8; ++s8) {
      const bf16x8 vf = *(const bf16x8*)(VT + ((size_t)(b * 512 + head * 128 + 32 * dvt + r)) * NKEY + key0 + 16 * s8 + 8 * hh);
#pragma unroll
      for (int t2 = 0; t2 < 2; ++t2) {
        const bf16x8 pf_ = *(const bf16x8*)(pS + (32 * (2 * tp + t2) + r) * 136 + 16 * s8 + 8 * hh);
        aP[t2] = mfma32(vf, pf_, aP[t2]);
      }
    }
    const u16* cF = CST + ((size_t)(chainF * 66 + P)) * 16384 + (32 * dvt + r) * 128 + 8 * hh;
    const u16* cB = CST + ((size_t)(chainB * 66 + P)) * 16384 + (32 * dvt + r) * 128 + 8 * hh;
#pragma unroll
    for (int ks = 0; ks < 8; ++ks) {
      const bf16x8 f1 = *(const bf16x8*)(cF + 16 * ks);
      const bf16x8 f2 = *(const bf16x8*)(cB + 16 * ks);
#pragma unroll
      for (int t2 = 0; t2 < 2; ++t2) {
        const bf16x8 qf = *(const bf16x8*)(qS + (32 * (2 * tp + t2) + r) * 136 + 16 * ks + 8 * hh);
        aF[t2] = mfma32(f1, qf, aF[t2]);
        aB[t2] = mfma32(f2, qf, aB[t2]);
      }
    }
#pragma unroll
    for (int t2 = 0; t2 < 2; ++t2) {
      const int t = 32 * (2 * tp + t2) + r;
      const float cf = cfs[t], cb = cfs[128 + t];
      float ss = 0.f;
#pragma unroll
      for (int e = 0; e < 16; ++e) {
        const float hv = aP[t2][e] + cf * aF[t2][e] + cb * aB[t2][e];
        hacc[t2][e] = hv;
        ss += hv * hv;
      }
      ss += __shfl_xor(ss, 32, 64);
      if (hh == 0) hsq[dvt * 128 + t] = ss;
    }
  }
  __syncthreads();
  {
    u16* OB = piece(p, P_OB);
    const u16* ZB = piece(p, P_ZB);
    const float* mg = p.ml_g + l * 128;
#pragma unroll
    for (int t2 = 0; t2 < 2; ++t2) {
      const int t = 32 * (2 * tp + t2) + r;
      const float rinv = rsqrtf((hsq[t] + hsq[128 + t] + hsq[256 + t] + hsq[384 + t]) * (1.f / 128.f) + 1e-6f);
#pragma unroll
      for (int g = 0; g < 4; ++g) {
        const int dv0 = 32 * dvt + 8 * g + 4 * hh;
        const size_t off = (size_t)(grow0 + t) * 512 + head * 128 + dv0;
        const v2u ov = *(const v2u*)(OB + off);
        const v2u zv = *(const v2u*)(ZB + off);
        const float y0 = sigmoid_f(bflo(ov[0])) * hacc[t2][4 * g] * rinv * mg[dv0] * silu_f(bflo(zv[0]));
        const float y1 = sigmoid_f(bfhi(ov[0])) * hacc[t2][4 * g + 1] * rinv * mg[dv0 + 1] * silu_f(bfhi(zv[0]));
        const float y2 = sigmoid_f(bflo(ov[1])) * hacc[t2][4 * g + 2] * rinv * mg[dv0 + 2] * silu_f(bflo(zv[1]));
        const float y3 = sigmoid_f(bfhi(ov[1])) * hacc[t2][4 * g + 3] * rinv * mg[dv0 + 3] * silu_f(bfhi(zv[1]));
        v2u o;
        o[0] = pk2(y0, y1);
        o[1] = pk2(y2, y3);
        *(v2u*)(OB + off) = o;
      }
    }
  }
  __syncthreads();
}

__device__ __attribute__((always_inline)) void phase_s3(const Params& p, int l, unsigned char* smem) {
  const int nActx = (l == 0) ? 16 : 0, nCctx = (l == 0) ? 8 : 0;
  if ((gridDim.x & 7) == 0) {
    const int xcd = blockIdx.x & 7, slot = blockIdx.x >> 3, nb = gridDim.x >> 3;
#pragma unroll 1
    for (int q = slot; q < 64 + (nActx >> 3); q += nb) {
      const int b = xcd >> 2, h = xcd & 3;
      if (q < 64) attn_item(p, l, b, h, b * 8192 + q * 128, 0, 132, smem);
      else attn_item(p, l, b, h, 16384 + b * 256 + (q - 64) * 128, 128, 132, smem);
    }
  } else {
#pragma unroll 1
    for (int j = blockIdx.x; j < 512 + nActx; j += gridDim.x) {
      if (j < 512) {
        const int b = j >> 8, h = (j >> 6) & 3, qb = j & 63;
        attn_item(p, l, b, h, b * 8192 + qb * 128, 0, 132, smem);
      } else {
        const int jj = j - 512;
        const int b = jj >> 3, h = (jj >> 1) & 3, qh = jj & 1;
        attn_item(p, l, b, h, 16384 + b * 256 + qh * 128, 128, 132, smem);
      }
    }
  }
#pragma unroll 1
  for (int j = (blockIdx.x + gridDim.x - 32) % gridDim.x; j < 528; j += gridDim.x) {
    const int b = j / 264, rem = j % 264, head = rem / 66, P = rem % 66;
    mlstm_b1_item(p, l, b, head, P, smem);
  }
#pragma unroll 1
  for (int j = (blockIdx.x + gridDim.x - 64) % gridDim.x; j < 256 + nCctx; j += gridDim.x) {
    if (j < 256) natten_item(p, l, j >> 7, j & 127, (j >> 7) * 8192 + (j & 127) * 64, 0, smem);
    else natten_item(p, l, (j - 256) >> 2, 0, 16384 + ((j - 256) >> 2) * 256 + ((j - 256) & 3) * 64, 8, smem);
  }
}

__device__ __attribute__((always_inline)) void h2_rows(const Params& p, int l) {
  const int tid = opaque_tid(), lane = tid & 63, wave = tid >> 6;
  u16* H2 = slotp(p, 3);
  const float* rstd = (const float*)(p.ws + WS_RSTD);
  for (int row = blockIdx.x * 8 + wave; row < R_TOT; row += gridDim.x * 8) {
    const float* xr = xrow(p, l, row);
    const int w = which_of(row);
    const float* gs = (const float*)(p.ws + WS_GS) + w * 1024;
    const float* sh = (const float*)(p.ws + WS_SH) + w * 1024;
    const float rs = rstd[row];
#pragma unroll
    for (int j = 0; j < 4; ++j) {
      const int k = lane * 4 + 256 * j;
      const v4f v = *(const v4f*)(xr + k);
      const v4f g = *(const v4f*)(gs + k);
      const v4f sf = *(const v4f*)(sh + k);
      v2u pk;
      pk[0] = pk2(v[0] * rs * g[0] + sf[0], v[1] * rs * g[1] + sf[1]);
      pk[1] = pk2(v[2] * rs * g[2] + sf[2], v[3] * rs * g[3] + sf[3]);
      *(v2u*)(H2 + (size_t)row * 1024 + k) = pk;
    }
  }
}

__device__ __attribute__((always_inline)) void phase_s5(const Params& p, int l, unsigned char* smem) {
  h2_rows(p, l);
  const int P0 = (l == 0) ? 0 : 2;
  const int nP = 66 - P0;
  for (int it = (blockIdx.x + gridDim.x - 96) % gridDim.x; it < 8 * nP; it += gridDim.x) {
    const int bh = it / nP, P = P0 + it % nP;
    mlstm_b3_item(p, l, bh >> 2, bh & 3, P, smem);
  }
}

__device__ __forceinline__ void s6a_tile(const Params& p, int rt, int ct, unsigned char* smem) {
  const int tid = opaque_tid(), lane = tid & 63, wave = tid >> 6;
  const int wm = wave >> 1, wn = wave & 1, r = lane & 31, hh = lane >> 5;
  const u16* H2 = slotp(p, 3);
  const u16* WTI = (const u16*)(p.ws + WS_WT_IN);
  u16* G = slotp(p, 5);
  const int row0 = rt * 256;
  f32x16 acc[2][2];
  acc[0][0] = zero16(); acc[0][1] = zero16(); acc[1][0] = zero16(); acc[1][1] = zero16();
  gemm_core<0, 2>(acc, H2 + (size_t)row0 * 1024, 1024, nullptr, nullptr, nullptr, nullptr,
                  WTI + (size_t)(6656 + ct * 128) * 1024, 1024, smem);
  u16* Gn = G + (size_t)(ct >> 3) * R_TOT * 1024;
  const int d0 = (ct & 7) * 128 + 64 * wn + r;
#pragma unroll
  for (int i = 0; i < 2; ++i)
#pragma unroll
    for (int e = 0; e < 16; ++e) {
      const int row = row0 + 64 * wm + 32 * i + (e & 3) + 8 * (e >> 2) + 4 * hh;
      u16* rp = Gn + (size_t)row * 1024 + d0;
      asm volatile("" : "+v"(rp));
      rp[0] = f2bf(sigmoid_f(acc[i][0][e]));
      rp[32] = f2bf(sigmoid_f(acc[i][1][e]));
    }
}

__device__ __forceinline__ void s6a_tile256(const Params& p, int rt, int ct, unsigned char* smem) {
  const int tid = opaque_tid(), lane = tid & 63, wave = tid >> 6;
  const int wm = wave >> 1, wn = wave & 1, r = lane & 31, hh = lane >> 5;
  const u16* H2 = slotp(p, 3);
  const u16* WTI = (const u16*)(p.ws + WS_WT_IN);
  u16* G = slotp(p, 5);
  const int row0 = rt * 256;
  f32x16 acc[2][4];
#pragma unroll
  for (int i = 0; i < 2; ++i)
#pragma unroll
    for (int j = 0; j < 4; ++j) acc[i][j] = zero16();
  gemm_core256<1>(acc, H2 + (size_t)row0 * 1024, 1024, WTI + (size_t)(6656 + ct * 256) * 1024, 1024, smem);
  u16* Gn = G + (size_t)(ct >> 2) * R_TOT * 1024;
  const int d0 = (ct & 3) * 256 + 128 * wn + r;
#pragma unroll
  for (int i = 0; i < 2; ++i)
#pragma unroll
    for (int e = 0; e < 16; ++e) {
      const int row = row0 + 64 * wm + 32 * i + (e & 3) + 8 * (e >> 2) + 4 * hh;
      u16* rp = Gn + (size_t)row * 1024 + d0;
      asm volatile("" : "+v"(rp));
#pragma unroll
      for (int j = 0; j < 4; ++j) {
        float v = acc[i][j][e];
        asm volatile("" : "+v"(v));
        rp[32 * j] = f2bf(sigmoid_f(v));
      }
    }
}

__device__ __attribute__((always_inline)) void phase_s6a(const Params& p, int l, unsigned char* smem) {
  {
    const bool xs = (gridDim.x & 7) == 0;
    const int nb = xs ? (gridDim.x >> 3) : gridDim.x;
    const int xcd = xs ? (blockIdx.x & 7) : 0, slot = xs ? (blockIdx.x >> 3) : blockIdx.x;
    const int seg0 = xs ? 96 * xcd : 0, seg1 = xs ? 96 * (xcd + 1) : 768;
#pragma unroll 1
    for (int L = seg0 + slot; L < seg1; L += nb) {
      const int g = L / 96, rem = L % 96;
      s6a_tile256(p, 8 * g + (rem & 7), rem >> 3, smem);
    }
  }
  if (l == 0) {
#pragma unroll 1
    for (int it = blockIdx.x; it < 48; it += gridDim.x) s6a_tile(p, 64 + (it & 1), it >> 1, smem);
  }
}

template <int MI>
__device__ __forceinline__ void s6b_tile(const Params& p, int row0, int ct, unsigned char* smem) {
  const int tid = opaque_tid(), lane = tid & 63, wave = tid >> 6;
  const int wm = wave >> 1, wn = wave & 1, r = lane & 31, hh = lane >> 5;
  const u16* WTB = (const u16*)(p.ws + WS_WT_BR);
  const u16* G = slotp(p, 5);
  u16* M = (u16*)(p.ws + WS_H);
  f32x16 tot[MI][2];
#pragma unroll
  for (int i = 0; i < MI; ++i) { tot[i][0] = zero16(); tot[i][1] = zero16(); }
#pragma unroll 1
  for (int n = 0; n < 3; ++n) {
    f32x16 ap[MI][2];
#pragma unroll
    for (int i = 0; i < MI; ++i) { ap[i][0] = zero16(); ap[i][1] = zero16(); }
    gemm_core<0, MI>(ap, slotp(p, n) + (size_t)row0 * 512, 512, nullptr, nullptr, nullptr, nullptr,
                     WTB + (size_t)(n * 1024 + ct * 128) * 512, 512, smem);
    const u16* Gn = G + (size_t)n * R_TOT * 1024;
#pragma unroll
    for (int i = 0; i < MI; ++i)
#pragma unroll
      for (int e = 0; e < 16; ++e) {
        const int row = row0 + 32 * MI * wm + 32 * i + (e & 3) + 8 * (e >> 2) + 4 * hh;
        const u16* rp = Gn + (size_t)row * 1024 + ct * 128 + 64 * wn + r;
        asm volatile("" : "+v"(rp));
        tot[i][0][e] += bf2f(rp[0]) * ap[i][0][e];
        tot[i][1][e] += bf2f(rp[32]) * ap[i][1][e];
      }
  }
#pragma unroll
  for (int i = 0; i < MI; ++i)
#pragma unroll
    for (int e = 0; e < 16; ++e) {
      const int row = row0 + 32 * MI * wm + 32 * i + (e & 3) + 8 * (e >> 2) + 4 * hh;
      u16* rp = M + (size_t)row * 1024 + ct * 128 + 64 * wn + r;
      asm volatile("" : "+v"(rp));
      rp[0] = f2bf(tot[i][0][e]);
      rp[32] = f2bf(tot[i][1][e]);
    }
}

__device__ __attribute__((always_inline)) void phase_s6b(const Params& p, int l, unsigned char* smem) {
  {
    const bool xs = (gridDim.x & 7) == 0;
    const int nb = xs ? (gridDim.x >> 3) : gridDim.x;
    const int xcd = xs ? (blockIdx.x & 7) : 0, slot = xs ? (blockIdx.x >> 3) : blockIdx.x;
    const int seg0 = xs ? 128 * xcd : 0, seg1 = xs ? 128 * (xcd + 1) : 1024;
#pragma unroll 1
    for (int L = seg0 + slot; L < seg1; L += nb) {
      const int g = L >> 7, rem = L & 127, ct = rem >> 4, rt = 16 * g + (rem & 15);
      s6b_tile<1>(p, rt * 128, ct, smem);
    }
  }
  if (l == 0) {
#pragma unroll 1
    for (int it = blockIdx.x; it < 32; it += gridDim.x) s6b_tile<1>(p, 16384 + (it & 3) * 128, it >> 2, smem);
  }
}

template <int MI>
__device__ __forceinline__ void s7_tile(const Params& p, int l, int row0, int ct, unsigned char* smem) {
  const int tid = opaque_tid(), lane = tid & 63, wave = tid >> 6;
  const int wm = wave >> 1, wn = wave & 1, r = lane & 31, hh = lane >> 5;
  const u16* WTO = (const u16*)(p.ws + WS_WT_OUT);
  const u16* M = (const u16*)(p.ws + WS_H);
  const float* mod = (const float*)(p.ws + WS_MOD) + (size_t)l * 3 * 3072;
  const int w = which_of(row0);
  f32x16 acc[MI][2];
#pragma unroll
  for (int i = 0; i < MI; ++i) { acc[i][0] = zero16(); acc[i][1] = zero16(); }
  gemm_core<0, MI>(acc, M + (size_t)row0 * 1024, 1024, nullptr, nullptr, nullptr, nullptr, WTO + (size_t)(ct * 128) * 1024, 1024, smem);
  const float* xs_ = xrow(p, l, row0);
  float* xd = (row0 < 16384) ? (p.out + (size_t)row0 * 1024) : ((float*)(p.ws + WS_XC) + (size_t)(row0 - 16384) * 1024);
  const int col0 = ct * 128 + 64 * wn + r;
  const float g0 = mod[w * 3072 + 2048 + col0], g1 = mod[w * 3072 + 2048 + col0 + 32];
#pragma unroll
  for (int i = 0; i < MI; ++i)
#pragma unroll
    for (int e = 0; e < 16; ++e) {
      const size_t off = (size_t)(32 * MI * wm + 32 * i + (e & 3) + 8 * (e >> 2) + 4 * hh) * 1024 + col0;
      const float* sp = xs_ + off;
      float* dp = xd + off;
      asm volatile("" : "+v"(sp), "+v"(dp));
      dp[0] = sp[0] + g0 * acc[i][0][e];
      dp[32] = sp[32] + g1 * acc[i][1][e];
    }
}

__device__ __forceinline__ void s7_tile256(const Params& p, int l, int rt, int ct, unsigned char* smem) {
  const int tid = opaque_tid(), lane = tid & 63, wave = tid >> 6;
  const int wm = wave >> 1, wn = wave & 1, r = lane & 31, hh = lane >> 5;
  const u16* WTO = (const u16*)(p.ws + WS_WT_OUT);
  const u16* M = (const u16*)(p.ws + WS_H);
  const float* mod = (const float*)(p.ws + WS_MOD) + (size_t)l * 3 * 3072;
  const int row0 = rt * 256;
  const int w = which_of(row0);
  f32x16 acc[2][4];
#pragma unroll
  for (int i = 0; i < 2; ++i)
#pragma unroll
    for (int j = 0; j < 4; ++j) acc[i][j] = zero16();
  gemm_core256<1>(acc, M + (size_t)row0 * 1024, 1024, WTO + (size_t)(ct * 256) * 1024, 1024, smem);
  const float* xs_ = xrow(p, l, row0);
  float* xd = p.out + (size_t)row0 * 1024;
  const int col0 = ct * 256 + 128 * wn + r;
#pragma unroll
  for (int i = 0; i < 2; ++i)
#pragma unroll
    for (int e = 0; e < 16; ++e) {
      const size_t off = (size_t)(64 * wm + 32 * i + (e & 3) + 8 * (e >> 2) + 4 * hh) * 1024 + col0;
      const float* sp = xs_ + off;
      float* dp = xd + off;
      const float* gp = mod + w * 3072 + 2048 + col0;
      asm volatile("" : "+v"(sp), "+v"(dp), "+v"(gp));
#pragma unroll
      for (int j = 0; j < 4; ++j) {
        float v = acc[i][j][e];
        asm volatile("" : "+v"(v));
        dp[32 * j] = sp[32 * j] + gp[32 * j] * v;
      }
    }
}

__device__ __attribute__((always_inline)) void phase_s7(const Params& p, int l, unsigned char* smem) {
  {
    const bool xs = (gridDim.x & 7) == 0;
    const int nb = xs ? (gridDim.x >> 3) : gridDim.x;
    const int xcd = xs ? (blockIdx.x & 7) : 0, slot = xs ? (blockIdx.x >> 3) : blockIdx.x;
    const int seg0 = xs ? 32 * xcd : 0, seg1 = xs ? 32 * (xcd + 1) : 256;
#pragma unroll 1
    for (int L = seg0 + slot; L < seg1; L += nb) {
      const int g = L >> 5, rem = L & 31;
      s7_tile256(p, l, 8 * g + (rem & 7), rem >> 3, smem);
    }
  }
  if (l == 0) {
#pragma unroll 1
    for (int it = blockIdx.x; it < 32; it += gridDim.x) s7_tile<1>(p, l, 16384 + (it & 3) * 128, it >> 2, smem);
  }
}

__device__ __attribute__((always_inline)) void phase_final(const Params& p) {
  const int tid = threadIdx.x, lane = tid & 63, wave = tid >> 6;
  for (int row = blockIdx.x * 8 + wave; row < 16384; row += gridDim.x * 8) {
    float* xr = p.out + (size_t)row * 1024;
    v4f v[4];
    float ss = 0.f;
#pragma unroll
    for (int j = 0; j < 4; ++j) {
      v[j] = *(const v4f*)(xr + lane * 4 + 256 * j);
      ss += v[j][0] * v[j][0] + v[j][1] * v[j][1] + v[j][2] * v[j][2] + v[j][3] * v[j][3];
    }
    ss = wave_sum(ss);
    const float rs = rsqrtf(ss * (1.f / 1024.f) + 1e-6f);
#pragma unroll
    for (int j = 0; j < 4; ++j) {
      const v4f g = *(const v4f*)(p.final_g + lane * 4 + 256 * j);
      v4f o;
#pragma unroll
      for (int e = 0; e < 4; ++e) o[e] = v[j][e] * rs * g[e];
      *(v4f*)(xr + lane * 4 + 256 * j) = o;
    }
  }
}

#define XB_TMO      128
#define XB_XCNT(j)  (256  + 64 * (j))
#define XB_XSUB(j)  (1280 + 64 * (j))
#define XB_XGEN(j)  (2304 + 64 * (j))
#define XB_TOP      3328
#define XB_TOPGEN   3392
#define XCD_BAR_WORDS 3456
#define XB_SPIN_CAP (1u << 18)
#define LAS __attribute__((address_space(3)))

__device__ __forceinline__ unsigned xb_ld(unsigned* p)              { return __hip_atomic_load(p, __ATOMIC_RELAXED, __HIP_MEMORY_SCOPE_AGENT); }
__device__ __forceinline__ unsigned xb_add(unsigned* p, unsigned v) { return __hip_atomic_fetch_add(p, v, __ATOMIC_RELAXED, __HIP_MEMORY_SCOPE_AGENT); }
__device__ __forceinline__ unsigned xb_xcc_id() { return (unsigned)__builtin_amdgcn_s_getreg((3 << 11) | 20) & 0xFu; }
#define XB_SPIN(cond, bar) do { unsigned _sp = 0; while (cond) { __builtin_amdgcn_s_sleep(1); \
    if ((++_sp & 255u) == 0u) { if (xb_ld(&(bar)[XB_TMO])) break; if (_sp > XB_SPIN_CAP) { atomicAdd(&(bar)[XB_TMO], 1u); break; } } } } while (0)

struct XcdBarrier {
    unsigned* bar; unsigned x;
    volatile LAS unsigned* st;
};

__device__ __forceinline__ XcdBarrier xcd_barrier_post(unsigned* bar, volatile LAS unsigned* st) {
    XcdBarrier b; b.bar = bar; b.x = xb_xcc_id(); b.st = st;
    if (threadIdx.x == 0) (void)xb_add(&bar[XB_XCNT(b.x)], 1u);
    return b;
}
__device__ __forceinline__ void xcd_barrier_complete(unsigned* bar, unsigned x, unsigned& nloc, unsigned& nx) {
    const unsigned G = gridDim.x * gridDim.y * gridDim.z;
    unsigned sum, cnt, mine, sp = 0u;
    for (;;) {
        sum = 0u; cnt = 0u; mine = 0u;
#pragma unroll
        for (unsigned j = 0; j < 16; ++j) { const unsigned c = xb_ld(&bar[XB_XCNT(j)]); sum += c; cnt += (c > 0u) ? 1u : 0u; mine = (j == x) ? c : mine; }
        if (sum == G) break;
        __builtin_amdgcn_s_sleep(1);
        if ((++sp & 255u) == 0u) { if (xb_ld(&bar[XB_TMO])) break; if (sp > XB_SPIN_CAP) { atomicAdd(&bar[XB_TMO], 1u); break; } }
    }
    nloc = mine > 0u ? mine : 1u; nx = cnt > 0u ? cnt : 1u;
}

__device__ __forceinline__ void xcd_barrier(const XcdBarrier& b) {
    asm volatile("s_waitcnt vmcnt(0)" ::: "memory");
    __syncthreads();
    if (threadIdx.x == 0) {
        unsigned* bar = b.bar;
        __builtin_amdgcn_s_waitcnt(0);
        unsigned nloc = b.st[0], nx = b.st[1];
        if (nloc == 0u) { xcd_barrier_complete(bar, b.x, nloc, nx); b.st[0] = nloc; b.st[1] = nx; }
        const unsigned old = xb_add(&bar[XB_XSUB(b.x)], 1u);
        const unsigned gen = old / nloc;
        if (old + 1u == (gen + 1u) * nloc) {
            __builtin_amdgcn_fence(__ATOMIC_RELEASE, "agent");
            asm volatile("s_waitcnt vmcnt(0)" ::: "memory");
            const unsigned og = xb_add(&bar[XB_TOP], 1u);
            const unsigned tg = og / nx;
            if (og + 1u == (tg + 1u) * nx) xb_add(&bar[XB_TOPGEN], 1u);
            else XB_SPIN(xb_ld(&bar[XB_TOPGEN]) == tg, bar);
            __builtin_amdgcn_fence(__ATOMIC_ACQUIRE, "agent");
            xb_add(&bar[XB_XGEN(b.x)], 1u);
            asm volatile("s_waitcnt vmcnt(0)" ::: "memory");
        } else {
            XB_SPIN(xb_ld(&bar[XB_XGEN(b.x)]) == gen, bar);
            __builtin_amdgcn_fence(__ATOMIC_ACQUIRE, "agent");
            asm volatile("s_waitcnt vmcnt(0)" ::: "memory");
        }
    }
    __syncthreads();
}


__global__ void __launch_bounds__(NTHR) fwd_megakernel(Params p) {
  extern __shared__ __attribute__((aligned(16))) unsigned char smem[];
  cg::grid_group grid = cg::this_grid();
  __shared__ uint4 xb_words;
  if (threadIdx.x == 0) xb_words = make_uint4(0u, 0u, 0u, 0u);
  __syncthreads();
  XcdBarrier xbar = xcd_barrier_post((unsigned*)(p.ws + WS_BAR), (volatile LAS unsigned*)&xb_words);
#define PH(k, call)                                  \
  if (p.ph_lo <= (k) && (k) < p.ph_hi) {             \
    call;                                            \
    if ((k) + 1 < p.ph_hi) { if ((k) == 0) grid.sync(); else xcd_barrier(xbar); }  \
  }
  PH(0, phase_s0(p))
  PH(1, phase_s1(p, 0, smem))
  PH(2, phase_s2(p, 0, smem))
  PH(3, phase_s3(p, 0, smem))
  PH(4, phase_b2(p))
  PH(5, phase_s5(p, 0, smem))
  PH(6, phase_s6a(p, 0, smem))
  PH(7, phase_s6b(p, 0, smem))
  PH(8, phase_s7(p, 0, smem))
  PH(9, phase_s1(p, 1, smem))
  PH(10, phase_s2(p, 1, smem))
  PH(11, phase_s3(p, 1, smem))
  PH(12, phase_b2(p))
  PH(13, phase_s5(p, 1, smem))
  PH(14, phase_s6a(p, 1, smem))
  PH(15, phase_s6b(p, 1, smem))
  PH(16, phase_s7(p, 1, smem))
  PH(17, phase_final(p))
#undef PH
}

extern "C" void kernel_launch(void* const* d_in, const int* in_sizes, int n_in, void* d_out, int out_size,
                              void* d_ws, size_t ws_size, hipStream_t stream) {
  static int grid_blocks = 0;
  if (grid_blocks == 0) {
    if (n_in != 19 || ws_size < WS_END) {
      fprintf(stderr, "kernel_launch: unexpected n_in %d or ws_size %zu (< %llu)\n", n_in, ws_size, (unsigned long long)WS_END);
      grid_blocks = -1;
      return;
    }
    int dev = 0, cus = 0, per_cu = 0;
    hipGetDevice(&dev);
    hipDeviceGetAttribute(&cus, hipDeviceAttributeMultiprocessorCount, dev);
    if (hipFuncSetAttribute((const void*)fwd_megakernel, hipFuncAttributeMaxDynamicSharedMemorySize, LDS_BYTES) != hipSuccess) {
      fprintf(stderr, "kernel_launch: hipFuncSetAttribute failed\n");
      grid_blocks = -1;
      return;
    }
    hipOccupancyMaxActiveBlocksPerMultiprocessor(&per_cu, (const void*)fwd_megakernel, NTHR, LDS_BYTES);
    if (per_cu < 1) { fprintf(stderr, "kernel_launch: occupancy query says %d blocks/CU\n", per_cu); per_cu = 1; }
    (void)hipGetLastError();
    grid_blocks = cus;
  }
  if (grid_blocks < 0) return;
  hipMemsetAsync((char*)d_ws + WS_MOD, 0, 73728, stream);
  hipMemsetAsync((char*)d_ws + WS_BAR, 0, 13824, stream);
  Params p{};
  p.x = (const float*)d_in[0]; p.c = (const float*)d_in[1]; p.ctx = (const float*)d_in[2]; p.c_ctx = (const float*)d_in[3];
  p.w_mod = (const float*)d_in[4]; p.b_mod = (const float*)d_in[5]; p.norm_g = (const float*)d_in[6]; p.w_in = (const float*)d_in[7];
  p.lam_q = (const float*)d_in[8]; p.lam_k = (const float*)d_in[9]; p.da_g = (const float*)d_in[10];
  p.conv_w = (const float*)d_in[11]; p.conv_b = (const float*)d_in[12]; p.gate_b = (const float*)d_in[13]; p.ml_g = (const float*)d_in[14];
  p.rpb = (const float*)d_in[15]; p.w_br = (const float*)d_in[16]; p.w_out = (const float*)d_in[17]; p.final_g = (const float*)d_in[18];
  p.out = (float*)d_out; p.ws = (unsigned char*)d_ws;
#if MULTI_LAUNCH
  for (int ph = 0; ph < NPHASE; ++ph) {
    p.ph_lo = ph; p.ph_hi = ph + 1;
    hipLaunchKernelGGL(fwd_megakernel, dim3(grid_blocks), dim3(NTHR), LDS_BYTES, stream, p);
  }
#else
  p.ph_lo = 0; p.ph_hi = NPHASE;
  void* args[] = {&p};
  hipError_t e = hipLaunchCooperativeKernel((void*)fwd_megakernel, dim3(grid_blocks), dim3(NTHR), args, LDS_BYTES, stream);
  if (e != hipSuccess) fprintf(stderr, "cooperative launch failed: %s (grid %d)\n", hipGetErrorString(e), grid_blocks);
#endif
}
```

```cpp
#include <hip/hip_runtime.h>
#include <hip/hip_cooperative_groups.h>
#include <cstdio>
namespace cg = cooperative_groups;

#ifndef MULTI_LAUNCH
#define MULTI_LAUNCH 0
#endif

typedef unsigned short u16;
typedef __attribute__((ext_vector_type(8))) short bf16x8;
typedef __attribute__((ext_vector_type(16))) float f32x16;
typedef __attribute__((ext_vector_type(4))) unsigned int v4u;
typedef __attribute__((ext_vector_type(2))) unsigned int v2u;
typedef __attribute__((ext_vector_type(4))) float v4f;

#define R_TOT 16896
#define NKEY 8448
#define NPAD 9856
#define NTHR 512
#define LDS_BYTES 147456
#define NPHASE 18

#define WS_WT_IN 0ull
#define WS_WT_BR 20185088ull
#define WS_WT_OUT 23330816ull
#define WS_H 25427968ull
#define WS_PIECE 60030976ull
#define PIECE_SZ 17301504ull
#define WS_XC 284950528ull
#define WS_G 287047680ull
#define WS_MOD 288129024ull
#define WS_ROPE 288202752ull
#define WS_RSTD 288219136ull
#define WS_DN 288286720ull
#define WS_NPREV 288827392ull
#define WS_BL 289368064ull
#define WS_GS 289372416ull
#define WS_SH 289384704ull
#define WS_BAR 289396992ull
#define WS_END 289412096ull

enum { P_QA = 0, P_KA, P_VTA, P_ZA, P_QB, P_KB, P_VTB, P_OB, P_ZB, P_QC, P_KC, P_VTC, P_ZC };

struct Params {
  const float *x, *c, *ctx, *c_ctx, *w_mod, *b_mod, *norm_g, *w_in, *lam_q, *lam_k, *da_g,
      *conv_w, *conv_b, *gate_b, *ml_g, *rpb, *w_br, *w_out, *final_g;
  float* out;
  unsigned char* ws;
  int ph_lo, ph_hi;
};

__device__ __forceinline__ int opaque_tid() { int t = threadIdx.x; asm volatile("" : "+v"(t)); return t; }
__device__ __forceinline__ u16 f2bf(float f) {
  unsigned u = __float_as_uint(f);
  u += 0x7fffu + ((u >> 16) & 1u);
  return (u16)(u >> 16);
}
__device__ __forceinline__ float bf2f(u16 h) { return __uint_as_float(((unsigned)h) << 16); }
typedef __attribute__((ext_vector_type(2))) __bf16 bf16x2_t;
typedef __attribute__((ext_vector_type(2))) float f32x2_t;
__device__ __forceinline__ unsigned pk2(float a, float b) { f32x2_t v = {a, b}; bf16x2_t r = __builtin_convertvector(v, bf16x2_t); return __builtin_bit_cast(unsigned, r); }
__device__ __forceinline__ float bflo(unsigned u) { return __uint_as_float(u << 16); }
__device__ __forceinline__ float bfhi(unsigned u) { return __uint_as_float(u & 0xffff0000u); }
__device__ __forceinline__ float silu_f(float x) { return x / (1.f + __expf(-x)); }
__device__ __forceinline__ float sigmoid_f(float x) { return 1.f / (1.f + __expf(-x)); }
__device__ __forceinline__ float ex2(float x) { return __builtin_amdgcn_exp2f(x); }
__device__ __forceinline__ float wave_sum(float v) {
#pragma unroll
  for (int o = 32; o > 0; o >>= 1) v += __shfl_xor(v, o, 64);
  return v;
}
__device__ __forceinline__ f32x16 mfma32(bf16x8 a, bf16x8 b, f32x16 c) {
  return __builtin_amdgcn_mfma_f32_32x32x16_bf16(a, b, c, 0, 0, 0);
}
__device__ __forceinline__ f32x16 zero16() {
  f32x16 z;
#pragma unroll
  for (int i = 0; i < 16; ++i) z[i] = 0.f;
  return z;
}
__device__ __forceinline__ int pslot(int i) { return (int)((0xCBA2918765430ull >> (4 * i)) & 15ull); }
__device__ __forceinline__ u16* piece(const Params& p, int i) { return (u16*)(p.ws + WS_PIECE + (size_t)pslot(i) * PIECE_SZ); }
__device__ __forceinline__ u16* slotp(const Params& p, int sl) { return (u16*)(p.ws + WS_PIECE + (size_t)sl * PIECE_SZ); }
__device__ __forceinline__ const float* xrow(const Params& p, int l, int grow) {
  if (grow < 16384) return (l == 0 ? p.x : (const float*)p.out) + (size_t)grow * 1024;
  return (l == 0 ? p.ctx : (const float*)(p.ws + WS_XC)) + (size_t)(grow - 16384) * 1024;
}
__device__ __forceinline__ int which_of(int grow) { return grow < 8192 ? 0 : (grow < 16384 ? 1 : 2); }
__device__ __forceinline__ int perm16(int s) { return (s & ~15) | (((s >> 2) & 1) << 3) | (((s >> 3) & 1) << 2) | (s & 3); }

__device__ __attribute__((always_inline)) void phase_s0(const Params& p) {
  const int tid = threadIdx.x;
  float* mod = (float*)(p.ws + WS_MOD);
  for (int it = blockIdx.x; it < 2 * 12 * 16; it += gridDim.x) {
    const int l = it / 192, rem = it % 192, nch = rem / 16, kch = rem % 16;
    const int kh = tid >> 8, n = nch * 256 + (tid & 255);
    const int k0 = kch * 64 + kh * 32;
    const float* W = p.w_mod + (size_t)l * 1024 * 3072;
    float a0 = 0.f, a1 = 0.f, a2 = 0.f;
#pragma unroll 8
    for (int k = k0; k < k0 + 32; ++k) {
      const float w = W[(size_t)k * 3072 + n];
      a0 += silu_f(p.c[k]) * w;
      a1 += silu_f(p.c[1024 + k]) * w;
      a2 += silu_f(p.c_ctx[k]) * w;
    }
    if (kch == 0 && kh == 0) {
      const float bb = p.b_mod[l * 3072 + n];
      a0 += bb; a1 += bb; a2 += bb;
    }
    atomicAdd(&mod[(l * 3 + 0) * 3072 + n], a0);
    atomicAdd(&mod[(l * 3 + 1) * 3072 + n], a1);
    atomicAdd(&mod[(l * 3 + 2) * 3072 + n], a2);
  }
  const int gi = blockIdx.x * NTHR + tid;
  if (gi < 2048) {
    const int v = gi >> 4, f = gi & 15;
    const float inv = (float)exp(-(double)f * (9.210340371976184 / 16.0));
    const float angf = (float)v * inv;
    double a = (double)angf;
    const double twopi = 6.283185307179586476925;
    a -= twopi * floor(a / twopi + 0.5);
    const double a2 = a * a;
    double ts = a, tc = 1.0, sn = a, cs = 1.0;
    for (int i = 1; i <= 14; ++i) {
      tc = -tc * a2 / (double)((2 * i - 1) * (2 * i));
      ts = -ts * a2 / (double)((2 * i) * (2 * i + 1));
      cs += tc; sn += ts;
    }
    float* rt = (float*)(p.ws + WS_ROPE);
    rt[gi * 2] = (float)cs;
    rt[gi * 2 + 1] = (float)sn;
  }
}

__device__ __attribute__((always_inline)) void conv_tile(const float* __restrict__ src, int ld, int k0, int col0, int nvalid, bool perm,
                          u16* __restrict__ dst, int ldd, int n0, unsigned char* smem) {
  u16* t = (u16*)smem;
  const int tid = opaque_tid();
#pragma unroll
  for (int i = 0; i < 2; ++i) {
    const int idx = tid + NTHR * i;
    const int kk = idx >> 4, c4 = idx & 15;
    v4f v = {0.f, 0.f, 0.f, 0.f};
    if (4 * c4 < nvalid) v = *(const v4f*)(src + (size_t)(k0 + kk) * ld + col0 + 4 * c4);
#pragma unroll
    for (int e = 0; e < 4; ++e) {
      const int j = 4 * c4 + e;
      const int jp = perm ? ((j & 1) ? 32 + (j >> 1) : (j >> 1)) : j;
      t[jp * 72 + kk] = f2bf(v[e]);
    }
  }
  __syncthreads();
  {
    const int n = tid >> 3, ch = tid & 7;
    const v4u v = *(const v4u*)(t + n * 72 + ch * 8);
    *(v4u*)(dst + (size_t)(n0 + n) * ldd + k0 + ch * 8) = v;
  }
  __syncthreads();
}

__device__ __attribute__((always_inline)) void phase_s1(const Params& p, int l, unsigned char* smem) {
  const int tid = threadIdx.x, lane = tid & 63, wave = tid >> 6;
  const float* mod = (const float*)(p.ws + WS_MOD) + (size_t)l * 3 * 3072;
  const float* g = p.norm_g + l * 1024;
  u16* H = (u16*)(p.ws + WS_H);
  float* rstd = (float*)(p.ws + WS_RSTD);
  if (blockIdx.x == 0) {
    float* gs = (float*)(p.ws + WS_GS);
    float* sh = (float*)(p.ws + WS_SH);
    for (int i = tid; i < 3072; i += NTHR) {
      const int w = i >> 10, k = i & 1023;
      gs[i] = g[k] * (1.f + mod[w * 3072 + 1024 + k]);
      sh[i] = mod[w * 3072 + k];
    }
  }
  for (int row = blockIdx.x * 8 + wave; row < R_TOT; row += gridDim.x * 8) {
    const float* xr = xrow(p, l, row);
    const int w = which_of(row);
    v4f v[4];
    float ss = 0.f;
#pragma unroll
    for (int j = 0; j < 4; ++j) {
      v[j] = *(const v4f*)(xr + lane * 4 + 256 * j);
      ss += v[j][0] * v[j][0] + v[j][1] * v[j][1] + v[j][2] * v[j][2] + v[j][3] * v[j][3];
    }
    ss = wave_sum(ss);
    const float rs = rsqrtf(ss * (1.f / 1024.f) + 1e-6f);
    if (lane == 0) rstd[row] = rs;
#pragma unroll
    for (int j = 0; j < 4; ++j) {
      const int k = lane * 4 + 256 * j;
      const v4f gg = *(const v4f*)(g + k);
      const v4f sc = *(const v4f*)(mod + w * 3072 + 1024 + k);
      const v4f sf = *(const v4f*)(mod + w * 3072 + k);
      float o[4];
#pragma unroll
      for (int e = 0; e < 4; ++e) o[e] = v[j][e] * rs * gg[e] * (1.f + sc[e]) + sf[e];
      v2u pk;
      pk[0] = pk2(o[0], o[1]);
      pk[1] = pk2(o[2], o[3]);
      *(v2u*)(H + (size_t)row * 1024 + k) = pk;
    }
  }
  u16* WTI = (u16*)(p.ws + WS_WT_IN);
  u16* WTB = (u16*)(p.ws + WS_WT_BR);
  u16* WTO = (u16*)(p.ws + WS_WT_OUT);
  const float* win = p.w_in + (size_t)l * 1024 * 9744;
  u16* t = (u16*)smem;
#pragma unroll 1
  for (int it2 = blockIdx.x; it2 < (2464 + 384 + 256) / 2; it2 += gridDim.x) {
    v4f v[2][2];
    bool permv[2];
    u16* dstv[2];
    int lddv[2], n0v[2], k0v[2];
#pragma unroll
    for (int h2 = 0; h2 < 2; ++h2) {
      const int it = 2 * it2 + h2;
      const float* src; int ld, k0, col0, nvalid = 64; bool perm = false; u16* dst; int ldd, n0;
      if (it < 2464) {
        const int nb = it % 154, kb = it / 154;
        n0 = nb * 64; col0 = n0; perm = n0 < 1024;
        if (n0 >= 4608 && n0 < 9728) col0 = n0 + 16;
        else if (n0 == 9728) { col0 = 4608; nvalid = 16; }
        else if (n0 > 9728) { col0 = 0; nvalid = 0; }
        src = win; ld = 9744; k0 = kb * 64; dst = WTI; ldd = 1024;
      } else if (it < 2464 + 384) {
        const int j = it - 2464;
        const int n = j / 128, rr = j % 128, db = rr / 8, wb = rr % 8;
        src = p.w_br + ((size_t)l * 3 + n) * 512 * 1024; ld = 1024; k0 = wb * 64; col0 = db * 64;
        dst = WTB + (size_t)n * 1024 * 512; ldd = 512; n0 = db * 64;
      } else {
        const int j = it - 2464 - 384;
        const int db = j / 16, kb = j % 16;
        src = p.w_out + (size_t)l * 1024 * 1024; ld = 1024; k0 = kb * 64; col0 = db * 64;
        dst = WTO; ldd = 1024; n0 = db * 64;
      }
#pragma unroll
      for (int i = 0; i < 2; ++i) {
        const int idx = tid + NTHR * i;
        const int kk = idx >> 4, c4 = idx & 15;
        v4f z = {0.f, 0.f, 0.f, 0.f};
        v[h2][i] = (4 * c4 < nvalid) ? *(const v4f*)(src + (size_t)(k0 + kk) * ld + col0 + 4 * c4) : z;
      }
      permv[h2] = perm; dstv[h2] = dst; lddv[h2] = ldd; n0v[h2] = n0; k0v[h2] = k0;
    }
#pragma unroll
    for (int h2 = 0; h2 < 2; ++h2)
#pragma unroll
      for (int i = 0; i < 2; ++i) {
        const int idx = tid + NTHR * i;
        const int kk = idx >> 4, c4 = idx & 15;
#pragma unroll
        for (int e = 0; e < 4; ++e) {
          const int j = 4 * c4 + e;
          const int jp = permv[h2] ? ((j & 1) ? 32 + (j >> 1) : (j >> 1)) : j;
          t[h2 * 64 * 72 + jp * 72 + kk] = f2bf(v[h2][i][e]);
        }
      }
    __syncthreads();
#pragma unroll
    for (int h2 = 0; h2 < 2; ++h2) {
      const int n = tid >> 3, ch = tid & 7;
      const v4u vv = *(const v4u*)(t + h2 * 64 * 72 + n * 72 + ch * 8);
      *(v4u*)(dstv[h2] + (size_t)(n0v[h2] + n) * lddv[h2] + k0v[h2] + ch * 8) = vv;
    }
    __syncthreads();
  }
}

template <int AMODE, int MI>
__device__ __forceinline__ void gemm_core(f32x16 (&acc)[MI][2], const u16* __restrict__ A, int lda,
                                          const float* __restrict__ Ax, const float* __restrict__ rstd,
                                          const float* __restrict__ gs, const float* __restrict__ sh,
                                          const u16* __restrict__ B, int K, unsigned char* smem) {
  constexpr int AROWS = 128 * MI;
  u16* As = (u16*)smem;
  u16* Bs = (u16*)(smem + 73728);
  const int tid = opaque_tid(), lane = tid & 63, wave = tid >> 6;
  const int wm = wave >> 1, wn = wave & 1, r = lane & 31, hh = lane >> 5;
  const int lrow = tid >> 3, c8 = tid & 7;
  v4u ra[2][2 * MI], rb[2][2];
  float rs4[2 * MI];
  if (AMODE == 1) {
#pragma unroll
    for (int i = 0; i < 2 * MI; ++i) rs4[i] = rstd[lrow + 64 * i];
  }
  const int KT = K >> 6;
#define GEMM_LOAD(set, k0)                                                                        \
  {                                                                                               \
    if (AMODE == 0) {                                                                             \
      _Pragma("unroll") for (int i = 0; i < 2 * MI; ++i)                                          \
        ra[set][i] = *(const v4u*)(A + (size_t)(lrow + 64 * i) * lda + (k0) + c8 * 8);            \
    } else {                                                                                      \
      const v4f g0 = *(const v4f*)(gs + (k0) + c8 * 8), g1 = *(const v4f*)(gs + (k0) + c8 * 8 + 4); \
      const v4f s0 = *(const v4f*)(sh + (k0) + c8 * 8), s1 = *(const v4f*)(sh + (k0) + c8 * 8 + 4); \
      _Pragma("unroll") for (int i = 0; i < 2 * MI; ++i) {                                        \
        const float* xp = Ax + (size_t)(lrow + 64 * i) * 1024 + (k0) + c8 * 8;                    \
        const v4f x0 = *(const v4f*)xp, x1 = *(const v4f*)(xp + 4);                               \
        const float rr = rs4[i];                                                                  \
        ra[set][i][0] = pk2(x0[0] * rr * g0[0] + s0[0], x0[1] * rr * g0[1] + s0[1]);              \
        ra[set][i][1] = pk2(x0[2] * rr * g0[2] + s0[2], x0[3] * rr * g0[3] + s0[3]);              \
        ra[set][i][2] = pk2(x1[0] * rr * g1[0] + s1[0], x1[1] * rr * g1[1] + s1[1]);              \
        ra[set][i][3] = pk2(x1[2] * rr * g1[2] + s1[2], x1[3] * rr * g1[3] + s1[3]);              \
      }                                                                                           \
    }                                                                                             \
    _Pragma("unroll") for (int i = 0; i < 2; ++i)                                                 \
        rb[set][i] = *(const v4u*)(B + (size_t)(lrow + 64 * i) * K + (k0) + c8 * 8);              \
  }
#define GEMM_STORE(set, buf)                                                                      \
  {                                                                                               \
    _Pragma("unroll") for (int i = 0; i < 2 * MI; ++i)                                            \
        *(v4u*)(As + (buf) * AROWS * 72 + (lrow + 64 * i) * 72 + c8 * 8) = ra[set][i];            \
    _Pragma("unroll") for (int i = 0; i < 2; ++i)                                                 \
        *(v4u*)(Bs + (buf) * 128 * 72 + (lrow + 64 * i) * 72 + c8 * 8) = rb[set][i];              \
  }
#define GEMM_COMPUTE(cur)                                                                         \
  {                                                                                               \
    const u16* Ab = As + (cur) * AROWS * 72 + (32 * MI * wm + r) * 72 + 8 * hh;                   \
    const u16* Bb = Bs + (cur) * 128 * 72 + (64 * wn + r) * 72 + 8 * hh;                          \
    _Pragma("unroll") for (int ks = 0; ks < 4; ++ks) {                                            \
      const bf16x8 b0 = *(const bf16x8*)(Bb + ks * 16);                                           \
      const bf16x8 b1 = *(const bf16x8*)(Bb + 32 * 72 + ks * 16);                                 \
      _Pragma("unroll") for (int i = 0; i < MI; ++i) {                                            \
        const bf16x8 a0 = *(const bf16x8*)(Ab + i * 32 * 72 + ks * 16);                           \
        acc[i][0] = mfma32(a0, b0, acc[i][0]);                                                    \
        acc[i][1] = mfma32(a0, b1, acc[i][1]);                                                    \
      }                                                                                           \
    }                                                                                             \
  }
  GEMM_LOAD(0, 0);
  GEMM_LOAD(1, 64);
  GEMM_STORE(0, 0);
  __syncthreads();
  for (int kt = 0; kt < KT; kt += 2) {
    if (kt + 2 < KT) GEMM_LOAD(0, (kt + 2) * 64);
    GEMM_COMPUTE(0);
    GEMM_STORE(1, 1);
    __syncthreads();
    if (kt + 3 < KT) GEMM_LOAD(1, (kt + 3) * 64);
    GEMM_COMPUTE(1);
    if (kt + 2 < KT) GEMM_STORE(0, 0);
    __syncthreads();
  }
#undef GEMM_COMPUTE
#undef GEMM_LOAD
#undef GEMM_STORE
}

template <int LEAN>
__device__ __forceinline__ void gemm_core256(f32x16 (&acc)[2][4], const u16* __restrict__ A, int lda,
                                             const u16* __restrict__ B, int K, unsigned char* smem) {
  u16* As = (u16*)smem;
  u16* Bs = (u16*)(smem + 73728);
  const int tid = opaque_tid(), lane = tid & 63, wave = tid >> 6;
  const int wm = wave >> 1, wn = wave & 1, r = lane & 31, hh = lane >> 5;
  const int lrow = tid >> 3, c8 = tid & 7;
  v4u ra[4], rb[4];
  const int KT = K >> 6;
#define G2_LOAD(k0)                                                                               \
  {                                                                                               \
    _Pragma("unroll") for (int i = 0; i < 4; ++i) {                                               \
      ra[i] = *(const v4u*)(A + (size_t)(lrow + 64 * i) * lda + (k0) + c8 * 8);                   \
      rb[i] = *(const v4u*)(B + (size_t)(lrow + 64 * i) * K + (k0) + c8 * 8);                     \
    }                                                                                             \
  }
#define G2_STORE(buf)                                                                             \
  {                                                                                               \
    _Pragma("unroll") for (int i = 0; i < 4; ++i) {                                               \
      *(v4u*)(As + (buf) * 256 * 72 + (lrow + 64 * i) * 72 + c8 * 8) = ra[i];                     \
      *(v4u*)(Bs + (buf) * 256 * 72 + (lrow + 64 * i) * 72 + c8 * 8) = rb[i];                     \
    }                                                                                             \
  }
  G2_LOAD(0);
  G2_STORE(0);
  __syncthreads();
  if (KT > 1) G2_LOAD(64);
  for (int kt = 0; kt < KT; ++kt) {
    const int cur = kt & 1;
    const u16* Ab = As + cur * 256 * 72 + (64 * wm + r) * 72 + 8 * hh;
    const u16* Bb = Bs + cur * 256 * 72 + (128 * wn + r) * 72 + 8 * hh;
#pragma unroll
    for (int ks = 0; ks < 4; ++ks) {
      if (LEAN) __builtin_amdgcn_sched_barrier(0);
      const bf16x8 a0 = *(const bf16x8*)(Ab + ks * 16);
      const bf16x8 a1 = *(const bf16x8*)(Ab + 32 * 72 + ks * 16);
#pragma unroll
      for (int j = 0; j < 4; ++j) {
        const bf16x8 b0 = *(const bf16x8*)(Bb + j * 32 * 72 + ks * 16);
        acc[0][j] = mfma32(a0, b0, acc[0][j]);
        acc[1][j] = mfma32(a1, b0, acc[1][j]);
      }
    }
    if (kt + 1 < KT) {
      G2_STORE(cur ^ 1);
      if (kt + 2 < KT) G2_LOAD((kt + 2) * 64);
    }
    __syncthreads();
  }
#undef G2_LOAD
#undef G2_STORE
}

__device__ __forceinline__ void s2_store64(const Params& p, int grp, const f32x16& a0, const f32x16& a1, int rowbase, int fb64,
                                           bool latent, int b, int keyb, int r, int hh, const float* __restrict__ rope) {
  if (grp == P_VTA || grp == P_VTB || grp == P_VTC) {
    u16* VT = piece(p, grp);
#pragma unroll
    for (int j = 0; j < 2; ++j) {
      const int f = fb64 + 32 * j + r;
#pragma unroll
      for (int q = 0; q < 4; ++q) {
        const int key = keyb + 16 * (q >> 1) + 4 * (hh * 2 + (q & 1));
        v2u pk;
        if (j == 0) { pk[0] = pk2(a0[4 * q], a0[4 * q + 1]); pk[1] = pk2(a0[4 * q + 2], a0[4 * q + 3]); }
        else { pk[0] = pk2(a1[4 * q], a1[4 * q + 1]); pk[1] = pk2(a1[4 * q + 2], a1[4 * q + 3]); }
        *(v2u*)(VT + ((size_t)(b * 512 + f)) * NKEY + key) = pk;
      }
    }
  } else {
    u16* D = piece(p, grp);
    const bool rot = latent && (grp == P_QA || grp == P_KA);
    const float qs = (grp == P_QA || grp == P_QC) ? 0.18033688011112042f : 1.f;
#pragma unroll
    for (int e = 0; e < 16; ++e) {
      const int row = rowbase + (e & 3) + 8 * (e >> 2) + 4 * hh;
      float v0 = a0[e], v1 = a1[e];
      if (rot) {
        const int t = row & 8191;
        const int vv = (r < 16) ? (t >> 6) : (t & 63);
        const float cs = rope[(vv * 16 + (r & 15)) * 2], sn = rope[(vv * 16 + (r & 15)) * 2 + 1];
        const float o0 = v0 * cs - v1 * sn, o1 = v0 * sn + v1 * cs;
        v0 = o0; v1 = o1;
      }
      D[(size_t)row * 512 + fb64 + r] = f2bf(v0 * qs);
      D[(size_t)row * 512 + fb64 + 32 + r] = f2bf(v1 * qs);
    }
  }
}

__device__ __attribute__((always_inline)) void phase_s2(const Params& p, int l, unsigned char* smem) {
  const int tid = opaque_tid(), lane = tid & 63, wave = tid >> 6;
  const int wm = wave >> 1, wn = wave & 1, r = lane & 31, hh = lane >> 5;
  const u16* H = (const u16*)(p.ws + WS_H);
  const u16* WTI = (const u16*)(p.ws + WS_WT_IN);
  const float* rope = (const float*)(p.ws + WS_ROPE);
  float* G = (float*)(p.ws + WS_G);
  {
    const bool xs = (gridDim.x & 7) == 0;
    const int nb = xs ? (gridDim.x >> 3) : gridDim.x;
    const int xcd = xs ? (blockIdx.x & 7) : 0, slot = xs ? (blockIdx.x >> 3) : blockIdx.x;
    const int nx = xs ? 8 : 1;
    const int seg0 = (1716 * xcd) / nx, seg1 = (1716 * (xcd + 1)) / nx;
#pragma unroll 1
    for (int L = seg0 + slot; L < seg1; L += nb) {
      int rt, ct;
      if (L < 1664) { const int g = L / 208, rem = L % 208; ct = rem >> 3; rt = 8 * g + (rem & 7); }
      else { const int rem = L - 1664; ct = rem >> 1; rt = 64 + (rem & 1); }
      const int row0 = rt * 256, n0 = ct * 256;
      f32x16 acc[2][4];
#pragma unroll
      for (int i = 0; i < 2; ++i)
#pragma unroll
        for (int j = 0; j < 4; ++j) acc[i][j] = zero16();
      gemm_core256<0>(acc, H + (size_t)row0 * 1024, 1024, WTI + (size_t)n0 * 1024, 1024, smem);
      const bool latent = row0 < 16384;
      const int b = latent ? (row0 >> 13) : ((row0 - 16384) >> 8);
      const int keybase = latent ? (row0 & 8191) : 8192;
      const int grp = n0 >> 9;
      const int fbase = (n0 & 511) + 128 * wn;
#pragma unroll
      for (int i = 0; i < 2; ++i)
#pragma unroll
        for (int g2 = 0; g2 < 2; ++g2)
          s2_store64(p, grp, acc[i][2 * g2], acc[i][2 * g2 + 1], row0 + 64 * wm + 32 * i, fbase + 64 * g2, latent, b,
                     keybase + 64 * wm + 32 * i, r, hh, rope);
    }
  }
#pragma unroll 1
  for (int rt = blockIdx.x; rt < 66; rt += gridDim.x) {
    const int row0 = rt * 256;
    f32x16 acc[2][2];
    acc[0][0] = zero16(); acc[0][1] = zero16(); acc[1][0] = zero16(); acc[1][1] = zero16();
    gemm_core<0, 2>(acc, H + (size_t)row0 * 1024, 1024, nullptr, nullptr, nullptr, nullptr, WTI + (size_t)9728 * 1024, 1024, smem);
    if (wn == 0) {
#pragma unroll
      for (int i = 0; i < 2; ++i)
#pragma unroll
        for (int e = 0; e < 16; ++e) {
          const int row = row0 + 64 * wm + 32 * i + (e & 3) + 8 * (e >> 2) + 4 * hh;
          if (r < 16) G[(size_t)row * 16 + r] = acc[i][0][e];
        }
    }
  }
}

__device__ __attribute__((always_inline)) void attn_item(const Params& p, int l, int b, int h, int qgrow0, int kt0, int kt1, unsigned char* smem) {
  u16* Ks = (u16*)smem;
  u16* Vs = (u16*)(smem + 34816);
  const int tid = opaque_tid(), lane = tid & 63, wave = tid >> 6;
  const int c = wave & 1, qg = wave >> 1, r = lane & 31, hh = lane >> 5;
  u16* QA = piece(p, P_QA);
  const u16* KA = piece(p, P_KA);
  const u16* VT = piece(p, P_VTA);
  const u16* ZA = piece(p, P_ZA);
  const float lam_init = 0.8f - 0.6f * expf(-0.3f * (float)l);
  float lam;
  {
    const float* lq = p.lam_q + l * 128;
    const float* lk = p.lam_k + l * 128;
    const float s0 = wave_sum(lq[lane] * lk[lane]);
    const float s1 = wave_sum(lq[64 + lane] * lk[64 + lane]);
    lam = expf(s0) - expf(s1) + lam_init;
  }
  const int qrow = qgrow0 + qg * 32 + r;
  bf16x8 qf[4];
#pragma unroll
  for (int ks = 0; ks < 4; ++ks) qf[ks] = *(const bf16x8*)(QA + (size_t)qrow * 512 + h * 128 + c * 64 + ks * 16 + hh * 8);
  f32x16 O[4];
#pragma unroll
  for (int i = 0; i < 4; ++i) O[i] = zero16();
  float m = -1e30f, lsum = 0.f;
  const int krow_l = tid >> 4, kc16 = tid & 15;
  const int vrow_l = tid >> 3, vc8 = tid & 7;
  v4u rk[2], rv[2];
#define ATT_LOADK(kt)                                                                             \
  {                                                                                               \
    const int key0 = (kt) * 64;                                                                   \
    const int gbase = (key0 < 8192) ? (b * 8192 + key0) : (16384 + b * 256 + key0 - 8192);        \
    _Pragma("unroll") for (int i = 0; i < 2; ++i)                                                 \
      rk[i] = *(const v4u*)(KA + (size_t)(gbase + krow_l + 32 * i) * 512 + h * 128 + kc16 * 8);   \
  }
#define ATT_LOADV(kt)                                                                             \
  {                                                                                               \
    const int key0 = (kt) * 64;                                                                   \
    _Pragma("unroll") for (int i = 0; i < 2; ++i)                                                 \
      rv[i] = *(const v4u*)(VT + ((size_t)(b * 512 + h * 128 + vrow_l + 64 * i)) * NKEY + key0 + vc8 * 8); \
  }
#define ATT_STOREK(buf)                                                                           \
  {                                                                                               \
    _Pragma("unroll") for (int i = 0; i < 2; ++i)                                                 \
      *(v4u*)(Ks + (buf) * 64 * 136 + (krow_l + 32 * i) * 136 + kc16 * 8) = rk[i];                \
  }
#define ATT_STOREV(buf)                                                                           \
  {                                                                                               \
    _Pragma("unroll") for (int i = 0; i < 2; ++i)                                                 \
      *(v4u*)(Vs + (buf) * 128 * 72 + (vrow_l + 64 * i) * 72 + vc8 * 8) = rv[i];                  \
  }
#define ATT_QK(Sx, buf)                                                                           \
  {                                                                                               \
    _Pragma("unroll") for (int kk = 0; kk < 2; ++kk) {                                            \
      Sx[kk] = zero16();                                                                          \
      _Pragma("unroll") for (int ks = 0; ks < 4; ++ks) {                                          \
        const bf16x8 kf = *(const bf16x8*)(Ks + (buf) * 64 * 136 + (32 * kk + r) * 136 + c * 64 + ks * 16 + hh * 8); \
        Sx[kk] = mfma32(kf, qf[ks], Sx[kk]);                                                      \
      }                                                                                           \
    }                                                                                             \
  }
  ATT_LOADK(kt0);
  ATT_LOADV(kt0);
  ATT_STOREK(0);
  ATT_STOREV(0);
  if (kt0 + 1 < kt1) { ATT_LOADK(kt0 + 1); ATT_STOREK(1); }
  __syncthreads();
  f32x16 S[2], Sn[2];
  ATT_QK(S, 0);
  if (kt0 + 2 < kt1) ATT_LOADK(kt0 + 2);
  if (kt0 + 1 < kt1) ATT_LOADV(kt0 + 1);
  for (int kt = kt0; kt < kt1; ++kt) {
    const int cur = (kt - kt0) & 1;
    if (kt + 1 < kt1) ATT_QK(Sn, cur ^ 1);
    float mx = -1e30f;
#pragma unroll
    for (int kk = 0; kk < 2; ++kk)
#pragma unroll
      for (int e = 0; e < 16; ++e) mx = fmaxf(mx, S[kk][e]);
    mx = fmaxf(mx, __shfl_xor(mx, 32, 64));
    const float mnew = fmaxf(m, mx);
    if (__builtin_amdgcn_ballot_w64(mnew > m) != 0ull) {
      const float alpha = ex2(m - mnew);
      lsum *= alpha;
#pragma unroll
      for (int i = 0; i < 4; ++i)
#pragma unroll
        for (int e = 0; e < 16; ++e) O[i][e] *= alpha;
    }
    m = mnew;
    bf16x8 pf[4];
#pragma unroll
    for (int kk = 0; kk < 2; ++kk)
#pragma unroll
      for (int s2 = 0; s2 < 2; ++s2) {
        v4u pkd;
#pragma unroll
        for (int jj = 0; jj < 4; ++jj) {
          const float p0 = ex2(S[kk][8 * s2 + 2 * jj] - mnew);
          const float p1 = ex2(S[kk][8 * s2 + 2 * jj + 1] - mnew);
          lsum += p0 + p1;
          pkd[jj] = pk2(p0, p1);
        }
        pf[2 * kk + s2] = (bf16x8)pkd;
      }
#pragma unroll
    for (int dvt = 0; dvt < 4; ++dvt)
#pragma unroll
      for (int s = 0; s < 4; ++s) {
        const bf16x8 vf = *(const bf16x8*)(Vs + cur * 128 * 72 + (32 * dvt + r) * 72 + 16 * s + 8 * hh);
        O[dvt] = mfma32(vf, pf[s], O[dvt]);
      }
    if (kt + 2 < kt1) ATT_STOREK(cur);
    if (kt + 1 < kt1) ATT_STOREV(cur ^ 1);
    if (kt + 3 < kt1) ATT_LOADK(kt + 3);
    if (kt + 2 < kt1) ATT_LOADV(kt + 2);
    __syncthreads();
    S[0] = Sn[0];
    S[1] = Sn[1];
  }
#undef ATT_LOADK
#undef ATT_LOADV
#undef ATT_STOREK
#undef ATT_STOREV
#undef ATT_QK
  const float ltot = lsum + __shfl_xor(lsum, 32, 64);
  const float inv = 1.f / ltot;
  float* X = (float*)smem;
  if (c == 1) {
#pragma unroll
    for (int dvt = 0; dvt < 4; ++dvt)
#pragma unroll
      for (int e = 0; e < 16; ++e) X[(qg * 128 + 32 * dvt + (e & 3) + 8 * (e >> 2) + 4 * hh) * 32 + r] = O[dvt][e] * inv;
  }
  __syncthreads();
  if (c == 0) {
    float ss = 0.f;
#pragma unroll
    for (int dvt = 0; dvt < 4; ++dvt)
#pragma unroll
      for (int e = 0; e < 16; ++e) {
        const float o = O[dvt][e] * inv - lam * X[(qg * 128 + 32 * dvt + (e & 3) + 8 * (e >> 2) + 4 * hh) * 32 + r];
        O[dvt][e] = o;
        ss += o * o;
      }
    ss += __shfl_xor(ss, 32, 64);
    const float rinv = rsqrtf(ss * (1.f / 128.f) + 1e-6f) * (1.f - lam_init);
    const float* dg = p.da_g + l * 128;
#pragma unroll
    for (int dvt = 0; dvt < 4; ++dvt)
#pragma unroll
      for (int g = 0; g < 4; ++g) {
        const int dv0 = 32 * dvt + 8 * g + 4 * hh;
        const size_t off = (size_t)qrow * 512 + h * 128 + dv0;
        const v2u z = *(const v2u*)(ZA + off);
        const float y0 = O[dvt][4 * g] * rinv * dg[dv0] * silu_f(bflo(z[0]));
        const float y1 = O[dvt][4 * g + 1] * rinv * dg[dv0 + 1] * silu_f(bfhi(z[0]));
        const float y2 = O[dvt][4 * g + 2] * rinv * dg[dv0 + 2] * silu_f(bflo(z[1]));
        const float y3 = O[dvt][4 * g + 3] * rinv * dg[dv0 + 3] * silu_f(bfhi(z[1]));
        v2u o;
        o[0] = pk2(y0, y1);
        o[1] = pk2(y2, y3);
        *(v2u*)(QA + off) = o;
      }
  }
  __syncthreads();
}

__device__ __attribute__((always_inline)) void natten_item(const Params& p, int l, int b, int rr, int qgrow, int i0, unsigned char* smem) {
  float* rp = (float*)smem;
  const int tid = opaque_tid(), lane = tid & 63, head = tid >> 6;
  const int r = lane & 31, hh = lane >> 5;
  for (int i = tid; i < 3720; i += NTHR) rp[i] = p.rpb[(size_t)l * 3720 + i];
  __syncthreads();
  u16* QC = piece(p, P_QC);
  const u16* KC = piece(p, P_KC);
  const u16* VT = piece(p, P_VTC);
  const u16* ZC = piece(p, P_ZC);
  const int rs = min(max(rr - 4, 0), 120);
  bf16x8 qf[2][4];
#pragma unroll
  for (int qt = 0; qt < 2; ++qt)
#pragma unroll
    for (int ks = 0; ks < 4; ++ks)
      qf[qt][ks] = *(const bf16x8*)(QC + (size_t)(qgrow + 32 * qt + r) * 512 + head * 64 + ks * 16 + hh * 8);
  f32x16 O[2][2];
  O[0][0] = zero16(); O[0][1] = zero16(); O[1][0] = zero16(); O[1][1] = zero16();
  float m[2] = {-1e30f, -1e30f}, lsum[2] = {0.f, 0.f};
  const float L2E = 1.4426950408889634f;
  for (int i = i0; i < 12; ++i) {
    const bool local = i < 8;
    const int krow = rs + i;
    const int kg0 = local ? (b * 8192 + krow * 64) : (16384 + b * 256 + (i - 8) * 64);
    const int key0 = local ? krow * 64 : 8192 + (i - 8) * 64;
    f32x16 S[2][2];
    S[0][0] = zero16(); S[0][1] = zero16(); S[1][0] = zero16(); S[1][1] = zero16();
#pragma unroll
    for (int kk = 0; kk < 2; ++kk)
#pragma unroll
      for (int ks = 0; ks < 4; ++ks) {
        const bf16x8 kf = *(const bf16x8*)(KC + (size_t)(kg0 + 32 * kk + r) * 512 + head * 64 + ks * 16 + hh * 8);
        S[kk][0] = mfma32(kf, qf[0][ks], S[kk][0]);
        S[kk][1] = mfma32(kf, qf[1][ks], S[kk][1]);
      }
    bf16x8 pf[2][4];
#pragma unroll
    for (int qt = 0; qt < 2; ++qt) {
      const int qcol = 32 * qt + r;
      const int cs = min(max(qcol - 8, 0), 48);
      const float* rprow = rp + (head * 15 + (local ? (krow - rr + 7) : 0)) * 31 + 15 - qcol;
      float mx = -1e30f;
#pragma unroll
      for (int kk = 0; kk < 2; ++kk)
#pragma unroll
        for (int e = 0; e < 16; ++e) {
          const int kcol = 32 * kk + (e & 3) + 8 * (e >> 2) + 4 * hh;
          float s = S[kk][qt][e];
          if (local) {
            const bool valid = (kcol >= cs) && (kcol < cs + 16);
            const int ci = min(max(kcol, cs), cs + 15);
            s = valid ? (s + rprow[ci] * L2E) : -1e30f;
          }
          S[kk][qt][e] = s;
          mx = fmaxf(mx, s);
        }
      mx = fmaxf(mx, __shfl_xor(mx, 32, 64));
      const float mnew = fmaxf(m[qt], mx);
      if (__builtin_amdgcn_ballot_w64(mnew > m[qt]) != 0ull) {
        const float alpha = ex2(m[qt] - mnew);
        lsum[qt] *= alpha;
#pragma unroll
        for (int dvt = 0; dvt < 2; ++dvt)
#pragma unroll
          for (int e = 0; e < 16; ++e) O[dvt][qt][e] *= alpha;
      }
      m[qt] = mnew;
#pragma unroll
      for (int kk = 0; kk < 2; ++kk)
#pragma unroll
        for (int s2 = 0; s2 < 2; ++s2) {
          v4u pkd;
#pragma unroll
          for (int jj = 0; jj < 4; ++jj) {
            const float p0 = ex2(S[kk][qt][8 * s2 + 2 * jj] - mnew);
            const float p1 = ex2(S[kk][qt][8 * s2 + 2 * jj + 1] - mnew);
            lsum[qt] += p0 + p1;
            pkd[jj] = pk2(p0, p1);
          }
          pf[qt][2 * kk + s2] = (bf16x8)pkd;
        }
    }
#pragma unroll
    for (int dvt = 0; dvt < 2; ++dvt)
#pragma unroll
      for (int s = 0; s < 4; ++s) {
        const bf16x8 vf = *(const bf16x8*)(VT + ((size_t)(b * 512 + head * 64 + 32 * dvt + r)) * NKEY + key0 + 16 * s + 8 * hh);
        O[dvt][0] = mfma32(vf, pf[0][s], O[dvt][0]);
        O[dvt][1] = mfma32(vf, pf[1][s], O[dvt][1]);
      }
  }
#pragma unroll
  for (int qt = 0; qt < 2; ++qt) {
    const float inv = 1.f / (lsum[qt] + __shfl_xor(lsum[qt], 32, 64));
    const int qrow = qgrow + 32 * qt + r;
#pragma unroll
    for (int dvt = 0; dvt < 2; ++dvt)
#pragma unroll
      for (int g = 0; g < 4; ++g) {
        const int dv0 = 32 * dvt + 8 * g + 4 * hh;
        const size_t off = (size_t)qrow * 512 + head * 64 + dv0;
        const v2u z = *(const v2u*)(ZC + off);
        v2u o;
        o[0] = pk2(O[dvt][qt][4 * g] * inv * silu_f(bflo(z[0])), O[dvt][qt][4 * g + 1] * inv * silu_f(bfhi(z[0])));
        o[1] = pk2(O[dvt][qt][4 * g + 2] * inv * silu_f(bflo(z[1])), O[dvt][qt][4 * g + 3] * inv * silu_f(bfhi(z[1])));
        *(v2u*)(QC + off) = o;
      }
  }
  __syncthreads();
}

__device__ __forceinline__ float logsigmoid_f(float x) { return fminf(x, 0.f) - log1pf(__expf(-fabsf(x))); }
__device__ __forceinline__ int chunk_grow0(int b, int P) { return P < 2 ? 16384 + b * 256 + 128 * P : b * 8192 + 128 * (P - 2); }
__device__ __forceinline__ int chunk_key0(int P) { return P < 2 ? 8192 + 128 * P : 128 * (P - 2); }

__device__ __forceinline__ void mlstm_gates(const Params& p, int l, int head, int grow0, float* lf, float* li) {
  const int tid = opaque_tid();
  if (tid < 256) {
    const int d = tid >> 7, s = tid & 127;
    const float* G = (const float*)(p.ws + WS_G) + (size_t)(grow0 + s) * 16;
    const float gi = G[d * 8 + head] + p.gate_b[l * 16 + d * 8 + head];
    const float gf = G[d * 8 + 4 + head] + p.gate_b[l * 16 + d * 8 + 4 + head];
    li[d * 128 + s] = gi;
    lf[d * 128 + s] = logsigmoid_f(gf);
  }
}

__device__ __forceinline__ void conv8(const Params& p, int l, const u16* src, int grow, int fcol, int ch0, bool hasprev,
                                      bool hasnext, float scale, float (&o)[8]) {
  const v4u zero = {0u, 0u, 0u, 0u};
  const v4u xm = hasprev ? *(const v4u*)(src + (size_t)(grow - 1) * 512 + fcol) : zero;
  const v4u x0 = *(const v4u*)(src + (size_t)grow * 512 + fcol);
  const v4u xp = hasnext ? *(const v4u*)(src + (size_t)(grow + 1) * 512 + fcol) : zero;
  const float* cw = p.conv_w + (size_t)l * 3 * 1024 + ch0;
  const float* cb = p.conv_b + (size_t)l * 1024 + ch0;
#pragma unroll
  for (int e = 0; e < 8; ++e) {
    const float a = (e & 1) ? bfhi(xm[e >> 1]) : bflo(xm[e >> 1]);
    const float bq = (e & 1) ? bfhi(x0[e >> 1]) : bflo(x0[e >> 1]);
    const float cq = (e & 1) ? bfhi(xp[e >> 1]) : bflo(xp[e >> 1]);
    const float y = a * cw[e] + bq * cw[1024 + e] + cq * cw[2048 + e] + cb[e];
    o[e] = silu_f(y) * scale;
  }
}

__device__ __attribute__((always_inline)) void mlstm_b1_item(const Params& p, int l, int b, int head, int P, unsigned char* smem) {
  u16* kwT = (u16*)smem;
  float* lf = (float*)(smem + 69632);
  float* li = lf + 256;
  float* wS = li + 256;
  const int tid = opaque_tid(), lane = tid & 63, wave = tid >> 6;
  const int r = lane & 31, hh = lane >> 5;
  const int grow0 = chunk_grow0(b, P), key0 = chunk_key0(P);
  float* BL = (float*)(p.ws + WS_BL);
  float* DN = (float*)(p.ws + WS_DN);
  u16* CST = (u16*)(p.ws + WS_H);
  mlstm_gates(p, l, head, grow0, lf, li);
  __syncthreads();
  if (tid < 256) {
    const int d = tid >> 7, s = tid & 127;
    float tot = 0.f, bs = 0.f;
    for (int j = 0; j < 128; ++j) {
      const float v = lf[d * 128 + j];
      tot += v;
      if (d == 0 ? (j <= s) : (j >= s)) bs += v;
    }
    wS[d * 128 + s] = __expf(tot - bs + li[d * 128 + s]);
    if (s == 0) BL[((b * 4 + head) * 2 + d) * 66 + P] = tot;
  }
  __syncthreads();
  const u16* KB = piece(p, P_KB);
#pragma unroll 1
  for (int i = 0; i < 4; ++i) {
    const int u = tid + NTHR * i;
    const int s = u >> 4, dg = u & 15;
    const bool hasprev = !((P == 0 || P == 2) && s == 0);
    const bool hasnext = !((P == 1 || P == 65) && s == 127);
    float kc[8];
    conv8(p, l, KB, grow0 + s, head * 128 + dg * 8, 512 + head * 128 + dg * 8, hasprev, hasnext, 0.08838834764831845f, kc);
    const int ps = perm16(s);
    const float w0 = wS[s], w1 = wS[128 + s];
#pragma unroll
    for (int e = 0; e < 8; ++e) {
      kwT[(dg * 8 + e) * 136 + ps] = f2bf(kc[e] * w0);
      kwT[(128 + dg * 8 + e) * 136 + ps] = f2bf(kc[e] * w1);
    }
  }
  __syncthreads();
  {
    const int d = wave >> 2, dvt = wave & 3;
    const u16* VT = piece(p, P_VTB);
    bf16x8 vf[8];
#pragma unroll
    for (int s8 = 0; s8 < 8; ++s8)
      vf[s8] = *(const bf16x8*)(VT + ((size_t)(b * 512 + head * 128 + 32 * dvt + r)) * NKEY + key0 + 16 * s8 + 8 * hh);
    const int chain = (b * 4 + head) * 2 + d;
    u16* dst = CST + ((size_t)(chain * 66 + P)) * 16384;
#pragma unroll
    for (int dkt = 0; dkt < 4; ++dkt) {
      f32x16 acc = zero16();
#pragma unroll
      for (int s8 = 0; s8 < 8; ++s8) {
        const bf16x8 kf = *(const bf16x8*)(kwT + (d * 128 + 32 * dkt + r) * 136 + 16 * s8 + 8 * hh);
        acc = mfma32(vf[s8], kf, acc);
      }
#pragma unroll
      for (int e = 0; e < 16; ++e) {
        const int dv = 32 * dvt + (e & 3) + 8 * (e >> 2) + 4 * hh;
        dst[dv * 128 + 32 * dkt + r] = f2bf(acc[e]);
      }
    }
  }
  if (tid < 256) {
    const int d = tid >> 7, dk = tid & 127;
    float s = 0.f;
    for (int j = 0; j < 128; ++j) s += bf2f(kwT[(d * 128 + dk) * 136 + j]);
    DN[(((b * 4 + head) * 2 + d) * 66 + P) * 128 + dk] = s;
  }
  __syncthreads();
}

__device__ __attribute__((always_inline)) void phase_b2(const Params& p) {
  const int gid = blockIdx.x * NTHR + threadIdx.x;
  const float* BL = (const float*)(p.ws + WS_BL);
  if (gid < 131072) {
    const int chain = gid >> 13, e2 = gid & 8191;
    const int d = chain & 1;
    unsigned* base = (unsigned*)(p.ws + WS_H) + (size_t)chain * 66 * 8192 + e2;
    float c0 = 0.f, c1 = 0.f;
    for (int i0 = 0; i0 < 66; i0 += 6) {
      unsigned v[6];
      float a[6];
#pragma unroll
      for (int j = 0; j < 6; ++j) {
        const int i = i0 + j;
        const int P = d == 0 ? i : (i < 2 ? 1 - i : 67 - i);
        v[j] = base[(size_t)P * 8192];
        a[j] = __expf(BL[chain * 66 + P]);
      }
#pragma unroll
      for (int j = 0; j < 6; ++j) {
        const int i = i0 + j;
        const int P = d == 0 ? i : (i < 2 ? 1 - i : 67 - i);
        base[(size_t)P * 8192] = pk2(c0, c1);
        c0 = a[j] * c0 + bflo(v[j]);
        c1 = a[j] * c1 + bfhi(v[j]);
      }
    }
  }
  if (gid < 2048) {
    const int chain = gid >> 7, dk = gid & 127;
    const int d = chain & 1;
    const float* DN = (const float*)(p.ws + WS_DN);
    float* NP = (float*)(p.ws + WS_NPREV);
    float run = 0.f;
    for (int i = 0; i < 66; ++i) {
      const int P = d == 0 ? i : (i < 2 ? 1 - i : 67 - i);
      NP[(chain * 66 + P) * 128 + dk] = run;
      run = __expf(BL[chain * 66 + P]) * run + DN[(chain * 66 + P) * 128 + dk];
    }
  }
}

__device__ __attribute__((always_inline)) void mlstm_b3_item(const Params& p, int l, int b, int head, int P, unsigned char* smem) {
  u16* qS = (u16*)smem;
  u16* kS = (u16*)(smem + 34816);
  u16* pS = (u16*)(smem + 69632);
  float* fb = (float*)(smem + 104448);
  float* lf = fb;
  float* li = fb + 256;
  float* bc = fb + 512;
  float* colsum = fb + 768;
  float* nS = fb + 1280;
  float* nq = fb + 1536;
  float* cfs = fb + 1792;
  float* hsq = fb + 2048;
  const int tid = opaque_tid(), lane = tid & 63, wave = tid >> 6;
  const int r = lane & 31, hh = lane >> 5;
  const int grow0 = chunk_grow0(b, P), key0 = chunk_key0(P);
  const int chainF = (b * 4 + head) * 2, chainB = chainF + 1;
  mlstm_gates(p, l, head, grow0, lf, li);
  __syncthreads();
  if (tid < 256) {
    const int d = tid >> 7, s = tid & 127;
    float bs = 0.f;
    for (int j = 0; j < 128; ++j) {
      const float v = lf[d * 128 + j];
      if (d == 0 ? (j <= s) : (j >= s)) bs += v;
    }
    bc[d * 128 + s] = bs;
    nS[d * 128 + s] = ((const float*)(p.ws + WS_NPREV))[((chainF + d) * 66 + P) * 128 + s];
  }
  {
    const u16* QB = piece(p, P_QB);
    const u16* KB = piece(p, P_KB);
#pragma unroll 1
    for (int i = 0; i < 4; ++i) {
      const int u = tid + NTHR * i;
      const int s = u >> 4, dg = u & 15;
      const bool hasprev = !((P == 0 || P == 2) && s == 0);
      const bool hasnext = !((P == 1 || P == 65) && s == 127);
      float o[8];
      conv8(p, l, QB, grow0 + s, head * 128 + dg * 8, head * 128 + dg * 8, hasprev, hasnext, 1.f, o);
      v4u pk;
      pk[0] = pk2(o[0], o[1]); pk[1] = pk2(o[2], o[3]); pk[2] = pk2(o[4], o[5]); pk[3] = pk2(o[6], o[7]);
      *(v4u*)(qS + s * 136 + dg * 8) = pk;
      conv8(p, l, KB, grow0 + s, head * 128 + dg * 8, 512 + head * 128 + dg * 8, hasprev, hasnext, 0.08838834764831845f, o);
      pk[0] = pk2(o[0], o[1]); pk[1] = pk2(o[2], o[3]); pk[2] = pk2(o[4], o[5]); pk[3] = pk2(o[6], o[7]);
      *(v4u*)(kS + s * 136 + dg * 8) = pk;
    }
  }
  __syncthreads();
  if (tid < 256) {
    const int d = tid >> 7, t = tid & 127;
    float s = 0.f;
    for (int k = 0; k < 128; ++k) s += nS[d * 128 + k] * bf2f(qS[t * 136 + k]);
    nq[d * 128 + t] = s;
  }
  f32x16 Pf[2], Pb[2];
  {
    const int tt = wave & 3, sh = wave >> 2;
    const int t = 32 * tt + r;
    bf16x8 qf[8];
#pragma unroll
    for (int ks = 0; ks < 8; ++ks) qf[ks] = *(const bf16x8*)(qS + t * 136 + 16 * ks + 8 * hh);
    const float bFt = bc[t], bBt = bc[128 + t];
    float csf = 0.f, csb = 0.f;
#pragma unroll
    for (int st2 = 0; st2 < 2; ++st2) {
      const int stile = 2 * sh + st2;
      f32x16 S = zero16();
#pragma unroll
      for (int ks = 0; ks < 8; ++ks) {
        const bf16x8 kf = *(const bf16x8*)(kS + (32 * stile + r) * 136 + 16 * ks + 8 * hh);
        S = mfma32(kf, qf[ks], S);
      }
#pragma unroll
      for (int e = 0; e < 16; ++e) {
        const int s = 32 * stile + (e & 3) + 8 * (e >> 2) + 4 * hh;
        const float raw = S[e];
        const float pf_ = (s <= t) ? raw * __expf(bFt - bc[s] + li[s]) : 0.f;
        const float pb_ = (s >= t) ? raw * __expf(bBt - bc[128 + s] + li[128 + s]) : 0.f;
        Pf[st2][e] = pf_;
        Pb[st2][e] = pb_;
        csf += pf_;
        csb += pb_;
      }
    }
    csf += __shfl_xor(csf, 32, 64);
    csb += __shfl_xor(csb, 32, 64);
    if (hh == 0) {
      colsum[(0 * 2 + sh) * 128 + t] = csf;
      colsum[(1 * 2 + sh) * 128 + t] = csb;
    }
  }
  __syncthreads();
  {
    const int tt = wave & 3, sh = wave >> 2;
    const int t = 32 * tt + r;
    const float eF = __expf(bc[t]), eB = __expf(bc[128 + t]);
    const float denF = eF * nq[t] + colsum[0 * 128 + t] + colsum[1 * 128 + t];
    const float denB = eB * nq[128 + t] + colsum[2 * 128 + t] + colsum[3 * 128 + t];
    const float invF = 1.f / fmaxf(fabsf(denF), 1.f);
    const float invB = 1.f / fmaxf(fabsf(denB), 1.f);
    if (sh == 0 && hh == 0) {
      cfs[t] = eF * invF;
      cfs[128 + t] = eB * invB;
    }
#pragma unroll
    for (int st2 = 0; st2 < 2; ++st2) {
      const int stile = 2 * sh + st2;
#pragma unroll
      for (int g = 0; g < 4; ++g) {
        v2u pk;
        pk[0] = pk2(Pf[st2][4 * g] * invF + Pb[st2][4 * g] * invB, Pf[st2][4 * g + 1] * invF + Pb[st2][4 * g + 1] * invB);
        pk[1] = pk2(Pf[st2][4 * g + 2] * invF + Pb[st2][4 * g + 2] * invB, Pf[st2][4 * g + 3] * invF + Pb[st2][4 * g + 3] * invB);
        const int pos = 32 * stile + 16 * (g >> 1) + 4 * (hh * 2 + (g & 1));
        *(v2u*)(pS + t * 136 + pos) = pk;
      }
    }
  }
  __syncthreads();
  const int dvt = wave & 3, tp = wave >> 2;
  f32x16 hacc[2];
  {
    const u16* VT = piece(p, P_VTB);
    const u16* CST = (const u16*)(p.ws + WS_H);
    f32x16 aP[2], aF[2], aB[2];
#pragma unroll
    for (int t2 = 0; t2 < 2; ++t2) { aP[t2] = zero16(); aF[t2] = zero16(); aB[t2] = zero16(); }
#pragma unroll
    for (int s8 = 0; s8 < 8; ++s8) {
      const bf16x8 vf = *(const bf16x8*)(VT + ((size_t)(b * 512 + head * 128 + 32 * dvt + r)) * NKEY + key0 + 16 * s8 + 8 * hh);
#pragma unroll
      for (int t2 = 0; t2 < 2; ++t2) {
        const bf16x8 pf_ = *(const bf16x8*)(pS + (32 * (2 * tp + t2) + r) * 136 + 16 * s8 + 8 * hh);
        aP[t2] = mfma32(vf, pf_, aP[t2]);
      }
    }
    const u16* cF = CST + ((size_t)(chainF * 66 + P)) * 16384 + (32 * dvt + r) * 128 + 8 * hh;
    const u16* cB = CST + ((size_t)(chainB * 66 + P)) * 16384 + (32 * dvt + r) * 128 + 8 * hh;
#pragma unroll
    for (int ks = 0; ks < 8; ++ks) {
      const bf16x8 f1 = *(const bf16x8*)(cF + 16 * ks);
      const bf16x8 f2 = *(const bf16x8*)(cB + 16 * ks);
#pragma unroll
      for (int t2 = 0; t2 < 2; ++t2) {
        const bf16x8 qf = *(const bf16x8*)(qS + (32 * (2 * tp + t2) + r) * 136 + 16 * ks + 8 * hh);
        aF[t2] = mfma32(f1, qf, aF[t2]);
        aB[t2] = mfma32(f2, qf, aB[t2]);
      }
    }
#pragma unroll
    for (int t2 = 0; t2 < 2; ++t2) {
      const int t = 32 * (2 * tp + t2) + r;
      const float cf = cfs[t], cb = cfs[128 + t];
      float ss = 0.f;
#pragma unroll
      for (int e = 0; e < 16; ++e) {
        const float hv = aP[t2][e] + cf * aF[t2][e] + cb * aB[t2][e];
        hacc[t2][e] = hv;
        ss += hv * hv;
      }
      ss += __shfl_xor(ss, 32, 64);
      if (hh == 0) hsq[dvt * 128 + t] = ss;
    }
  }
  __syncthreads();
  {
    u16* OB = piece(p, P_OB);
    const u16* ZB = piece(p, P_ZB);
    const float* mg = p.ml_g + l * 128;
#pragma unroll
    for (int t2 = 0; t2 < 2; ++t2) {
      const int t = 32 * (2 * tp + t2) + r;
      const float rinv = rsqrtf((hsq[t] + hsq[128 + t] + hsq[256 + t] + hsq[384 + t]) * (1.f / 128.f) + 1e-6f);
#pragma unroll
      for (int g = 0; g < 4; ++g) {
        const int dv0 = 32 * dvt + 8 * g + 4 * hh;
        const size_t off = (size_t)(grow0 + t) * 512 + head * 128 + dv0;
        const v2u ov = *(const v2u*)(OB + off);
        const v2u zv = *(const v2u*)(ZB + off);
        const float y0 = sigmoid_f(bflo(ov[0])) * hacc[t2][4 * g] * rinv * mg[dv0] * silu_f(bflo(zv[0]));
        const float y1 = sigmoid_f(bfhi(ov[0])) * hacc[t2][4 * g + 1] * rinv * mg[dv0 + 1] * silu_f(bfhi(zv[0]));
        const float y2 = sigmoid_f(bflo(ov[1])) * hacc[t2][4 * g + 2] * rinv * mg[dv0 + 2] * silu_f(bflo(zv[1]));
        const float y3 = sigmoid_f(bfhi(ov[1])) * hacc[t2][4 * g + 3] * rinv * mg[dv0 + 3] * silu_f(bfhi(zv[1]));
        v2u o;
        o[0] = pk2(y0, y1);
        o[1] = pk2(y2, y3);
        *(v2u*)(OB + off) = o;
      }
    }
  }
  __syncthreads();
}

__device__ __attribute__((always_inline)) void phase_s3(const Params& p, int l, unsigned char* smem) {
  const int nActx = (l == 0) ? 16 : 0, nCctx = (l == 0) ? 8 : 0;
  if ((gridDim.x & 7) == 0) {
    const int xcd = blockIdx.x & 7, slot = blockIdx.x >> 3, nb = gridDim.x >> 3;
#pragma unroll 1
    for (int q = slot; q < 64 + (nActx >> 3); q += nb) {
      const int b = xcd >> 2, h = xcd & 3;
      if (q < 64) attn_item(p, l, b, h, b * 8192 + q * 128, 0, 132, smem);
      else attn_item(p, l, b, h, 16384 + b * 256 + (q - 64) * 128, 128, 132, smem);
    }
  } else {
#pragma unroll 1
    for (int j = blockIdx.x; j < 512 + nActx; j += gridDim.x) {
      if (j < 512) {
        const int b = j >> 8, h = (j >> 6) & 3, qb = j & 63;
        attn_item(p, l, b, h, b * 8192 + qb * 128, 0, 132, smem);
      } else {
        const int jj = j - 512;
        const int b = jj >> 3, h = (jj >> 1) & 3, qh = jj & 1;
        attn_item(p, l, b, h, 16384 + b * 256 + qh * 128, 128, 132, smem);
      }
    }
  }
#pragma unroll 1
  for (int j = (blockIdx.x + gridDim.x - 32) % gridDim.x; j < 528; j += gridDim.x) {
    const int b = j / 264, rem = j % 264, head = rem / 66, P = rem % 66;
    mlstm_b1_item(p, l, b, head, P, smem);
  }
#pragma unroll 1
  for (int j = (blockIdx.x + gridDim.x - 64) % gridDim.x; j < 256 + nCctx; j += gridDim.x) {
    if (j < 256) natten_item(p, l, j >> 7, j & 127, (j >> 7) * 8192 + (j & 127) * 64, 0, smem);
    else natten_item(p, l, (j - 256) >> 2, 0, 16384 + ((j - 256) >> 2) * 256 + ((j - 256) & 3) * 64, 8, smem);
  }
}

__device__ __attribute__((always_inline)) void h2_rows(const Params& p, int l) {
  const int tid = opaque_tid(), lane = tid & 63, wave = tid >> 6;
  u16* H2 = slotp(p, 3);
  const float* rstd = (const float*)(p.ws + WS_RSTD);
  for (int row = blockIdx.x * 8 + wave; row < R_TOT; row += gridDim.x * 8) {
    const float* xr = xrow(p, l, row);
    const int w = which_of(row);
    const float* gs = (const float*)(p.ws + WS_GS) + w * 1024;
    const float* sh = (const float*)(p.ws + WS_SH) + w * 1024;
    const float rs = rstd[row];
#pragma unroll
    for (int j = 0; j < 4; ++j) {
      const int k = lane * 4 + 256 * j;
      const v4f v = *(const v4f*)(xr + k);
      const v4f g = *(const v4f*)(gs + k);
      const v4f sf = *(const v4f*)(sh + k);
      v2u pk;
      pk[0] = pk2(v[0] * rs * g[0] + sf[0], v[1] * rs * g[1] + sf[1]);
      pk[1] = pk2(v[2] * rs * g[2] + sf[2], v[3] * rs * g[3] + sf[3]);
      *(v2u*)(H2 + (size_t)row * 1024 + k) = pk;
    }
  }
}

__device__ __attribute__((always_inline)) void phase_s5(const Params& p, int l, unsigned char* smem) {
  h2_rows(p, l);
  const int P0 = (l == 0) ? 0 : 2;
  const int nP = 66 - P0;
  for (int it = (blockIdx.x + gridDim.x - 96) % gridDim.x; it < 8 * nP; it += gridDim.x) {
    const int bh = it / nP, P = P0 + it % nP;
    mlstm_b3_item(p, l, bh >> 2, bh & 3, P, smem);
  }
}

__device__ __forceinline__ void s6a_tile(const Params& p, int rt, int ct, unsigned char* smem) {
  const int tid = opaque_tid(), lane = tid & 63, wave = tid >> 6;
  const int wm = wave >> 1, wn = wave & 1, r = lane & 31, hh = lane >> 5;
  const u16* H2 = slotp(p, 3);
  const u16* WTI = (const u16*)(p.ws + WS_WT_IN);
  u16* G = slotp(p, 5);
  const int row0 = rt * 256;
  f32x16 acc[2][2];
  acc[0][0] = zero16(); acc[0][1] = zero16(); acc[1][0] = zero16(); acc[1][1] = zero16();
  gemm_core<0, 2>(acc, H2 + (size_t)row0 * 1024, 1024, nullptr, nullptr, nullptr, nullptr,
                  WTI + (size_t)(6656 + ct * 128) * 1024, 1024, smem);
  u16* Gn = G + (size_t)(ct >> 3) * R_TOT * 1024;
  const int d0 = (ct & 7) * 128 + 64 * wn + r;
#pragma unroll
  for (int i = 0; i < 2; ++i)
#pragma unroll
    for (int e = 0; e < 16; ++e) {
      const int row = row0 + 64 * wm + 32 * i + (e & 3) + 8 * (e >> 2) + 4 * hh;
      u16* rp = Gn + (size_t)row * 1024 + d0;
      asm volatile("" : "+v"(rp));
      rp[0] = f2bf(sigmoid_f(acc[i][0][e]));
      rp[32] = f2bf(sigmoid_f(acc[i][1][e]));
    }
}

__device__ __forceinline__ void s6a_tile256(const Params& p, int rt, int ct, unsigned char* smem) {
  const int tid = opaque_tid(), lane = tid & 63, wave = tid >> 6;
  const int wm = wave >> 1, wn = wave & 1, r = lane & 31, hh = lane >> 5;
  const u16* H2 = slotp(p, 3);
  const u16* WTI = (const u16*)(p.ws + WS_WT_IN);
  u16* G = slotp(p, 5);
  const int row0 = rt * 256;
  f32x16 acc[2][4];
#pragma unroll
  for (int i = 0; i < 2; ++i)
#pragma unroll
    for (int j = 0; j < 4; ++j) acc[i][j] = zero16();
  gemm_core256<1>(acc, H2 + (size_t)row0 * 1024, 1024, WTI + (size_t)(6656 + ct * 256) * 1024, 1024, smem);
  u16* Gn = G + (size_t)(ct >> 2) * R_TOT * 1024;
  const int d0 = (ct & 3) * 256 + 128 * wn + r;
#pragma unroll
  for (int i = 0; i < 2; ++i)
#pragma unroll
    for (int e = 0; e < 16; ++e) {
      const int row = row0 + 64 * wm + 32 * i + (e & 3) + 8 * (e >> 2) + 4 * hh;
      u16* rp = Gn + (size_t)row * 1024 + d0;
      asm volatile("" : "+v"(rp));
#pragma unroll
      for (int j = 0; j < 4; ++j) {
        float v = acc[i][j][e];
        asm volatile("" : "+v"(v));
        rp[32 * j] = f2bf(sigmoid_f(v));
      }
    }
}

__device__ __attribute__((always_inline)) void phase_s6a(const Params& p, int l, unsigned char* smem) {
  {
    const bool xs = (gridDim.x & 7) == 0;
    const int nb = xs ? (gridDim.x >> 3) : gridDim.x;
    const int xcd = xs ? (blockIdx.x & 7) : 0, slot = xs ? (blockIdx.x >> 3) : blockIdx.x;
    const int seg0 = xs ? 96 * xcd : 0, seg1 = xs ? 96 * (xcd + 1) : 768;
#pragma unroll 1
    for (int L = seg0 + slot; L < seg1; L += nb) {
      const int g = L / 96, rem = L % 96;
      s6a_tile256(p, 8 * g + (rem & 7), rem >> 3, smem);
    }
  }
  if (l == 0) {
#pragma unroll 1
    for (int it = blockIdx.x; it < 48; it += gridDim.x) s6a_tile(p, 64 + (it & 1), it >> 1, smem);
  }
}

template <int MI>
__device__ __forceinline__ void s6b_tile(const Params& p, int row0, int ct, unsigned char* smem) {
  const int tid = opaque_tid(), lane = tid & 63, wave = tid >> 6;
  const int wm = wave >> 1, wn = wave & 1, r = lane & 31, hh = lane >> 5;
  const u16* WTB = (const u16*)(p.ws + WS_WT_BR);
  const u16* G = slotp(p, 5);
  u16* M = (u16*)(p.ws + WS_H);
  f32x16 tot[MI][2];
#pragma unroll
  for (int i = 0; i < MI; ++i) { tot[i][0] = zero16(); tot[i][1] = zero16(); }
#pragma unroll 1
  for (int n = 0; n < 3; ++n) {
    f32x16 ap[MI][2];
#pragma unroll
    for (int i = 0; i < MI; ++i) { ap[i][0] = zero16(); ap[i][1] = zero16(); }
    gemm_core<0, MI>(ap, slotp(p, n) + (size_t)row0 * 512, 512, nullptr, nullptr, nullptr, nullptr,
                     WTB + (size_t)(n * 1024 + ct * 128) * 512, 512, smem);
    const u16* Gn = G + (size_t)n * R_TOT * 1024;
#pragma unroll
    for (int i = 0; i < MI; ++i)
#pragma unroll
      for (int e = 0; e < 16; ++e) {
        const int row = row0 + 32 * MI * wm + 32 * i + (e & 3) + 8 * (e >> 2) + 4 * hh;
        const u16* rp = Gn + (size_t)row * 1024 + ct * 128 + 64 * wn + r;
        asm volatile("" : "+v"(rp));
        tot[i][0][e] += bf2f(rp[0]) * ap[i][0][e];
        tot[i][1][e] += bf2f(rp[32]) * ap[i][1][e];
      }
  }
#pragma unroll
  for (int i = 0; i < MI; ++i)
#pragma unroll
    for (int e = 0; e < 16; ++e) {
      const int row = row0 + 32 * MI * wm + 32 * i + (e & 3) + 8 * (e >> 2) + 4 * hh;
      u16* rp = M + (size_t)row * 1024 + ct * 128 + 64 * wn + r;
      asm volatile("" : "+v"(rp));
      rp[0] = f2bf(tot[i][0][e]);
      rp[32] = f2bf(tot[i][1][e]);
    }
}

__device__ __attribute__((always_inline)) void phase_s6b(const Params& p, int l, unsigned char* smem) {
  {
    const bool xs = (gridDim.x & 7) == 0;
    const int nb = xs ? (gridDim.x >> 3) : gridDim.x;
    const int xcd = xs ? (blockIdx.x & 7) : 0, slot = xs ? (blockIdx.x >> 3) : blockIdx.x;
    const int seg0 = xs ? 128 * xcd : 0, seg1 = xs ? 128 * (xcd + 1) : 1024;
#pragma unroll 1
    for (int L = seg0 + slot; L < seg1; L += nb) {
      const int g = L >> 7, rem = L & 127, ct = rem >> 4, rt = 16 * g + (rem & 15);
      s6b_tile<1>(p, rt * 128, ct, smem);
    }
  }
  if (l == 0) {
#pragma unroll 1
    for (int it = blockIdx.x; it < 32; it += gridDim.x) s6b_tile<1>(p, 16384 + (it & 3) * 128, it >> 2, smem);
  }
}

template <int MI>
__device__ __forceinline__ void s7_tile(const Params& p, int l, int row0, int ct, unsigned char* smem) {
  const int tid = opaque_tid(), lane = tid & 63, wave = tid >> 6;
  const int wm = wave >> 1, wn = wave & 1, r = lane & 31, hh = lane >> 5;
  const u16* WTO = (const u16*)(p.ws + WS_WT_OUT);
  const u16* M = (const u16*)(p.ws + WS_H);
  const float* mod = (const float*)(p.ws + WS_MOD) + (size_t)l * 3 * 3072;
  const int w = which_of(row0);
  f32x16 acc[MI][2];
#pragma unroll
  for (int i = 0; i < MI; ++i) { acc[i][0] = zero16(); acc[i][1] = zero16(); }
  gemm_core<0, MI>(acc, M + (size_t)row0 * 1024, 1024, nullptr, nullptr, nullptr, nullptr, WTO + (size_t)(ct * 128) * 1024, 1024, smem);
  const float* xs_ = xrow(p, l, row0);
  float* xd = (row0 < 16384) ? (p.out + (size_t)row0 * 1024) : ((float*)(p.ws + WS_XC) + (size_t)(row0 - 16384) * 1024);
  const int col0 = ct * 128 + 64 * wn + r;
  const float g0 = mod[w * 3072 + 2048 + col0], g1 = mod[w * 3072 + 2048 + col0 + 32];
#pragma unroll
  for (int i = 0; i < MI; ++i)
#pragma unroll
    for (int e = 0; e < 16; ++e) {
      const size_t off = (size_t)(32 * MI * wm + 32 * i + (e & 3) + 8 * (e >> 2) + 4 * hh) * 1024 + col0;
      const float* sp = xs_ + off;
      float* dp = xd + off;
      asm volatile("" : "+v"(sp), "+v"(dp));
      dp[0] = sp[0] + g0 * acc[i][0][e];
      dp[32] = sp[32] + g1 * acc[i][1][e];
    }
}

__device__ __attribute__((always_inline)) void phase_s7(const Params& p, int l, unsigned char* smem) {
  {
    const bool xs = (gridDim.x & 7) == 0;
    const int nb = xs ? (gridDim.x >> 3) : gridDim.x;
    const int xcd = xs ? (blockIdx.x & 7) : 0, slot = xs ? (blockIdx.x >> 3) : blockIdx.x;
    const int seg0 = xs ? 64 * xcd : 0, seg1 = xs ? 64 * (xcd + 1) : 512;
#pragma unroll 1
    for (int L = seg0 + slot; L < seg1; L += nb) {
      const int g = L >> 6, rem = L & 63;
      s7_tile<2>(p, l, (8 * g + (rem & 7)) * 256, rem >> 3, smem);
    }
  }
  if (l == 0) {
#pragma unroll 1
    for (int it = blockIdx.x; it < 32; it += gridDim.x) s7_tile<1>(p, l, 16384 + (it & 3) * 128, it >> 2, smem);
  }
}

__device__ __attribute__((always_inline)) void phase_final(const Params& p) {
  const int tid = threadIdx.x, lane = tid & 63, wave = tid >> 6;
  for (int row = blockIdx.x * 8 + wave; row < 16384; row += gridDim.x * 8) {
    float* xr = p.out + (size_t)row * 1024;
    v4f v[4];
    float ss = 0.f;
#pragma unroll
    for (int j = 0; j < 4; ++j) {
      v[j] = *(const v4f*)(xr + lane * 4 + 256 * j);
      ss += v[j][0] * v[j][0] + v[j][1] * v[j][1] + v[j][2] * v[j][2] + v[j][3] * v[j][3];
    }
    ss = wave_sum(ss);
    const float rs = rsqrtf(ss * (1.f / 1024.f) + 1e-6f);
#pragma unroll
    for (int j = 0; j < 4; ++j) {
      const v4f g = *(const v4f*)(p.final_g + lane * 4 + 256 * j);
      v4f o;
#pragma unroll
      for (int e = 0; e < 4; ++e) o[e] = v[j][e] * rs * g[e];
      *(v4f*)(xr + lane * 4 + 256 * j) = o;
    }
  }
}

#define XB_TMO      128
#define XB_XCNT(j)  (256  + 64 * (j))
#define XB_XSUB(j)  (1280 + 64 * (j))
#define XB_XGEN(j)  (2304 + 64 * (j))
#define XB_TOP      3328
#define XB_TOPGEN   3392
#define XCD_BAR_WORDS 3456
#define XB_SPIN_CAP (1u << 18)
#define LAS __attribute__((address_space(3)))

__device__ __forceinline__ unsigned xb_ld(unsigned* p)              { return __hip_atomic_load(p, __ATOMIC_RELAXED, __HIP_MEMORY_SCOPE_AGENT); }
__device__ __forceinline__ unsigned xb_add(unsigned* p, unsigned v) { return __hip_atomic_fetch_add(p, v, __ATOMIC_RELAXED, __HIP_MEMORY_SCOPE_AGENT); }
__device__ __forceinline__ unsigned xb_xcc_id() { return (unsigned)__builtin_amdgcn_s_getreg((3 << 11) | 20) & 0xFu; }
#define XB_SPIN(cond, bar) do { unsigned _sp = 0; while (cond) { __builtin_amdgcn_s_sleep(1); \
    if ((++_sp & 255u) == 0u) { if (xb_ld(&(bar)[XB_TMO])) break; if (_sp > XB_SPIN_CAP) { atomicAdd(&(bar)[XB_TMO], 1u); break; } } } } while (0)

struct XcdBarrier {
    unsigned* bar; unsigned x;
    volatile LAS unsigned* st;
};

__device__ __forceinline__ XcdBarrier xcd_barrier_post(unsigned* bar, volatile LAS unsigned* st) {
    XcdBarrier b; b.bar = bar; b.x = xb_xcc_id(); b.st = st;
    if (threadIdx.x == 0) (void)xb_add(&bar[XB_XCNT(b.x)], 1u);
    return b;
}
__device__ __forceinline__ void xcd_barrier_complete(unsigned* bar, unsigned x, unsigned& nloc, unsigned& nx) {
    const unsigned G = gridDim.x * gridDim.y * gridDim.z;
    unsigned sum, cnt, mine, sp = 0u;
    for (;;) {
        sum = 0u; cnt = 0u; mine = 0u;
#pragma unroll
        for (unsigned j = 0; j < 16; ++j) { const unsigned c = xb_ld(&bar[XB_XCNT(j)]); sum += c; cnt += (c > 0u) ? 1u : 0u; mine = (j == x) ? c : mine; }
        if (sum == G) break;
        __builtin_amdgcn_s_sleep(1);
        if ((++sp & 255u) == 0u) { if (xb_ld(&bar[XB_TMO])) break; if (sp > XB_SPIN_CAP) { atomicAdd(&bar[XB_TMO], 1u); break; } }
    }
    nloc = mine > 0u ? mine : 1u; nx = cnt > 0u ? cnt : 1u;
}

__device__ __forceinline__ void xcd_barrier(const XcdBarrier& b) {
    asm volatile("s_waitcnt vmcnt(0)" ::: "memory");
    __syncthreads();
    if (threadIdx.x == 0) {
        unsigned* bar = b.bar;
        __builtin_amdgcn_s_waitcnt(0);
        unsigned nloc = b.st[0], nx = b.st[1];
        if (nloc == 0u) { xcd_barrier_complete(bar, b.x, nloc, nx); b.st[0] = nloc; b.st[1] = nx; }
        const unsigned old = xb_add(&bar[XB_XSUB(b.x)], 1u);
        const unsigned gen = old / nloc;
        if (old + 1u == (gen + 1u) * nloc) {
            __builtin_amdgcn_fence(__ATOMIC_RELEASE, "agent");
            asm volatile("s_waitcnt vmcnt(0)" ::: "memory");
            const unsigned og = xb_add(&bar[XB_TOP], 1u);
            const unsigned tg = og / nx;
            if (og + 1u == (tg + 1u) * nx) xb_add(&bar[XB_TOPGEN], 1u);
            else XB_SPIN(xb_ld(&bar[XB_TOPGEN]) == tg, bar);
            __builtin_amdgcn_fence(__ATOMIC_ACQUIRE, "agent");
            xb_add(&bar[XB_XGEN(b.x)], 1u);
            asm volatile("s_waitcnt vmcnt(0)" ::: "memory");
        } else {
            XB_SPIN(xb_ld(&bar[XB_XGEN(b.x)]) == gen, bar);
            __builtin_amdgcn_fence(__ATOMIC_ACQUIRE, "agent");
            asm volatile("s_waitcnt vmcnt(0)" ::: "memory");
        }
    }
    __syncthreads();
}


__global__ void __launch_bounds__(NTHR) fwd_megakernel(Params p) {
  extern __shared__ __attribute__((aligned(16))) unsigned char smem[];
  cg::grid_group grid = cg::this_grid();
  __shared__ uint4 xb_words;
  if (threadIdx.x == 0) xb_words = make_uint4(0u, 0u, 0u, 0u);
  __syncthreads();
  XcdBarrier xbar = xcd_barrier_post((unsigned*)(p.ws + WS_BAR), (volatile LAS unsigned*)&xb_words);
#define PH(k, call)                                  \
  if (p.ph_lo <= (k) && (k) < p.ph_hi) {             \
    call;                                            \
    if ((k) + 1 < p.ph_hi) { if ((k) == 0) grid.sync(); else xcd_barrier(xbar); }  \
  }
  PH(0, phase_s0(p))
  PH(1, phase_s1(p, 0, smem))
  PH(2, phase_s2(p, 0, smem))
  PH(3, phase_s3(p, 0, smem))
  PH(4, phase_b2(p))
  PH(5, phase_s5(p, 0, smem))
  PH(6, phase_s6a(p, 0, smem))
  PH(7, phase_s6b(p, 0, smem))
  PH(8, phase_s7(p, 0, smem))
  PH(9, phase_s1(p, 1, smem))
  PH(10, phase_s2(p, 1, smem))
  PH(11, phase_s3(p, 1, smem))
  PH(12, phase_b2(p))
  PH(13, phase_s5(p, 1, smem))
  PH(14, phase_s6a(p, 1, smem))
  PH(15, phase_s6b(p, 1, smem))
  PH(16, phase_s7(p, 1, smem))
  PH(17, phase_final(p))
#undef PH
}

extern "C" void kernel_launch(void* const* d_in, const int* in_sizes, int n_in, void* d_out, int out_size,
                              void* d_ws, size_t ws_size, hipStream_t stream) {
  static int grid_blocks = 0;
  if (grid_blocks == 0) {
    if (n_in != 19 || ws_size < WS_END) {
      fprintf(stderr, "kernel_launch: unexpected n_in %d or ws_size %zu (< %llu)\n", n_in, ws_size, (unsigned long long)WS_END);
      grid_blocks = -1;
      return;
    }
    int dev = 0, cus = 0, per_cu = 0;
    hipGetDevice(&dev);
    hipDeviceGetAttribute(&cus, hipDeviceAttributeMultiprocessorCount, dev);
    if (hipFuncSetAttribute((const void*)fwd_megakernel, hipFuncAttributeMaxDynamicSharedMemorySize, LDS_BYTES) != hipSuccess) {
      fprintf(stderr, "kernel_launch: hipFuncSetAttribute failed\n");
      grid_blocks = -1;
      return;
    }
    hipOccupancyMaxActiveBlocksPerMultiprocessor(&per_cu, (const void*)fwd_megakernel, NTHR, LDS_BYTES);
    if (per_cu < 1) { fprintf(stderr, "kernel_launch: occupancy query says %d blocks/CU\n", per_cu); per_cu = 1; }
    (void)hipGetLastError();
    grid_blocks = cus;
  }
  if (grid_blocks < 0) return;
  hipMemsetAsync((char*)d_ws + WS_MOD, 0, 73728, stream);
  hipMemsetAsync((char*)d_ws + WS_BAR, 0, 13824, stream);
  Params p{};
  p.x = (const float*)d_in[0]; p.c = (const float*)d_in[1]; p.ctx = (const float*)d_in[2]; p.c_ctx = (const float*)d_in[3];
  p.w_mod = (const float*)d_in[4]; p.b_mod = (const float*)d_in[5]; p.norm_g = (const float*)d_in[6]; p.w_in = (const float*)d_in[7];
  p.lam_q = (const float*)d_in[8]; p.lam_k = (const float*)d_in[9]; p.da_g = (const float*)d_in[10];
  p.conv_w = (const float*)d_in[11]; p.conv_b = (const float*)d_in[12]; p.gate_b = (const float*)d_in[13]; p.ml_g = (const float*)d_in[14];
  p.rpb = (const float*)d_in[15]; p.w_br = (const float*)d_in[16]; p.w_out = (const float*)d_in[17]; p.final_g = (const float*)d_in[18];
  p.out = (float*)d_out; p.ws = (unsigned char*)d_ws;
#if MULTI_LAUNCH
  for (int ph = 0; ph < NPHASE; ++ph) {
    p.ph_lo = ph; p.ph_hi = ph + 1;
    hipLaunchKernelGGL(fwd_megakernel, dim3(grid_blocks), dim3(NTHR), LDS_BYTES, stream, p);
  }
#else
  p.ph_lo = 0; p.ph_hi = NPHASE;
  void* args[] = {&p};
  hipError_t e = hipLaunchCooperativeKernel((void*)fwd_megakernel, dim3(grid_blocks), dim3(NTHR), args, LDS_BYTES, stream);
  if (e != hipSuccess) fprintf(stderr, "cooperative launch failed: %s (grid %d)\n", hipGetErrorString(e), grid_blocks);
#endif
}
```

```cpp
#include <hip/hip_runtime.h>
#include <hip/hip_cooperative_groups.h>
#include <cstdio>
namespace cg = cooperative_groups;

#ifndef MULTI_LAUNCH
#define MULTI_LAUNCH 0
#endif

typedef unsigned short u16;
typedef __attribute__((ext_vector_type(8))) short bf16x8;
typedef __attribute__((ext_vector_type(16))) float f32x16;
typedef __attribute__((ext_vector_type(4))) unsigned int v4u;
typedef __attribute__((ext_vector_type(2))) unsigned int v2u;
typedef __attribute__((ext_vector_type(4))) float v4f;

#define R_TOT 16896
#define NKEY 8448
#define NPAD 9856
#define NTHR 512
#define LDS_BYTES 147456
#define NPHASE 18

#define WS_WT_IN 0ull
#define WS_WT_BR 20185088ull
#define WS_WT_OUT 23330816ull
#define WS_H 25427968ull
#define WS_PIECE 60030976ull
#define PIECE_SZ 17301504ull
#define WS_XC 284950528ull
#define WS_G 287047680ull
#define WS_MOD 288129024ull
#define WS_ROPE 288202752ull
#define WS_RSTD 288219136ull
#define WS_DN 288286720ull
#define WS_NPREV 288827392ull
#define WS_BL 289368064ull
#define WS_GS 289372416ull
#define WS_SH 289384704ull
#define WS_BAR 289396992ull
#define WS_END 289412096ull

enum { P_QA = 0, P_KA, P_VTA, P_ZA, P_QB, P_KB, P_VTB, P_OB, P_ZB, P_QC, P_KC, P_VTC, P_ZC };

struct Params {
  const float *x, *c, *ctx, *c_ctx, *w_mod, *b_mod, *norm_g, *w_in, *lam_q, *lam_k, *da_g,
      *conv_w, *conv_b, *gate_b, *ml_g, *rpb, *w_br, *w_out, *final_g;
  float* out;
  unsigned char* ws;
  int ph_lo, ph_hi;
};

__device__ __forceinline__ int opaque_tid() { int t = threadIdx.x; asm volatile("" : "+v"(t)); return t; }
__device__ __forceinline__ u16 f2bf(float f) {
  unsigned u = __float_as_uint(f);
  u += 0x7fffu + ((u >> 16) & 1u);
  return (u16)(u >> 16);
}
__device__ __forceinline__ float bf2f(u16 h) { return __uint_as_float(((unsigned)h) << 16); }
typedef __attribute__((ext_vector_type(2))) __bf16 bf16x2_t;
typedef __attribute__((ext_vector_type(2))) float f32x2_t;
__device__ __forceinline__ unsigned pk2(float a, float b) { f32x2_t v = {a, b}; bf16x2_t r = __builtin_convertvector(v, bf16x2_t); return __builtin_bit_cast(unsigned, r); }
__device__ __forceinline__ float bflo(unsigned u) { return __uint_as_float(u << 16); }
__device__ __forceinline__ float bfhi(unsigned u) { return __uint_as_float(u & 0xffff0000u); }
__device__ __forceinline__ float silu_f(float x) { return x / (1.f + __expf(-x)); }
__device__ __forceinline__ float sigmoid_f(float x) { return 1.f / (1.f + __expf(-x)); }
__device__ __forceinline__ float ex2(float x) { return __builtin_amdgcn_exp2f(x); }
__device__ __forceinline__ float wave_sum(float v) {
#pragma unroll
  for (int o = 32; o > 0; o >>= 1) v += __shfl_xor(v, o, 64);
  return v;
}
__device__ __forceinline__ f32x16 mfma32(bf16x8 a, bf16x8 b, f32x16 c) {
  return __builtin_amdgcn_mfma_f32_32x32x16_bf16(a, b, c, 0, 0, 0);
}
__device__ __forceinline__ f32x16 zero16() {
  f32x16 z;
#pragma unroll
  for (int i = 0; i < 16; ++i) z[i] = 0.f;
  return z;
}
__device__ __forceinline__ int pslot(int i) { return (int)((0xCBA2918765430ull >> (4 * i)) & 15ull); }
__device__ __forceinline__ u16* piece(const Params& p, int i) { return (u16*)(p.ws + WS_PIECE + (size_t)pslot(i) * PIECE_SZ); }
__device__ __forceinline__ u16* slotp(const Params& p, int sl) { return (u16*)(p.ws + WS_PIECE + (size_t)sl * PIECE_SZ); }
__device__ __forceinline__ const float* xrow(const Params& p, int l, int grow) {
  if (grow < 16384) return (l == 0 ? p.x : (const float*)p.out) + (size_t)grow * 1024;
  return (l == 0 ? p.ctx : (const float*)(p.ws + WS_XC)) + (size_t)(grow - 16384) * 1024;
}
__device__ __forceinline__ int which_of(int grow) { return grow < 8192 ? 0 : (grow < 16384 ? 1 : 2); }
__device__ __forceinline__ int perm16(int s) { return (s & ~15) | (((s >> 2) & 1) << 3) | (((s >> 3) & 1) << 2) | (s & 3); }

__device__ __attribute__((always_inline)) void phase_s0(const Params& p) {
  const int tid = threadIdx.x;
  float* mod = (float*)(p.ws + WS_MOD);
  for (int it = blockIdx.x; it < 2 * 12 * 16; it += gridDim.x) {
    const int l = it / 192, rem = it % 192, nch = rem / 16, kch = rem % 16;
    const int kh = tid >> 8, n = nch * 256 + (tid & 255);
    const int k0 = kch * 64 + kh * 32;
    const float* W = p.w_mod + (size_t)l * 1024 * 3072;
    float a0 = 0.f, a1 = 0.f, a2 = 0.f;
#pragma unroll 8
    for (int k = k0; k < k0 + 32; ++k) {
      const float w = W[(size_t)k * 3072 + n];
      a0 += silu_f(p.c[k]) * w;
      a1 += silu_f(p.c[1024 + k]) * w;
      a2 += silu_f(p.c_ctx[k]) * w;
    }
    if (kch == 0 && kh == 0) {
      const float bb = p.b_mod[l * 3072 + n];
      a0 += bb; a1 += bb; a2 += bb;
    }
    atomicAdd(&mod[(l * 3 + 0) * 3072 + n], a0);
    atomicAdd(&mod[(l * 3 + 1) * 3072 + n], a1);
    atomicAdd(&mod[(l * 3 + 2) * 3072 + n], a2);
  }
  const int gi = blockIdx.x * NTHR + tid;
  if (gi < 2048) {
    const int v = gi >> 4, f = gi & 15;
    const float inv = (float)exp(-(double)f * (9.210340371976184 / 16.0));
    const float angf = (float)v * inv;
    double a = (double)angf;
    const double twopi = 6.283185307179586476925;
    a -= twopi * floor(a / twopi + 0.5);
    const double a2 = a * a;
    double ts = a, tc = 1.0, sn = a, cs = 1.0;
    for (int i = 1; i <= 14; ++i) {
      tc = -tc * a2 / (double)((2 * i - 1) * (2 * i));
      ts = -ts * a2 / (double)((2 * i) * (2 * i + 1));
      cs += tc; sn += ts;
    }
    float* rt = (float*)(p.ws + WS_ROPE);
    rt[gi * 2] = (float)cs;
    rt[gi * 2 + 1] = (float)sn;
  }
}

__device__ __attribute__((always_inline)) void conv_tile(const float* __restrict__ src, int ld, int k0, int col0, int nvalid, bool perm,
                          u16* __restrict__ dst, int ldd, int n0, unsigned char* smem) {
  u16* t = (u16*)smem;
  const int tid = opaque_tid();
#pragma unroll
  for (int i = 0; i < 2; ++i) {
    const int idx = tid + NTHR * i;
    const int kk = idx >> 4, c4 = idx & 15;
    v4f v = {0.f, 0.f, 0.f, 0.f};
    if (4 * c4 < nvalid) v = *(const v4f*)(src + (size_t)(k0 + kk) * ld + col0 + 4 * c4);
#pragma unroll
    for (int e = 0; e < 4; ++e) {
      const int j = 4 * c4 + e;
      const int jp = perm ? ((j & 1) ? 32 + (j >> 1) : (j >> 1)) : j;
      t[jp * 72 + kk] = f2bf(v[e]);
    }
  }
  __syncthreads();
  {
    const int n = tid >> 3, ch = tid & 7;
    const v4u v = *(const v4u*)(t + n * 72 + ch * 8);
    *(v4u*)(dst + (size_t)(n0 + n) * ldd + k0 + ch * 8) = v;
  }
  __syncthreads();
}

__device__ __attribute__((always_inline)) void phase_s1(const Params& p, int l, unsigned char* smem) {
  const int tid = threadIdx.x, lane = tid & 63, wave = tid >> 6;
  const float* mod = (const float*)(p.ws + WS_MOD) + (size_t)l * 3 * 3072;
  const float* g = p.norm_g + l * 1024;
  u16* H = (u16*)(p.ws + WS_H);
  float* rstd = (float*)(p.ws + WS_RSTD);
  if (blockIdx.x == 0) {
    float* gs = (float*)(p.ws + WS_GS);
    float* sh = (float*)(p.ws + WS_SH);
    for (int i = tid; i < 3072; i += NTHR) {
      const int w = i >> 10, k = i & 1023;
      gs[i] = g[k] * (1.f + mod[w * 3072 + 1024 + k]);
      sh[i] = mod[w * 3072 + k];
    }
  }
  for (int row = blockIdx.x * 8 + wave; row < R_TOT; row += gridDim.x * 8) {
    const float* xr = xrow(p, l, row);
    const int w = which_of(row);
    v4f v[4];
    float ss = 0.f;
#pragma unroll
    for (int j = 0; j < 4; ++j) {
      v[j] = *(const v4f*)(xr + lane * 4 + 256 * j);
      ss += v[j][0] * v[j][0] + v[j][1] * v[j][1] + v[j][2] * v[j][2] + v[j][3] * v[j][3];
    }
    ss = wave_sum(ss);
    const float rs = rsqrtf(ss * (1.f / 1024.f) + 1e-6f);
    if (lane == 0) rstd[row] = rs;
#pragma unroll
    for (int j = 0; j < 4; ++j) {
      const int k = lane * 4 + 256 * j;
      const v4f gg = *(const v4f*)(g + k);
      const v4f sc = *(const v4f*)(mod + w * 3072 + 1024 + k);
      const v4f sf = *(const v4f*)(mod + w * 3072 + k);
      float o[4];
#pragma unroll
      for (int e = 0; e < 4; ++e) o[e] = v[j][e] * rs * gg[e] * (1.f + sc[e]) + sf[e];
      v2u pk;
      pk[0] = pk2(o[0], o[1]);
      pk[1] = pk2(o[2], o[3]);
      *(v2u*)(H + (size_t)row * 1024 + k) = pk;
    }
  }
  u16* WTI = (u16*)(p.ws + WS_WT_IN);
  u16* WTB = (u16*)(p.ws + WS_WT_BR);
  u16* WTO = (u16*)(p.ws + WS_WT_OUT);
  const float* win = p.w_in + (size_t)l * 1024 * 9744;
  for (int it = blockIdx.x; it < 2464 + 384 + 256; it += gridDim.x) {
    if (it < 2464) {
      const int nb = it % 154, kb = it / 154;
      const int n0 = nb * 64;
      int col0 = n0, nvalid = 64;
      bool perm = n0 < 1024;
      if (n0 >= 4608 && n0 < 9728) col0 = n0 + 16;
      else if (n0 == 9728) { col0 = 4608; nvalid = 16; }
      else if (n0 > 9728) { col0 = 0; nvalid = 0; }
      conv_tile(win, 9744, kb * 64, col0, nvalid, perm, WTI, 1024, n0, smem);
    } else if (it < 2464 + 384) {
      const int j = it - 2464;
      const int n = j / 128, r = j % 128, db = r / 8, wb = r % 8;
      conv_tile(p.w_br + ((size_t)l * 3 + n) * 512 * 1024, 1024, wb * 64, db * 64, 64, false,
                WTB + (size_t)n * 1024 * 512, 512, db * 64, smem);
    } else {
      const int j = it - 2464 - 384;
      const int db = j / 16, kb = j % 16;
      conv_tile(p.w_out + (size_t)l * 1024 * 1024, 1024, kb * 64, db * 64, 64, false, WTO, 1024, db * 64, smem);
    }
  }
}

template <int AMODE, int MI>
__device__ __forceinline__ void gemm_core(f32x16 (&acc)[MI][2], const u16* __restrict__ A, int lda,
                                          const float* __restrict__ Ax, const float* __restrict__ rstd,
                                          const float* __restrict__ gs, const float* __restrict__ sh,
                                          const u16* __restrict__ B, int K, unsigned char* smem) {
  constexpr int AROWS = 128 * MI;
  u16* As = (u16*)smem;
  u16* Bs = (u16*)(smem + 73728);
  const int tid = opaque_tid(), lane = tid & 63, wave = tid >> 6;
  const int wm = wave >> 1, wn = wave & 1, r = lane & 31, hh = lane >> 5;
  const int lrow = tid >> 3, c8 = tid & 7;
  v4u ra[2][2 * MI], rb[2][2];
  float rs4[2 * MI];
  if (AMODE == 1) {
#pragma unroll
    for (int i = 0; i < 2 * MI; ++i) rs4[i] = rstd[lrow + 64 * i];
  }
  const int KT = K >> 6;
#define GEMM_LOAD(set, k0)                                                                        \
  {                                                                                               \
    if (AMODE == 0) {                                                                             \
      _Pragma("unroll") for (int i = 0; i < 2 * MI; ++i)                                          \
        ra[set][i] = *(const v4u*)(A + (size_t)(lrow + 64 * i) * lda + (k0) + c8 * 8);            \
    } else {                                                                                      \
      const v4f g0 = *(const v4f*)(gs + (k0) + c8 * 8), g1 = *(const v4f*)(gs + (k0) + c8 * 8 + 4); \
      const v4f s0 = *(const v4f*)(sh + (k0) + c8 * 8), s1 = *(const v4f*)(sh + (k0) + c8 * 8 + 4); \
      _Pragma("unroll") for (int i = 0; i < 2 * MI; ++i) {                                        \
        const float* xp = Ax + (size_t)(lrow + 64 * i) * 1024 + (k0) + c8 * 8;                    \
        const v4f x0 = *(const v4f*)xp, x1 = *(const v4f*)(xp + 4);                               \
        const float rr = rs4[i];                                                                  \
        ra[set][i][0] = pk2(x0[0] * rr * g0[0] + s0[0], x0[1] * rr * g0[1] + s0[1]);              \
        ra[set][i][1] = pk2(x0[2] * rr * g0[2] + s0[2], x0[3] * rr * g0[3] + s0[3]);              \
        ra[set][i][2] = pk2(x1[0] * rr * g1[0] + s1[0], x1[1] * rr * g1[1] + s1[1]);              \
        ra[set][i][3] = pk2(x1[2] * rr * g1[2] + s1[2], x1[3] * rr * g1[3] + s1[3]);              \
      }                                                                                           \
    }                                                                                             \
    _Pragma("unroll") for (int i = 0; i < 2; ++i)                                                 \
        rb[set][i] = *(const v4u*)(B + (size_t)(lrow + 64 * i) * K + (k0) + c8 * 8);              \
  }
#define GEMM_STORE(set, buf)                                                                      \
  {                                                                                               \
    _Pragma("unroll") for (int i = 0; i < 2 * MI; ++i)                                            \
        *(v4u*)(As + (buf) * AROWS * 72 + (lrow + 64 * i) * 72 + c8 * 8) = ra[set][i];            \
    _Pragma("unroll") for (int i = 0; i < 2; ++i)                                                 \
        *(v4u*)(Bs + (buf) * 128 * 72 + (lrow + 64 * i) * 72 + c8 * 8) = rb[set][i];              \
  }
#define GEMM_COMPUTE(cur)                                                                         \
  {                                                                                               \
    const u16* Ab = As + (cur) * AROWS * 72 + (32 * MI * wm + r) * 72 + 8 * hh;                   \
    const u16* Bb = Bs + (cur) * 128 * 72 + (64 * wn + r) * 72 + 8 * hh;                          \
    _Pragma("unroll") for (int ks = 0; ks < 4; ++ks) {                                            \
      const bf16x8 b0 = *(const bf16x8*)(Bb + ks * 16);                                           \
      const bf16x8 b1 = *(const bf16x8*)(Bb + 32 * 72 + ks * 16);                                 \
      _Pragma("unroll") for (int i = 0; i < MI; ++i) {                                            \
        const bf16x8 a0 = *(const bf16x8*)(Ab + i * 32 * 72 + ks * 16);                           \
        acc[i][0] = mfma32(a0, b0, acc[i][0]);                                                    \
        acc[i][1] = mfma32(a0, b1, acc[i][1]);                                                    \
      }                                                                                           \
    }                                                                                             \
  }
  GEMM_LOAD(0, 0);
  GEMM_LOAD(1, 64);
  GEMM_STORE(0, 0);
  __syncthreads();
  for (int kt = 0; kt < KT; kt += 2) {
    if (kt + 2 < KT) GEMM_LOAD(0, (kt + 2) * 64);
    GEMM_COMPUTE(0);
    GEMM_STORE(1, 1);
    __syncthreads();
    if (kt + 3 < KT) GEMM_LOAD(1, (kt + 3) * 64);
    GEMM_COMPUTE(1);
    if (kt + 2 < KT) GEMM_STORE(0, 0);
    __syncthreads();
  }
#undef GEMM_COMPUTE
#undef GEMM_LOAD
#undef GEMM_STORE
}

template <int LEAN>
__device__ __forceinline__ void gemm_core256(f32x16 (&acc)[2][4], const u16* __restrict__ A, int lda,
                                             const u16* __restrict__ B, int K, unsigned char* smem) {
  u16* As = (u16*)smem;
  u16* Bs = (u16*)(smem + 73728);
  const int tid = opaque_tid(), lane = tid & 63, wave = tid >> 6;
  const int wm = wave >> 1, wn = wave & 1, r = lane & 31, hh = lane >> 5;
  const int lrow = tid >> 3, c8 = tid & 7;
  v4u ra[4], rb[4];
  const int KT = K >> 6;
#define G2_LOAD(k0)                                                                               \
  {                                                                                               \
    _Pragma("unroll") for (int i = 0; i < 4; ++i) {                                               \
      ra[i] = *(const v4u*)(A + (size_t)(lrow + 64 * i) * lda + (k0) + c8 * 8);                   \
      rb[i] = *(const v4u*)(B + (size_t)(lrow + 64 * i) * K + (k0) + c8 * 8);                     \
    }                                                                                             \
  }
#define G2_STORE(buf)                                                                             \
  {                                                                                               \
    _Pragma("unroll") for (int i = 0; i < 4; ++i) {                                               \
      *(v4u*)(As + (buf) * 256 * 72 + (lrow + 64 * i) * 72 + c8 * 8) = ra[i];                     \
      *(v4u*)(Bs + (buf) * 256 * 72 + (lrow + 64 * i) * 72 + c8 * 8) = rb[i];                     \
    }                                                                                             \
  }
  G2_LOAD(0);
  G2_STORE(0);
  __syncthreads();
  if (KT > 1) G2_LOAD(64);
  for (int kt = 0; kt < KT; ++kt) {
    const int cur = kt & 1;
    const u16* Ab = As + cur * 256 * 72 + (64 * wm + r) * 72 + 8 * hh;
    const u16* Bb = Bs + cur * 256 * 72 + (128 * wn + r) * 72 + 8 * hh;
#pragma unroll
    for (int ks = 0; ks < 4; ++ks) {
      if (LEAN) __builtin_amdgcn_sched_barrier(0);
      const bf16x8 a0 = *(const bf16x8*)(Ab + ks * 16);
      const bf16x8 a1 = *(const bf16x8*)(Ab + 32 * 72 + ks * 16);
#pragma unroll
      for (int j = 0; j < 4; ++j) {
        const bf16x8 b0 = *(const bf16x8*)(Bb + j * 32 * 72 + ks * 16);
        acc[0][j] = mfma32(a0, b0, acc[0][j]);
        acc[1][j] = mfma32(a1, b0, acc[1][j]);
      }
    }
    if (kt + 1 < KT) {
      G2_STORE(cur ^ 1);
      if (kt + 2 < KT) G2_LOAD((kt + 2) * 64);
    }
    __syncthreads();
  }
#undef G2_LOAD
#undef G2_STORE
}

__device__ __forceinline__ void s2_store64(const Params& p, int grp, const f32x16& a0, const f32x16& a1, int rowbase, int fb64,
                                           bool latent, int b, int keyb, int r, int hh, const float* __restrict__ rope) {
  if (grp == P_VTA || grp == P_VTB || grp == P_VTC) {
    u16* VT = piece(p, grp);
#pragma unroll
    for (int j = 0; j < 2; ++j) {
      const int f = fb64 + 32 * j + r;
#pragma unroll
      for (int q = 0; q < 4; ++q) {
        const int key = keyb + 16 * (q >> 1) + 4 * (hh * 2 + (q & 1));
        v2u pk;
        if (j == 0) { pk[0] = pk2(a0[4 * q], a0[4 * q + 1]); pk[1] = pk2(a0[4 * q + 2], a0[4 * q + 3]); }
        else { pk[0] = pk2(a1[4 * q], a1[4 * q + 1]); pk[1] = pk2(a1[4 * q + 2], a1[4 * q + 3]); }
        *(v2u*)(VT + ((size_t)(b * 512 + f)) * NKEY + key) = pk;
      }
    }
  } else {
    u16* D = piece(p, grp);
    const bool rot = latent && (grp == P_QA || grp == P_KA);
    const float qs = (grp == P_QA || grp == P_QC) ? 0.18033688011112042f : 1.f;
#pragma unroll
    for (int e = 0; e < 16; ++e) {
      const int row = rowbase + (e & 3) + 8 * (e >> 2) + 4 * hh;
      float v0 = a0[e], v1 = a1[e];
      if (rot) {
        const int t = row & 8191;
        const int vv = (r < 16) ? (t >> 6) : (t & 63);
        const float cs = rope[(vv * 16 + (r & 15)) * 2], sn = rope[(vv * 16 + (r & 15)) * 2 + 1];
        const float o0 = v0 * cs - v1 * sn, o1 = v0 * sn + v1 * cs;
        v0 = o0; v1 = o1;
      }
      D[(size_t)row * 512 + fb64 + r] = f2bf(v0 * qs);
      D[(size_t)row * 512 + fb64 + 32 + r] = f2bf(v1 * qs);
    }
  }
}

__device__ __attribute__((always_inline)) void phase_s2(const Params& p, int l, unsigned char* smem) {
  const int tid = opaque_tid(), lane = tid & 63, wave = tid >> 6;
  const int wm = wave >> 1, wn = wave & 1, r = lane & 31, hh = lane >> 5;
  const u16* H = (const u16*)(p.ws + WS_H);
  const u16* WTI = (const u16*)(p.ws + WS_WT_IN);
  const float* rope = (const float*)(p.ws + WS_ROPE);
  float* G = (float*)(p.ws + WS_G);
  {
    const bool xs = (gridDim.x & 7) == 0;
    const int nb = xs ? (gridDim.x >> 3) : gridDim.x;
    const int xcd = xs ? (blockIdx.x & 7) : 0, slot = xs ? (blockIdx.x >> 3) : blockIdx.x;
    const int nx = xs ? 8 : 1;
    const int seg0 = (1716 * xcd) / nx, seg1 = (1716 * (xcd + 1)) / nx;
#pragma unroll 1
    for (int L = seg0 + slot; L < seg1; L += nb) {
      int rt, ct;
      if (L < 1664) { const int g = L / 208, rem = L % 208; ct = rem >> 3; rt = 8 * g + (rem & 7); }
      else { const int rem = L - 1664; ct = rem >> 1; rt = 64 + (rem & 1); }
      const int row0 = rt * 256, n0 = ct * 256;
      f32x16 acc[2][4];
#pragma unroll
      for (int i = 0; i < 2; ++i)
#pragma unroll
        for (int j = 0; j < 4; ++j) acc[i][j] = zero16();
      gemm_core256<1>(acc, H + (size_t)row0 * 1024, 1024, WTI + (size_t)n0 * 1024, 1024, smem);
      const bool latent = row0 < 16384;
      const int b = latent ? (row0 >> 13) : ((row0 - 16384) >> 8);
      const int keybase = latent ? (row0 & 8191) : 8192;
      const int grp = n0 >> 9;
      const int fbase = (n0 & 511) + 128 * wn;
#pragma unroll
      for (int i = 0; i < 2; ++i)
#pragma unroll
        for (int g2 = 0; g2 < 2; ++g2)
          s2_store64(p, grp, acc[i][2 * g2], acc[i][2 * g2 + 1], row0 + 64 * wm + 32 * i, fbase + 64 * g2, latent, b,
                     keybase + 64 * wm + 32 * i, r, hh, rope);
    }
  }
#pragma unroll 1
  for (int rt = blockIdx.x; rt < 66; rt += gridDim.x) {
    const int row0 = rt * 256;
    f32x16 acc[2][2];
    acc[0][0] = zero16(); acc[0][1] = zero16(); acc[1][0] = zero16(); acc[1][1] = zero16();
    gemm_core<0, 2>(acc, H + (size_t)row0 * 1024, 1024, nullptr, nullptr, nullptr, nullptr, WTI + (size_t)9728 * 1024, 1024, smem);
    if (wn == 0) {
#pragma unroll
      for (int i = 0; i < 2; ++i)
#pragma unroll
        for (int e = 0; e < 16; ++e) {
          const int row = row0 + 64 * wm + 32 * i + (e & 3) + 8 * (e >> 2) + 4 * hh;
          if (r < 16) G[(size_t)row * 16 + r] = acc[i][0][e];
        }
    }
  }
}

__device__ __attribute__((always_inline)) void attn_item(const Params& p, int l, int b, int h, int qgrow0, int kt0, int kt1, unsigned char* smem) {
  u16* Ks = (u16*)smem;
  u16* Vs = (u16*)(smem + 34816);
  const int tid = opaque_tid(), lane = tid & 63, wave = tid >> 6;
  const int c = wave & 1, qg = wave >> 1, r = lane & 31, hh = lane >> 5;
  u16* QA = piece(p, P_QA);
  const u16* KA = piece(p, P_KA);
  const u16* VT = piece(p, P_VTA);
  const u16* ZA = piece(p, P_ZA);
  const float lam_init = 0.8f - 0.6f * expf(-0.3f * (float)l);
  float lam;
  {
    const float* lq = p.lam_q + l * 128;
    const float* lk = p.lam_k + l * 128;
    const float s0 = wave_sum(lq[lane] * lk[lane]);
    const float s1 = wave_sum(lq[64 + lane] * lk[64 + lane]);
    lam = expf(s0) - expf(s1) + lam_init;
  }
  const int qrow = qgrow0 + qg * 32 + r;
  bf16x8 qf[4];
#pragma unroll
  for (int ks = 0; ks < 4; ++ks) qf[ks] = *(const bf16x8*)(QA + (size_t)qrow * 512 + h * 128 + c * 64 + ks * 16 + hh * 8);
  f32x16 O[4];
#pragma unroll
  for (int i = 0; i < 4; ++i) O[i] = zero16();
  float m = -1e30f, lsum = 0.f;
  const int krow_l = tid >> 4, kc16 = tid & 15;
  const int vrow_l = tid >> 3, vc8 = tid & 7;
  v4u rk[2], rv[2];
#define ATT_LOADK(kt)                                                                             \
  {                                                                                               \
    const int key0 = (kt) * 64;                                                                   \
    const int gbase = (key0 < 8192) ? (b * 8192 + key0) : (16384 + b * 256 + key0 - 8192);        \
    _Pragma("unroll") for (int i = 0; i < 2; ++i)                                                 \
      rk[i] = *(const v4u*)(KA + (size_t)(gbase + krow_l + 32 * i) * 512 + h * 128 + kc16 * 8);   \
  }
#define ATT_LOADV(kt)                                                                             \
  {                                                                                               \
    const int key0 = (kt) * 64;                                                                   \
    _Pragma("unroll") for (int i = 0; i < 2; ++i)                                                 \
      rv[i] = *(const v4u*)(VT + ((size_t)(b * 512 + h * 128 + vrow_l + 64 * i)) * NKEY + key0 + vc8 * 8); \
  }
#define ATT_STOREK(buf)                                                                           \
  {                                                                                               \
    _Pragma("unroll") for (int i = 0; i < 2; ++i)                                                 \
      *(v4u*)(Ks + (buf) * 64 * 136 + (krow_l + 32 * i) * 136 + kc16 * 8) = rk[i];                \
  }
#define ATT_STOREV(buf)                                                                           \
  {                                                                                               \
    _Pragma("unroll") for (int i = 0; i < 2; ++i)                                                 \
      *(v4u*)(Vs + (buf) * 128 * 72 + (vrow_l + 64 * i) * 72 + vc8 * 8) = rv[i];                  \
  }
#define ATT_QK(Sx, buf)                                                                           \
  {                                                                                               \
    _Pragma("unroll") for (int kk = 0; kk < 2; ++kk) {                                            \
      Sx[kk] = zero16();                                                                          \
      _Pragma("unroll") for (int ks = 0; ks < 4; ++ks) {                                          \
        const bf16x8 kf = *(const bf16x8*)(Ks + (buf) * 64 * 136 + (32 * kk + r) * 136 + c * 64 + ks * 16 + hh * 8); \
        Sx[kk] = mfma32(kf, qf[ks], Sx[kk]);                                                      \
      }                                                                                           \
    }                                                                                             \
  }
  ATT_LOADK(kt0);
  ATT_LOADV(kt0);
  ATT_STOREK(0);
  ATT_STOREV(0);
  if (kt0 + 1 < kt1) { ATT_LOADK(kt0 + 1); ATT_STOREK(1); }
  __syncthreads();
  f32x16 S[2], Sn[2];
  ATT_QK(S, 0);
  if (kt0 + 2 < kt1) ATT_LOADK(kt0 + 2);
  if (kt0 + 1 < kt1) ATT_LOADV(kt0 + 1);
  for (int kt = kt0; kt < kt1; ++kt) {
    const int cur = (kt - kt0) & 1;
    if (kt + 1 < kt1) ATT_QK(Sn, cur ^ 1);
    float mx = -1e30f;
#pragma unroll
    for (int kk = 0; kk < 2; ++kk)
#pragma unroll
      for (int e = 0; e < 16; ++e) mx = fmaxf(mx, S[kk][e]);
    mx = fmaxf(mx, __shfl_xor(mx, 32, 64));
    const float mnew = fmaxf(m, mx);
    if (__builtin_amdgcn_ballot_w64(mnew > m) != 0ull) {
      const float alpha = ex2(m - mnew);
      lsum *= alpha;
#pragma unroll
      for (int i = 0; i < 4; ++i)
#pragma unroll
        for (int e = 0; e < 16; ++e) O[i][e] *= alpha;
    }
    m = mnew;
    bf16x8 pf[4];
#pragma unroll
    for (int kk = 0; kk < 2; ++kk)
#pragma unroll
      for (int s2 = 0; s2 < 2; ++s2) {
        v4u pkd;
#pragma unroll
        for (int jj = 0; jj < 4; ++jj) {
          const float p0 = ex2(S[kk][8 * s2 + 2 * jj] - mnew);
          const float p1 = ex2(S[kk][8 * s2 + 2 * jj + 1] - mnew);
          lsum += p0 + p1;
          pkd[jj] = pk2(p0, p1);
        }
        pf[2 * kk + s2] = (bf16x8)pkd;
      }
#pragma unroll
    for (int dvt = 0; dvt < 4; ++dvt)
#pragma unroll
      for (int s = 0; s < 4; ++s) {
        const bf16x8 vf = *(const bf16x8*)(Vs + cur * 128 * 72 + (32 * dvt + r) * 72 + 16 * s + 8 * hh);
        O[dvt] = mfma32(vf, pf[s], O[dvt]);
      }
    if (kt + 2 < kt1) ATT_STOREK(cur);
    if (kt + 1 < kt1) ATT_STOREV(cur ^ 1);
    if (kt + 3 < kt1) ATT_LOADK(kt + 3);
    if (kt + 2 < kt1) ATT_LOADV(kt + 2);
    __syncthreads();
    S[0] = Sn[0];
    S[1] = Sn[1];
  }
#undef ATT_LOADK
#undef ATT_LOADV
#undef ATT_STOREK
#undef ATT_STOREV
#undef ATT_QK
  const float ltot = lsum + __shfl_xor(lsum, 32, 64);
  const float inv = 1.f / ltot;
  float* X = (float*)smem;
  if (c == 1) {
#pragma unroll
    for (int dvt = 0; dvt < 4; ++dvt)
#pragma unroll
      for (int e = 0; e < 16; ++e) X[(qg * 128 + 32 * dvt + (e & 3) + 8 * (e >> 2) + 4 * hh) * 32 + r] = O[dvt][e] * inv;
  }
  __syncthreads();
  if (c == 0) {
    float ss = 0.f;
#pragma unroll
    for (int dvt = 0; dvt < 4; ++dvt)
#pragma unroll
      for (int e = 0; e < 16; ++e) {
        const float o = O[dvt][e] * inv - lam * X[(qg * 128 + 32 * dvt + (e & 3) + 8 * (e >> 2) + 4 * hh) * 32 + r];
        O[dvt][e] = o;
        ss += o * o;
      }
    ss += __shfl_xor(ss, 32, 64);
    const float rinv = rsqrtf(ss * (1.f / 128.f) + 1e-6f) * (1.f - lam_init);
    const float* dg = p.da_g + l * 128;
#pragma unroll
    for (int dvt = 0; dvt < 4; ++dvt)
#pragma unroll
      for (int g = 0; g < 4; ++g) {
        const int dv0 = 32 * dvt + 8 * g + 4 * hh;
        const size_t off = (size_t)qrow * 512 + h * 128 + dv0;
        const v2u z = *(const v2u*)(ZA + off);
        const float y0 = O[dvt][4 * g] * rinv * dg[dv0] * silu_f(bflo(z[0]));
        const float y1 = O[dvt][4 * g + 1] * rinv * dg[dv0 + 1] * silu_f(bfhi(z[0]));
        const float y2 = O[dvt][4 * g + 2] * rinv * dg[dv0 + 2] * silu_f(bflo(z[1]));
        const float y3 = O[dvt][4 * g + 3] * rinv * dg[dv0 + 3] * silu_f(bfhi(z[1]));
        v2u o;
        o[0] = pk2(y0, y1);
        o[1] = pk2(y2, y3);
        *(v2u*)(QA + off) = o;
      }
  }
  __syncthreads();
}

__device__ __attribute__((always_inline)) void natten_item(const Params& p, int l, int b, int rr, int qgrow, int i0, unsigned char* smem) {
  float* rp = (float*)smem;
  const int tid = opaque_tid(), lane = tid & 63, head = tid >> 6;
  const int r = lane & 31, hh = lane >> 5;
  for (int i = tid; i < 3720; i += NTHR) rp[i] = p.rpb[(size_t)l * 3720 + i];
  __syncthreads();
  u16* QC = piece(p, P_QC);
  const u16* KC = piece(p, P_KC);
  const u16* VT = piece(p, P_VTC);
  const u16* ZC = piece(p, P_ZC);
  const int rs = min(max(rr - 4, 0), 120);
  bf16x8 qf[2][4];
#pragma unroll
  for (int qt = 0; qt < 2; ++qt)
#pragma unroll
    for (int ks = 0; ks < 4; ++ks)
      qf[qt][ks] = *(const bf16x8*)(QC + (size_t)(qgrow + 32 * qt + r) * 512 + head * 64 + ks * 16 + hh * 8);
  f32x16 O[2][2];
  O[0][0] = zero16(); O[0][1] = zero16(); O[1][0] = zero16(); O[1][1] = zero16();
  float m[2] = {-1e30f, -1e30f}, lsum[2] = {0.f, 0.f};
  const float L2E = 1.4426950408889634f;
  for (int i = i0; i < 12; ++i) {
    const bool local = i < 8;
    const int krow = rs + i;
    const int kg0 = local ? (b * 8192 + krow * 64) : (16384 + b * 256 + (i - 8) * 64);
    const int key0 = local ? krow * 64 : 8192 + (i - 8) * 64;
    f32x16 S[2][2];
    S[0][0] = zero16(); S[0][1] = zero16(); S[1][0] = zero16(); S[1][1] = zero16();
#pragma unroll
    for (int kk = 0; kk < 2; ++kk)
#pragma unroll
      for (int ks = 0; ks < 4; ++ks) {
        const bf16x8 kf = *(const bf16x8*)(KC + (size_t)(kg0 + 32 * kk + r) * 512 + head * 64 + ks * 16 + hh * 8);
        S[kk][0] = mfma32(kf, qf[0][ks], S[kk][0]);
        S[kk][1] = mfma32(kf, qf[1][ks], S[kk][1]);
      }
    bf16x8 pf[2][4];
#pragma unroll
    for (int qt = 0; qt < 2; ++qt) {
      const int qcol = 32 * qt + r;
      const int cs = min(max(qcol - 8, 0), 48);
      const float* rprow = rp + (head * 15 + (local ? (krow - rr + 7) : 0)) * 31 + 15 - qcol;
      float mx = -1e30f;
#pragma unroll
      for (int kk = 0; kk < 2; ++kk)
#pragma unroll
        for (int e = 0; e < 16; ++e) {
          const int kcol = 32 * kk + (e & 3) + 8 * (e >> 2) + 4 * hh;
          float s = S[kk][qt][e];
          if (local) {
            const bool valid = (kcol >= cs) && (kcol < cs + 16);
            const int ci = min(max(kcol, cs), cs + 15);
            s = valid ? (s + rprow[ci] * L2E) : -1e30f;
          }
          S[kk][qt][e] = s;
          mx = fmaxf(mx, s);
        }
      mx = fmaxf(mx, __shfl_xor(mx, 32, 64));
      const float mnew = fmaxf(m[qt], mx);
      if (__builtin_amdgcn_ballot_w64(mnew > m[qt]) != 0ull) {
        const float alpha = ex2(m[qt] - mnew);
        lsum[qt] *= alpha;
#pragma unroll
        for (int dvt = 0; dvt < 2; ++dvt)
#pragma unroll
          for (int e = 0; e < 16; ++e) O[dvt][qt][e] *= alpha;
      }
      m[qt] = mnew;
#pragma unroll
      for (int kk = 0; kk < 2; ++kk)
#pragma unroll
        for (int s2 = 0; s2 < 2; ++s2) {
          v4u pkd;
#pragma unroll
          for (int jj = 0; jj < 4; ++jj) {
            const float p0 = ex2(S[kk][qt][8 * s2 + 2 * jj] - mnew);
            const float p1 = ex2(S[kk][qt][8 * s2 + 2 * jj + 1] - mnew);
            lsum[qt] += p0 + p1;
            pkd[jj] = pk2(p0, p1);
          }
          pf[qt][2 * kk + s2] = (bf16x8)pkd;
        }
    }
#pragma unroll
    for (int dvt = 0; dvt < 2; ++dvt)
#pragma unroll
      for (int s = 0; s < 4; ++s) {
        const bf16x8 vf = *(const bf16x8*)(VT + ((size_t)(b * 512 + head * 64 + 32 * dvt + r)) * NKEY + key0 + 16 * s + 8 * hh);
        O[dvt][0] = mfma32(vf, pf[0][s], O[dvt][0]);
        O[dvt][1] = mfma32(vf, pf[1][s], O[dvt][1]);
      }
  }
#pragma unroll
  for (int qt = 0; qt < 2; ++qt) {
    const float inv = 1.f / (lsum[qt] + __shfl_xor(lsum[qt], 32, 64));
    const int qrow = qgrow + 32 * qt + r;
#pragma unroll
    for (int dvt = 0; dvt < 2; ++dvt)
#pragma unroll
      for (int g = 0; g < 4; ++g) {
        const int dv0 = 32 * dvt + 8 * g + 4 * hh;
        const size_t off = (size_t)qrow * 512 + head * 64 + dv0;
        const v2u z = *(const v2u*)(ZC + off);
        v2u o;
        o[0] = pk2(O[dvt][qt][4 * g] * inv * silu_f(bflo(z[0])), O[dvt][qt][4 * g + 1] * inv * silu_f(bfhi(z[0])));
        o[1] = pk2(O[dvt][qt][4 * g + 2] * inv * silu_f(bflo(z[1])), O[dvt][qt][4 * g + 3] * inv * silu_f(bfhi(z[1])));
        *(v2u*)(QC + off) = o;
      }
  }
  __syncthreads();
}

__device__ __forceinline__ float logsigmoid_f(float x) { return fminf(x, 0.f) - log1pf(__expf(-fabsf(x))); }
__device__ __forceinline__ int chunk_grow0(int b, int P) { return P < 2 ? 16384 + b * 256 + 128 * P : b * 8192 + 128 * (P - 2); }
__device__ __forceinline__ int chunk_key0(int P) { return P < 2 ? 8192 + 128 * P : 128 * (P - 2); }

__device__ __forceinline__ void mlstm_gates(const Params& p, int l, int head, int grow0, float* lf, float* li) {
  const int tid = opaque_tid();
  if (tid < 256) {
    const int d = tid >> 7, s = tid & 127;
    const float* G = (const float*)(p.ws + WS_G) + (size_t)(grow0 + s) * 16;
    const float gi = G[d * 8 + head] + p.gate_b[l * 16 + d * 8 + head];
    const float gf = G[d * 8 + 4 + head] + p.gate_b[l * 16 + d * 8 + 4 + head];
    li[d * 128 + s] = gi;
    lf[d * 128 + s] = logsigmoid_f(gf);
  }
}

__device__ __forceinline__ void conv8(const Params& p, int l, const u16* src, int grow, int fcol, int ch0, bool hasprev,
                                      bool hasnext, float scale, float (&o)[8]) {
  const v4u zero = {0u, 0u, 0u, 0u};
  const v4u xm = hasprev ? *(const v4u*)(src + (size_t)(grow - 1) * 512 + fcol) : zero;
  const v4u x0 = *(const v4u*)(src + (size_t)grow * 512 + fcol);
  const v4u xp = hasnext ? *(const v4u*)(src + (size_t)(grow + 1) * 512 + fcol) : zero;
  const float* cw = p.conv_w + (size_t)l * 3 * 1024 + ch0;
  const float* cb = p.conv_b + (size_t)l * 1024 + ch0;
#pragma unroll
  for (int e = 0; e < 8; ++e) {
    const float a = (e & 1) ? bfhi(xm[e >> 1]) : bflo(xm[e >> 1]);
    const float bq = (e & 1) ? bfhi(x0[e >> 1]) : bflo(x0[e >> 1]);
    const float cq = (e & 1) ? bfhi(xp[e >> 1]) : bflo(xp[e >> 1]);
    const float y = a * cw[e] + bq * cw[1024 + e] + cq * cw[2048 + e] + cb[e];
    o[e] = silu_f(y) * scale;
  }
}

__device__ __attribute__((always_inline)) void mlstm_b1_item(const Params& p, int l, int b, int head, int P, unsigned char* smem) {
  u16* kwT = (u16*)smem;
  float* lf = (float*)(smem + 69632);
  float* li = lf + 256;
  float* wS = li + 256;
  const int tid = opaque_tid(), lane = tid & 63, wave = tid >> 6;
  const int r = lane & 31, hh = lane >> 5;
  const int grow0 = chunk_grow0(b, P), key0 = chunk_key0(P);
  float* BL = (float*)(p.ws + WS_BL);
  float* DN = (float*)(p.ws + WS_DN);
  u16* CST = (u16*)(p.ws + WS_H);
  mlstm_gates(p, l, head, grow0, lf, li);
  __syncthreads();
  if (tid < 256) {
    const int d = tid >> 7, s = tid & 127;
    float tot = 0.f, bs = 0.f;
    for (int j = 0; j < 128; ++j) {
      const float v = lf[d * 128 + j];
      tot += v;
      if (d == 0 ? (j <= s) : (j >= s)) bs += v;
    }
    wS[d * 128 + s] = __expf(tot - bs + li[d * 128 + s]);
    if (s == 0) BL[((b * 4 + head) * 2 + d) * 66 + P] = tot;
  }
  __syncthreads();
  const u16* KB = piece(p, P_KB);
#pragma unroll 1
  for (int i = 0; i < 4; ++i) {
    const int u = tid + NTHR * i;
    const int s = u >> 4, dg = u & 15;
    const bool hasprev = !((P == 0 || P == 2) && s == 0);
    const bool hasnext = !((P == 1 || P == 65) && s == 127);
    float kc[8];
    conv8(p, l, KB, grow0 + s, head * 128 + dg * 8, 512 + head * 128 + dg * 8, hasprev, hasnext, 0.08838834764831845f, kc);
    const int ps = perm16(s);
    const float w0 = wS[s], w1 = wS[128 + s];
#pragma unroll
    for (int e = 0; e < 8; ++e) {
      kwT[(dg * 8 + e) * 136 + ps] = f2bf(kc[e] * w0);
      kwT[(128 + dg * 8 + e) * 136 + ps] = f2bf(kc[e] * w1);
    }
  }
  __syncthreads();
  {
    const int d = wave >> 2, dvt = wave & 3;
    const u16* VT = piece(p, P_VTB);
    bf16x8 vf[8];
#pragma unroll
    for (int s8 = 0; s8 < 8; ++s8)
      vf[s8] = *(const bf16x8*)(VT + ((size_t)(b * 512 + head * 128 + 32 * dvt + r)) * NKEY + key0 + 16 * s8 + 8 * hh);
    const int chain = (b * 4 + head) * 2 + d;
    u16* dst = CST + ((size_t)(chain * 66 + P)) * 16384;
#pragma unroll
    for (int dkt = 0; dkt < 4; ++dkt) {
      f32x16 acc = zero16();
#pragma unroll
      for (int s8 = 0; s8 < 8; ++s8) {
        const bf16x8 kf = *(const bf16x8*)(kwT + (d * 128 + 32 * dkt + r) * 136 + 16 * s8 + 8 * hh);
        acc = mfma32(vf[s8], kf, acc);
      }
#pragma unroll
      for (int e = 0; e < 16; ++e) {
        const int dv = 32 * dvt + (e & 3) + 8 * (e >> 2) + 4 * hh;
        dst[dv * 128 + 32 * dkt + r] = f2bf(acc[e]);
      }
    }
  }
  if (tid < 256) {
    const int d = tid >> 7, dk = tid & 127;
    float s = 0.f;
    for (int j = 0; j < 128; ++j) s += bf2f(kwT[(d * 128 + dk) * 136 + j]);
    DN[(((b * 4 + head) * 2 + d) * 66 + P) * 128 + dk] = s;
  }
  __syncthreads();
}

__device__ __attribute__((always_inline)) void phase_b2(const Params& p) {
  const int gid = blockIdx.x * NTHR + threadIdx.x;
  const float* BL = (const float*)(p.ws + WS_BL);
  if (gid < 131072) {
    const int chain = gid >> 13, e2 = gid & 8191;
    const int d = chain & 1;
    unsigned* base = (unsigned*)(p.ws + WS_H) + (size_t)chain * 66 * 8192 + e2;
    float c0 = 0.f, c1 = 0.f;
    for (int i0 = 0; i0 < 66; i0 += 6) {
      unsigned v[6];
      float a[6];
#pragma unroll
      for (int j = 0; j < 6; ++j) {
        const int i = i0 + j;
        const int P = d == 0 ? i : (i < 2 ? 1 - i : 67 - i);
        v[j] = base[(size_t)P * 8192];
        a[j] = __expf(BL[chain * 66 + P]);
      }
#pragma unroll
      for (int j = 0; j < 6; ++j) {
        const int i = i0 + j;
        const int P = d == 0 ? i : (i < 2 ? 1 - i : 67 - i);
        base[(size_t)P * 8192] = pk2(c0, c1);
        c0 = a[j] * c0 + bflo(v[j]);
        c1 = a[j] * c1 + bfhi(v[j]);
      }
    }
  }
  if (gid < 2048) {
    const int chain = gid >> 7, dk = gid & 127;
    const int d = chain & 1;
    const float* DN = (const float*)(p.ws + WS_DN);
    float* NP = (float*)(p.ws + WS_NPREV);
    float run = 0.f;
    for (int i = 0; i < 66; ++i) {
      const int P = d == 0 ? i : (i < 2 ? 1 - i : 67 - i);
      NP[(chain * 66 + P) * 128 + dk] = run;
      run = __expf(BL[chain * 66 + P]) * run + DN[(chain * 66 + P) * 128 + dk];
    }
  }
}

__device__ __attribute__((always_inline)) void mlstm_b3_item(const Params& p, int l, int b, int head, int P, unsigned char* smem) {
  u16* qS = (u16*)smem;
  u16* kS = (u16*)(smem + 34816);
  u16* pS = (u16*)(smem + 69632);
  float* fb = (float*)(smem + 104448);
  float* lf = fb;
  float* li = fb + 256;
  float* bc = fb + 512;
  float* colsum = fb + 768;
  float* nS = fb + 1280;
  float* nq = fb + 1536;
  float* cfs = fb + 1792;
  float* hsq = fb + 2048;
  const int tid = opaque_tid(), lane = tid & 63, wave = tid >> 6;
  const int r = lane & 31, hh = lane >> 5;
  const int grow0 = chunk_grow0(b, P), key0 = chunk_key0(P);
  const int chainF = (b * 4 + head) * 2, chainB = chainF + 1;
  mlstm_gates(p, l, head, grow0, lf, li);
  __syncthreads();
  if (tid < 256) {
    const int d = tid >> 7, s = tid & 127;
    float bs = 0.f;
    for (int j = 0; j < 128; ++j) {
      const float v = lf[d * 128 + j];
      if (d == 0 ? (j <= s) : (j >= s)) bs += v;
    }
    bc[d * 128 + s] = bs;
    nS[d * 128 + s] = ((const float*)(p.ws + WS_NPREV))[((chainF + d) * 66 + P) * 128 + s];
  }
  {
    const u16* QB = piece(p, P_QB);
    const u16* KB = piece(p, P_KB);
#pragma unroll 1
    for (int i = 0; i < 4; ++i) {
      const int u = tid + NTHR * i;
      const int s = u >> 4, dg = u & 15;
      const bool hasprev = !((P == 0 || P == 2) && s == 0);
      const bool hasnext = !((P == 1 || P == 65) && s == 127);
      float o[8];
      conv8(p, l, QB, grow0 + s, head * 128 + dg * 8, head * 128 + dg * 8, hasprev, hasnext, 1.f, o);
      v4u pk;
      pk[0] = pk2(o[0], o[1]); pk[1] = pk2(o[2], o[3]); pk[2] = pk2(o[4], o[5]); pk[3] = pk2(o[6], o[7]);
      *(v4u*)(qS + s * 136 + dg * 8) = pk;
      conv8(p, l, KB, grow0 + s, head * 128 + dg * 8, 512 + head * 128 + dg * 8, hasprev, hasnext, 0.08838834764831845f, o);
      pk[0] = pk2(o[0], o[1]); pk[1] = pk2(o[2], o[3]); pk[2] = pk2(o[4], o[5]); pk[3] = pk2(o[6], o[7]);
      *(v4u*)(kS + s * 136 + dg * 8) = pk;
    }
  }
  __syncthreads();
  if (tid < 256) {
    const int d = tid >> 7, t = tid & 127;
    float s = 0.f;
    for (int k = 0; k < 128; ++k) s += nS[d * 128 + k] * bf2f(qS[t * 136 + k]);
    nq[d * 128 + t] = s;
  }
  f32x16 Pf[2], Pb[2];
  {
    const int tt = wave & 3, sh = wave >> 2;
    const int t = 32 * tt + r;
    bf16x8 qf[8];
#pragma unroll
    for (int ks = 0; ks < 8; ++ks) qf[ks] = *(const bf16x8*)(qS + t * 136 + 16 * ks + 8 * hh);
    const float bFt = bc[t], bBt = bc[128 + t];
    float csf = 0.f, csb = 0.f;
#pragma unroll
    for (int st2 = 0; st2 < 2; ++st2) {
      const int stile = 2 * sh + st2;
      f32x16 S = zero16();
#pragma unroll
      for (int ks = 0; ks < 8; ++ks) {
        const bf16x8 kf = *(const bf16x8*)(kS + (32 * stile + r) * 136 + 16 * ks + 8 * hh);
        S = mfma32(kf, qf[ks], S);
      }
#pragma unroll
      for (int e = 0; e < 16; ++e) {
        const int s = 32 * stile + (e & 3) + 8 * (e >> 2) + 4 * hh;
        const float raw = S[e];
        const float pf_ = (s <= t) ? raw * __expf(bFt - bc[s] + li[s]) : 0.f;
        const float pb_ = (s >= t) ? raw * __expf(bBt - bc[128 + s] + li[128 + s]) : 0.f;
        Pf[st2][e] = pf_;
        Pb[st2][e] = pb_;
        csf += pf_;
        csb += pb_;
      }
    }
    csf += __shfl_xor(csf, 32, 64);
    csb += __shfl_xor(csb, 32, 64);
    if (hh == 0) {
      colsum[(0 * 2 + sh) * 128 + t] = csf;
      colsum[(1 * 2 + sh) * 128 + t] = csb;
    }
  }
  __syncthreads();
  {
    const int tt = wave & 3, sh = wave >> 2;
    const int t = 32 * tt + r;
    const float eF = __expf(bc[t]), eB = __expf(bc[128 + t]);
    const float denF = eF * nq[t] + colsum[0 * 128 + t] + colsum[1 * 128 + t];
    const float denB = eB * nq[128 + t] + colsum[2 * 128 + t] + colsum[3 * 128 + t];
    const float invF = 1.f / fmaxf(fabsf(denF), 1.f);
    const float invB = 1.f / fmaxf(fabsf(denB), 1.f);
    if (sh == 0 && hh == 0) {
      cfs[t] = eF * invF;
      cfs[128 + t] = eB * invB;
    }
#pragma unroll
    for (int st2 = 0; st2 < 2; ++st2) {
      const int stile = 2 * sh + st2;
#pragma unroll
      for (int g = 0; g < 4; ++g) {
        v2u pk;
        pk[0] = pk2(Pf[st2][4 * g] * invF + Pb[st2][4 * g] * invB, Pf[st2][4 * g + 1] * invF + Pb[st2][4 * g + 1] * invB);
        pk[1] = pk2(Pf[st2][4 * g + 2] * invF + Pb[st2][4 * g + 2] * invB, Pf[st2][4 * g + 3] * invF + Pb[st2][4 * g + 3] * invB);
        const int pos = 32 * stile + 16 * (g >> 1) + 4 * (hh * 2 + (g & 1));
        *(v2u*)(pS + t * 136 + pos) = pk;
      }
    }
  }
  __syncthreads();
  const int dvt = wave & 3, tp = wave >> 2;
  f32x16 hacc[2];
  {
    const u16* VT = piece(p, P_VTB);
    const u16* CST = (const u16*)(p.ws + WS_H);
    f32x16 aP[2], aF[2], aB[2];
#pragma unroll
    for (int t2 = 0; t2 < 2; ++t2) { aP[t2] = zero16(); aF[t2] = zero16(); aB[t2] = zero16(); }
#pragma unroll
    for (int s8 = 0; s8 < 8; ++s8) {
      const bf16x8 vf = *(const bf16x8*)(VT + ((size_t)(b * 512 + head * 128 + 32 * dvt + r)) * NKEY + key0 + 16 * s8 + 8 * hh);
#pragma unroll
      for (int t2 = 0; t2 < 2; ++t2) {
        const bf16x8 pf_ = *(const bf16x8*)(pS + (32 * (2 * tp + t2) + r) * 136 + 16 * s8 + 8 * hh);
        aP[t2] = mfma32(vf, pf_, aP[t2]);
      }
    }
    const u16* cF = CST + ((size_t)(chainF * 66 + P)) * 16384 + (32 * dvt + r) * 128 + 8 * hh;
    const u16* cB = CST + ((size_t)(chainB * 66 + P)) * 16384 + (32 * dvt + r) * 128 + 8 * hh;
#pragma unroll
    for (int ks = 0; ks < 8; ++ks) {
      const bf16x8 f1 = *(const bf16x8*)(cF + 16 * ks);
      const bf16x8 f2 = *(const bf16x8*)(cB + 16 * ks);
#pragma unroll
      for (int t2 = 0; t2 < 2; ++t2) {
        const bf16x8 qf = *(const bf16x8*)(qS + (32 * (2 * tp + t2) + r) * 136 + 16 * ks + 8 * hh);
        aF[t2] = mfma32(f1, qf, aF[t2]);
        aB[t2] = mfma32(f2, qf, aB[t2]);
      }
    }
#pragma unroll
    for (int t2 = 0; t2 < 2; ++t2) {
      const int t = 32 * (2 * tp + t2) + r;
      const float cf = cfs[t], cb = cfs[128 + t];
      float ss = 0.f;
#pragma unroll
      for (int e = 0; e < 16; ++e) {
        const float hv = aP[t2][e] + cf * aF[t2][e] + cb * aB[t2][e];
        hacc[t2][e] = hv;
        ss += hv * hv;
      }
      ss += __shfl_xor(ss, 32, 64);
      if (hh == 0) hsq[dvt * 128 + t] = ss;
    }
  }
  __syncthreads();
  {
    u16* OB = piece(p, P_OB);
    const u16* ZB = piece(p, P_ZB);
    const float* mg = p.ml_g + l * 128;
#pragma unroll
    for (int t2 = 0; t2 < 2; ++t2) {
      const int t = 32 * (2 * tp + t2) + r;
      const float rinv = rsqrtf((hsq[t] + hsq[128 + t] + hsq[256 + t] + hsq[384 + t]) * (1.f / 128.f) + 1e-6f);
#pragma unroll
      for (int g = 0; g < 4; ++g) {
        const int dv0 = 32 * dvt + 8 * g + 4 * hh;
        const size_t off = (size_t)(grow0 + t) * 512 + head * 128 + dv0;
        const v2u ov = *(const v2u*)(OB + off);
        const v2u zv = *(const v2u*)(ZB + off);
        const float y0 = sigmoid_f(bflo(ov[0])) * hacc[t2][4 * g] * rinv * mg[dv0] * silu_f(bflo(zv[0]));
        const float y1 = sigmoid_f(bfhi(ov[0])) * hacc[t2][4 * g + 1] * rinv * mg[dv0 + 1] * silu_f(bfhi(zv[0]));
        const float y2 = sigmoid_f(bflo(ov[1])) * hacc[t2][4 * g + 2] * rinv * mg[dv0 + 2] * silu_f(bflo(zv[1]));
        const float y3 = sigmoid_f(bfhi(ov[1])) * hacc[t2][4 * g + 3] * rinv * mg[dv0 + 3] * silu_f(bfhi(zv[1]));
        v2u o;
        o[0] = pk2(y0, y1);
        o[1] = pk2(y2, y3);
        *(v2u*)(OB + off) = o;
      }
    }
  }
  __syncthreads();
}

__device__ __attribute__((always_inline)) void phase_s3(const Params& p, int l, unsigned char* smem) {
  const int nActx = (l == 0) ? 16 : 0, nCctx = (l == 0) ? 8 : 0;
  if ((gridDim.x & 7) == 0) {
    const int xcd = blockIdx.x & 7, slot = blockIdx.x >> 3, nb = gridDim.x >> 3;
#pragma unroll 1
    for (int q = slot; q < 64 + (nActx >> 3); q += nb) {
      const int b = xcd >> 2, h = xcd & 3;
      if (q < 64) attn_item(p, l, b, h, b * 8192 + q * 128, 0, 132, smem);
      else attn_item(p, l, b, h, 16384 + b * 256 + (q - 64) * 128, 128, 132, smem);
    }
  } else {
#pragma unroll 1
    for (int j = blockIdx.x; j < 512 + nActx; j += gridDim.x) {
      if (j < 512) {
        const int b = j >> 8, h = (j >> 6) & 3, qb = j & 63;
        attn_item(p, l, b, h, b * 8192 + qb * 128, 0, 132, smem);
      } else {
        const int jj = j - 512;
        const int b = jj >> 3, h = (jj >> 1) & 3, qh = jj & 1;
        attn_item(p, l, b, h, 16384 + b * 256 + qh * 128, 128, 132, smem);
      }
    }
  }
#pragma unroll 1
  for (int j = (blockIdx.x + gridDim.x - 32) % gridDim.x; j < 528; j += gridDim.x) {
    const int b = j / 264, rem = j % 264, head = rem / 66, P = rem % 66;
    mlstm_b1_item(p, l, b, head, P, smem);
  }
#pragma unroll 1
  for (int j = (blockIdx.x + gridDim.x - 64) % gridDim.x; j < 256 + nCctx; j += gridDim.x) {
    if (j < 256) natten_item(p, l, j >> 7, j & 127, (j >> 7) * 8192 + (j & 127) * 64, 0, smem);
    else natten_item(p, l, (j - 256) >> 2, 0, 16384 + ((j - 256) >> 2) * 256 + ((j - 256) & 3) * 64, 8, smem);
  }
}

__device__ __attribute__((always_inline)) void h2_rows(const Params& p, int l) {
  const int tid = opaque_tid(), lane = tid & 63, wave = tid >> 6;
  u16* H2 = slotp(p, 3);
  const float* rstd = (const float*)(p.ws + WS_RSTD);
  for (int row = blockIdx.x * 8 + wave; row < R_TOT; row += gridDim.x * 8) {
    const float* xr = xrow(p, l, row);
    const int w = which_of(row);
    const float* gs = (const float*)(p.ws + WS_GS) + w * 1024;
    const float* sh = (const float*)(p.ws + WS_SH) + w * 1024;
    const float rs = rstd[row];
#pragma unroll
    for (int j = 0; j < 4; ++j) {
      const int k = lane * 4 + 256 * j;
      const v4f v = *(const v4f*)(xr + k);
      const v4f g = *(const v4f*)(gs + k);
      const v4f sf = *(const v4f*)(sh + k);
      v2u pk;
      pk[0] = pk2(v[0] * rs * g[0] + sf[0], v[1] * rs * g[1] + sf[1]);
      pk[1] = pk2(v[2] * rs * g[2] + sf[2], v[3] * rs * g[3] + sf[3]);
      *(v2u*)(H2 + (size_t)row * 1024 + k) = pk;
    }
  }
}

__device__ __attribute__((always_inline)) void phase_s5(const Params& p, int l, unsigned char* smem) {
  h2_rows(p, l);
  const int P0 = (l == 0) ? 0 : 2;
  const int nP = 66 - P0;
  for (int it = (blockIdx.x + gridDim.x - 96) % gridDim.x; it < 8 * nP; it += gridDim.x) {
    const int bh = it / nP, P = P0 + it % nP;
    mlstm_b3_item(p, l, bh >> 2, bh & 3, P, smem);
  }
}

__device__ __forceinline__ void s6a_tile(const Params& p, int rt, int ct, unsigned char* smem) {
  const int tid = opaque_tid(), lane = tid & 63, wave = tid >> 6;
  const int wm = wave >> 1, wn = wave & 1, r = lane & 31, hh = lane >> 5;
  const u16* H2 = slotp(p, 3);
  const u16* WTI = (const u16*)(p.ws + WS_WT_IN);
  u16* G = slotp(p, 5);
  const int row0 = rt * 256;
  f32x16 acc[2][2];
  acc[0][0] = zero16(); acc[0][1] = zero16(); acc[1][0] = zero16(); acc[1][1] = zero16();
  gemm_core<0, 2>(acc, H2 + (size_t)row0 * 1024, 1024, nullptr, nullptr, nullptr, nullptr,
                  WTI + (size_t)(6656 + ct * 128) * 1024, 1024, smem);
  u16* Gn = G + (size_t)(ct >> 3) * R_TOT * 1024;
  const int d0 = (ct & 7) * 128 + 64 * wn + r;
#pragma unroll
  for (int i = 0; i < 2; ++i)
#pragma unroll
    for (int e = 0; e < 16; ++e) {
      const int row = row0 + 64 * wm + 32 * i + (e & 3) + 8 * (e >> 2) + 4 * hh;
      u16* rp = Gn + (size_t)row * 1024 + d0;
      asm volatile("" : "+v"(rp));
      rp[0] = f2bf(sigmoid_f(acc[i][0][e]));
      rp[32] = f2bf(sigmoid_f(acc[i][1][e]));
    }
}

__device__ __forceinline__ void s6a_tile256(const Params& p, int rt, int ct, unsigned char* smem) {
  const int tid = opaque_tid(), lane = tid & 63, wave = tid >> 6;
  const int wm = wave >> 1, wn = wave & 1, r = lane & 31, hh = lane >> 5;
  const u16* H2 = slotp(p, 3);
  const u16* WTI = (const u16*)(p.ws + WS_WT_IN);
  u16* G = slotp(p, 5);
  const int row0 = rt * 256;
  f32x16 acc[2][4];
#pragma unroll
  for (int i = 0; i < 2; ++i)
#pragma unroll
    for (int j = 0; j < 4; ++j) acc[i][j] = zero16();
  gemm_core256<1>(acc, H2 + (size_t)row0 * 1024, 1024, WTI + (size_t)(6656 + ct * 256) * 1024, 1024, smem);
  u16* Gn = G + (size_t)(ct >> 2) * R_TOT * 1024;
  const int d0 = (ct & 3) * 256 + 128 * wn + r;
#pragma unroll
  for (int i = 0; i < 2; ++i)
#pragma unroll
    for (int e = 0; e < 16; ++e) {
      const int row = row0 + 64 * wm + 32 * i + (e & 3) + 8 * (e >> 2) + 4 * hh;
      u16* rp = Gn + (size_t)row * 1024 + d0;
      asm volatile("" : "+v"(rp));
#pragma unroll
      for (int j = 0; j < 4; ++j) {
        float v = acc[i][j][e];
        asm volatile("" : "+v"(v));
        rp[32 * j] = f2bf(sigmoid_f(v));
      }
    }
}

__device__ __attribute__((always_inline)) void phase_s6a(const Params& p, int l, unsigned char* smem) {
  {
    const bool xs = (gridDim.x & 7) == 0;
    const int nb = xs ? (gridDim.x >> 3) : gridDim.x;
    const int xcd = xs ? (blockIdx.x & 7) : 0, slot = xs ? (blockIdx.x >> 3) : blockIdx.x;
    const int seg0 = xs ? 96 * xcd : 0, seg1 = xs ? 96 * (xcd + 1) : 768;
#pragma unroll 1
    for (int L = seg0 + slot; L < seg1; L += nb) {
      const int g = L / 96, rem = L % 96;
      s6a_tile256(p, 8 * g + (rem & 7), rem >> 3, smem);
    }
  }
  if (l == 0) {
#pragma unroll 1
    for (int it = blockIdx.x; it < 48; it += gridDim.x) s6a_tile(p, 64 + (it & 1), it >> 1, smem);
  }
}

template <int MI>
__device__ __forceinline__ void s6b_tile(const Params& p, int row0, int ct, unsigned char* smem) {
  const int tid = opaque_tid(), lane = tid & 63, wave = tid >> 6;
  const int wm = wave >> 1, wn = wave & 1, r = lane & 31, hh = lane >> 5;
  const u16* WTB = (const u16*)(p.ws + WS_WT_BR);
  const u16* G = slotp(p, 5);
  u16* M = (u16*)(p.ws + WS_H);
  f32x16 tot[MI][2];
#pragma unroll
  for (int i = 0; i < MI; ++i) { tot[i][0] = zero16(); tot[i][1] = zero16(); }
#pragma unroll 1
  for (int n = 0; n < 3; ++n) {
    f32x16 ap[MI][2];
#pragma unroll
    for (int i = 0; i < MI; ++i) { ap[i][0] = zero16(); ap[i][1] = zero16(); }
    gemm_core<0, MI>(ap, slotp(p, n) + (size_t)row0 * 512, 512, nullptr, nullptr, nullptr, nullptr,
                     WTB + (size_t)(n * 1024 + ct * 128) * 512, 512, smem);
    const u16* Gn = G + (size_t)n * R_TOT * 1024;
#pragma unroll
    for (int i = 0; i < MI; ++i)
#pragma unroll
      for (int e = 0; e < 16; ++e) {
        const int row = row0 + 32 * MI * wm + 32 * i + (e & 3) + 8 * (e >> 2) + 4 * hh;
        const u16* rp = Gn + (size_t)row * 1024 + ct * 128 + 64 * wn + r;
        asm volatile("" : "+v"(rp));
        tot[i][0][e] += bf2f(rp[0]) * ap[i][0][e];
        tot[i][1][e] += bf2f(rp[32]) * ap[i][1][e];
      }
  }
#pragma unroll
  for (int i = 0; i < MI; ++i)
#pragma unroll
    for (int e = 0; e < 16; ++e) {
      const int row = row0 + 32 * MI * wm + 32 * i + (e & 3) + 8 * (e >> 2) + 4 * hh;
      u16* rp = M + (size_t)row * 1024 + ct * 128 + 64 * wn + r;
      asm volatile("" : "+v"(rp));
      rp[0] = f2bf(tot[i][0][e]);
      rp[32] = f2bf(tot[i][1][e]);
    }
}

__device__ __attribute__((always_inline)) void phase_s6b(const Params& p, int l, unsigned char* smem) {
  {
    const bool xs = (gridDim.x & 7) == 0;
    const int nb = xs ? (gridDim.x >> 3) : gridDim.x;
    const int xcd = xs ? (blockIdx.x & 7) : 0, slot = xs ? (blockIdx.x >> 3) : blockIdx.x;
    const int seg0 = xs ? 128 * xcd : 0, seg1 = xs ? 128 * (xcd + 1) : 1024;
#pragma unroll 1
    for (int L = seg0 + slot; L < seg1; L += nb) {
      const int g = L >> 7, rem = L & 127, ct = rem >> 4, rt = 16 * g + (rem & 15);
      s6b_tile<1>(p, rt * 128, ct, smem);
    }
  }
  if (l == 0) {
#pragma unroll 1
    for (int it = blockIdx.x; it < 32; it += gridDim.x) s6b_tile<1>(p, 16384 + (it & 3) * 128, it >> 2, smem);
  }
}

template <int MI>
__device__ __forceinline__ void s7_tile(const Params& p, int l, int row0, int ct, unsigned char* smem) {
  const int tid = opaque_tid(), lane = tid & 63, wave = tid >> 6;
  const int wm = wave >> 1, wn = wave & 1, r = lane & 31, hh = lane >> 5;
  const u16* WTO = (const u16*)(p.ws + WS_WT_OUT);
  const u16* M = (const u16*)(p.ws + WS_H);
  const float* mod = (const float*)(p.ws + WS_MOD) + (size_t)l * 3 * 3072;
  const int w = which_of(row0);
  f32x16 acc[MI][2];
#pragma unroll
  for (int i = 0; i < MI; ++i) { acc[i][0] = zero16(); acc[i][1] = zero16(); }
  gemm_core<0, MI>(acc, M + (size_t)row0 * 1024, 1024, nullptr, nullptr, nullptr, nullptr, WTO + (size_t)(ct * 128) * 1024, 1024, smem);
  const float* xs_ = xrow(p, l, row0);
  float* xd = (row0 < 16384) ? (p.out + (size_t)row0 * 1024) : ((float*)(p.ws + WS_XC) + (size_t)(row0 - 16384) * 1024);
  const int col0 = ct * 128 + 64 * wn + r;
  const float g0 = mod[w * 3072 + 2048 + col0], g1 = mod[w * 3072 + 2048 + col0 + 32];
#pragma unroll
  for (int i = 0; i < MI; ++i)
#pragma unroll
    for (int e = 0; e < 16; ++e) {
      const size_t off = (size_t)(32 * MI * wm + 32 * i + (e & 3) + 8 * (e >> 2) + 4 * hh) * 1024 + col0;
      const float* sp = xs_ + off;
      float* dp = xd + off;
      asm volatile("" : "+v"(sp), "+v"(dp));
      dp[0] = sp[0] + g0 * acc[i][0][e];
      dp[32] = sp[32] + g1 * acc[i][1][e];
    }
}

__device__ __attribute__((always_inline)) void phase_s7(const Params& p, int l, unsigned char* smem) {
  {
    const bool xs = (gridDim.x & 7) == 0;
    const int nb = xs ? (gridDim.x >> 3) : gridDim.x;
    const int xcd = xs ? (blockIdx.x & 7) : 0, slot = xs ? (blockIdx.x >> 3) : blockIdx.x;
    const int seg0 = xs ? 64 * xcd : 0, seg1 = xs ? 64 * (xcd + 1) : 512;
#pragma unroll 1
    for (int L = seg0 + slot; L < seg1; L += nb) {
      const int g = L >> 6, rem = L & 63;
      s7_tile<2>(p, l, (8 * g + (rem & 7)) * 256, rem >> 3, smem);
    }
  }
  if (l == 0) {
#pragma unroll 1
    for (int it = blockIdx.x; it < 32; it += gridDim.x) s7_tile<1>(p, l, 16384 + (it & 3) * 128, it >> 2, smem);
  }
}

__device__ __attribute__((always_inline)) void phase_final(const Params& p) {
  const int tid = threadIdx.x, lane = tid & 63, wave = tid >> 6;
  for (int row = blockIdx.x * 8 + wave; row < 16384; row += gridDim.x * 8) {
    float* xr = p.out + (size_t)row * 1024;
    v4f v[4];
    float ss = 0.f;
#pragma unroll
    for (int j = 0; j < 4; ++j) {
      v[j] = *(const v4f*)(xr + lane * 4 + 256 * j);
      ss += v[j][0] * v[j][0] + v[j][1] * v[j][1] + v[j][2] * v[j][2] + v[j][3] * v[j][3];
    }
    ss = wave_sum(ss);
    const float rs = rsqrtf(ss * (1.f / 1024.f) + 1e-6f);
#pragma unroll
    for (int j = 0; j < 4; ++j) {
      const v4f g = *(const v4f*)(p.final_g + lane * 4 + 256 * j);
      v4f o;
#pragma unroll
      for (int e = 0; e < 4; ++e) o[e] = v[j][e] * rs * g[e];
      *(v4f*)(xr + lane * 4 + 256 * j) = o;
    }
  }
}

#define XB_TMO      128
#define XB_XCNT(j)  (256  + 64 * (j))
#define XB_XSUB(j)  (1280 + 64 * (j))
#define XB_XGEN(j)  (2304 + 64 * (j))
#define XB_TOP      3328
#define XB_TOPGEN   3392
#define XCD_BAR_WORDS 3456
#define XB_SPIN_CAP (1u << 18)
#define LAS __attribute__((address_space(3)))

__device__ __forceinline__ unsigned xb_ld(unsigned* p)              { return __hip_atomic_load(p, __ATOMIC_RELAXED, __HIP_MEMORY_SCOPE_AGENT); }
__device__ __forceinline__ unsigned xb_add(unsigned* p, unsigned v) { return __hip_atomic_fetch_add(p, v, __ATOMIC_RELAXED, __HIP_MEMORY_SCOPE_AGENT); }
__device__ __forceinline__ unsigned xb_xcc_id() { return (unsigned)__builtin_amdgcn_s_getreg((3 << 11) | 20) & 0xFu; }
#define XB_SPIN(cond, bar) do { unsigned _sp = 0; while (cond) { __builtin_amdgcn_s_sleep(1); \
    if ((++_sp & 255u) == 0u) { if (xb_ld(&(bar)[XB_TMO])) break; if (_sp > XB_SPIN_CAP) { atomicAdd(&(bar)[XB_TMO], 1u); break; } } } } while (0)

struct XcdBarrier {
    unsigned* bar; unsigned x;
    volatile LAS unsigned* st;
};

__device__ __forceinline__ XcdBarrier xcd_barrier_post(unsigned* bar, volatile LAS unsigned* st) {
    XcdBarrier b; b.bar = bar; b.x = xb_xcc_id(); b.st = st;
    if (threadIdx.x == 0) (void)xb_add(&bar[XB_XCNT(b.x)], 1u);
    return b;
}
__device__ __forceinline__ void xcd_barrier_complete(unsigned* bar, unsigned x, unsigned& nloc, unsigned& nx) {
    const unsigned G = gridDim.x * gridDim.y * gridDim.z;
    unsigned sum, cnt, mine, sp = 0u;
    for (;;) {
        sum = 0u; cnt = 0u; mine = 0u;
#pragma unroll
        for (unsigned j = 0; j < 16; ++j) { const unsigned c = xb_ld(&bar[XB_XCNT(j)]); sum += c; cnt += (c > 0u) ? 1u : 0u; mine = (j == x) ? c : mine; }
        if (sum == G) break;
        __builtin_amdgcn_s_sleep(1);
        if ((++sp & 255u) == 0u) { if (xb_ld(&bar[XB_TMO])) break; if (sp > XB_SPIN_CAP) { atomicAdd(&bar[XB_TMO], 1u); break; } }
    }
    nloc = mine > 0u ? mine : 1u; nx = cnt > 0u ? cnt : 1u;
}

__device__ __forceinline__ void xcd_barrier(const XcdBarrier& b) {
    asm volatile("s_waitcnt vmcnt(0)" ::: "memory");
    __syncthreads();
    if (threadIdx.x == 0) {
        unsigned* bar = b.bar;
        __builtin_amdgcn_s_waitcnt(0);
        unsigned nloc = b.st[0], nx = b.st[1];
        if (nloc == 0u) { xcd_barrier_complete(bar, b.x, nloc, nx); b.st[0] = nloc; b.st[1] = nx; }
        const unsigned old = xb_add(&bar[XB_XSUB(b.x)], 1u);
        const unsigned gen = old / nloc;
        if (old + 1u == (gen + 1u) * nloc) {
            __builtin_amdgcn_fence(__ATOMIC_RELEASE, "agent");
            asm volatile("s_waitcnt vmcnt(0)" ::: "memory");
            const unsigned og = xb_add(&bar[XB_TOP], 1u);
            const unsigned tg = og / nx;
            if (og + 1u == (tg + 1u) * nx) xb_add(&bar[XB_TOPGEN], 1u);
            else XB_SPIN(xb_ld(&bar[XB_TOPGEN]) == tg, bar);
            __builtin_amdgcn_fence(__ATOMIC_ACQUIRE, "agent");
            xb_add(&bar[XB_XGEN(b.x)], 1u);
            asm volatile("s_waitcnt vmcnt(0)" ::: "memory");
        } else {
            XB_SPIN(xb_ld(&bar[XB_XGEN(b.x)]) == gen, bar);
            __builtin_amdgcn_fence(__ATOMIC_ACQUIRE, "agent");
            asm volatile("s_waitcnt vmcnt(0)" ::: "memory");
        }
    }
    __syncthreads();
}


__global__ void __launch_bounds__(NTHR) fwd_megakernel(Params p) {
  extern __shared__ __attribute__((aligned(16))) unsigned char smem[];
  cg::grid_group grid = cg::this_grid();
  __shared__ uint4 xb_words;
  if (threadIdx.x == 0) xb_words = make_uint4(0u, 0u, 0u, 0u);
  __syncthreads();
  XcdBarrier xbar = xcd_barrier_post((unsigned*)(p.ws + WS_BAR), (volatile LAS unsigned*)&xb_words);
#define PH(k, call)                                  \
  if (p.ph_lo <= (k) && (k) < p.ph_hi) {             \
    call;                                            \
    if ((k) + 1 < p.ph_hi) { if ((k) == 0) grid.sync(); else xcd_barrier(xbar); }  \
  }
  PH(0, phase_s0(p))
  PH(1, phase_s1(p, 0, smem))
  PH(2, phase_s2(p, 0, smem))
  PH(3, phase_s3(p, 0, smem))
  PH(4, phase_b2(p))
  PH(5, phase_s5(p, 0, smem))
  PH(6, phase_s6a(p, 0, smem))
  PH(7, phase_s6b(p, 0, smem))
  PH(8, phase_s7(p, 0, smem))
  PH(9, phase_s1(p, 1, smem))
  PH(10, phase_s2(p, 1, smem))
  PH(11, phase_s3(p, 1, smem))
  PH(12, phase_b2(p))
  PH(13, phase_s5(p, 1, smem))
  PH(14, phase_s6a(p, 1, smem))
  PH(15, phase_s6b(p, 1, smem))
  PH(16, phase_s7(p, 1, smem))
  PH(17, phase_final(p))
#undef PH
}

extern "C" void kernel_launch(void* const* d_in, const int* in_sizes, int n_in, void* d_out, int out_size,
                              void* d_ws, size_t ws_size, hipStream_t stream) {
  static int grid_blocks = 0;
  if (grid_blocks == 0) {
    if (n_in != 19 || ws_size < WS_END) {
      fprintf(stderr, "kernel_launch: unexpected n_in %d or ws_size %zu (< %llu)\n", n_in, ws_size, (unsigned long long)WS_END);
      grid_blocks = -1;
      return;
    }
    int dev = 0, cus = 0, per_cu = 0;
    hipGetDevice(&dev);
    hipDeviceGetAttribute(&cus, hipDeviceAttributeMultiprocessorCount, dev);
    if (hipFuncSetAttribute((const void*)fwd_megakernel, hipFuncAttributeMaxDynamicSharedMemorySize, LDS_BYTES) != hipSuccess) {
      fprintf(stderr, "kernel_launch: hipFuncSetAttribute failed\n");
      grid_blocks = -1;
      return;
    }
    hipOccupancyMaxActiveBlocksPerMultiprocessor(&per_cu, (const void*)fwd_megakernel, NTHR, LDS_BYTES);
    if (per_cu < 1) { fprintf(stderr, "kernel_launch: occupancy query says %d blocks/CU\n", per_cu); per_cu = 1; }
    (void)hipGetLastError();
    grid_blocks = cus;
  }
  if (grid_blocks < 0) return;
  hipMemsetAsync((char*)d_ws + WS_MOD, 0, 73728, stream);
  hipMemsetAsync((char*)d_ws + WS_BAR, 0, 13824, stream);
  Params p{};
  p.x = (const float*)d_in[0]; p.c = (const float*)d_in[1]; p.ctx = (const float*)d_in[2]; p.c_ctx = (const float*)d_in[3];
  p.w_mod = (const float*)d_in[4]; p.b_mod = (const float*)d_in[5]; p.norm_g = (const float*)d_in[6]; p.w_in = (const float*)d_in[7];
  p.lam_q = (const float*)d_in[8]; p.lam_k = (const float*)d_in[9]; p.da_g = (const float*)d_in[10];
  p.conv_w = (const float*)d_in[11]; p.conv_b = (const float*)d_in[12]; p.gate_b = (const float*)d_in[13]; p.ml_g = (const float*)d_in[14];
  p.rpb = (const float*)d_in[15]; p.w_br = (const float*)d_in[16]; p.w_out = (const float*)d_in[17]; p.final_g = (const float*)d_in[18];
  p.out = (float*)d_out; p.ws = (unsigned char*)d_ws;
#if MULTI_LAUNCH
  for (int ph = 0; ph < NPHASE; ++ph) {
    p.ph_lo = ph; p.ph_hi = ph + 1;
    hipLaunchKernelGGL(fwd_megakernel, dim3(grid_blocks), dim3(NTHR), LDS_BYTES, stream, p);
  }
#else
  p.ph_lo = 0; p.ph_hi = NPHASE;
  void* args[] = {&p};
  hipError_t e = hipLaunchCooperativeKernel((void*)fwd_megakernel, dim3(grid_blocks), dim3(NTHR), args, LDS_BYTES, stream);
  if (e != hipSuccess) fprintf(stderr, "cooperative launch failed: %s (grid %d)\n", hipGetErrorString(e), grid_blocks);
#endif
}
```

```cpp
#include <hip/hip_runtime.h>
#include <hip/hip_cooperative_groups.h>
#include <cstdio>
namespace cg = cooperative_groups;

#ifndef MULTI_LAUNCH
#define MULTI_LAUNCH 0
#endif

typedef unsigned short u16;
typedef __attribute__((ext_vector_type(8))) short bf16x8;
typedef __attribute__((ext_vector_type(16))) float f32x16;
typedef __attribute__((ext_vector_type(4))) unsigned int v4u;
typedef __attribute__((ext_vector_type(2))) unsigned int v2u;
typedef __attribute__((ext_vector_type(4))) float v4f;

#define R_TOT 16896
#define NKEY 8448
#define NPAD 9856
#define NTHR 512
#define LDS_BYTES 147456
#define NPHASE 18

#define WS_WT_IN 0ull
#define WS_WT_BR 20185088ull
#define WS_WT_OUT 23330816ull
#define WS_H 25427968ull
#define WS_PIECE 60030976ull
#define PIECE_SZ 17301504ull
#define WS_XC 284950528ull
#define WS_G 287047680ull
#define WS_MOD 288129024ull
#define WS_ROPE 288202752ull
#define WS_RSTD 288219136ull
#define WS_DN 288286720ull
#define WS_NPREV 288827392ull
#define WS_BL 289368064ull
#define WS_GS 289372416ull
#define WS_SH 289384704ull
#define WS_BAR 289396992ull
#define WS_END 289412096ull

enum { P_QA = 0, P_KA, P_VTA, P_ZA, P_QB, P_KB, P_VTB, P_OB, P_ZB, P_QC, P_KC, P_VTC, P_ZC };

#define GAS __attribute__((address_space(1)))
typedef GAS u16 gu16;
typedef GAS float gfloat;
typedef GAS v2u gv2u;
typedef GAS v4f gv4f;
struct Params {
  const float *x, *c, *ctx, *c_ctx, *w_mod, *b_mod, *norm_g, *w_in, *lam_q, *lam_k, *da_g,
      *conv_w, *conv_b, *gate_b, *ml_g, *rpb, *w_br, *w_out, *final_g;
  float* out;
  unsigned char* ws;
  int ph_lo, ph_hi;
};

__device__ __forceinline__ int opaque_tid() { int t = threadIdx.x; asm volatile("" : "+v"(t)); return t; }
__device__ __forceinline__ u16 f2bf(float f) {
  unsigned u = __float_as_uint(f);
  u += 0x7fffu + ((u >> 16) & 1u);
  return (u16)(u >> 16);
}
__device__ __forceinline__ float bf2f(u16 h) { return __uint_as_float(((unsigned)h) << 16); }
typedef __attribute__((ext_vector_type(2))) __bf16 bf16x2_t;
typedef __attribute__((ext_vector_type(2))) float f32x2_t;
__device__ __forceinline__ unsigned pk2(float a, float b) { f32x2_t v = {a, b}; bf16x2_t r = __builtin_convertvector(v, bf16x2_t); return __builtin_bit_cast(unsigned, r); }
__device__ __forceinline__ float bflo(unsigned u) { return __uint_as_float(u << 16); }
__device__ __forceinline__ float bfhi(unsigned u) { return __uint_as_float(u & 0xffff0000u); }
__device__ __forceinline__ float silu_f(float x) { return x / (1.f + __expf(-x)); }
__device__ __forceinline__ float sigmoid_f(float x) { return 1.f / (1.f + __expf(-x)); }
__device__ __forceinline__ float ex2(float x) { return __builtin_amdgcn_exp2f(x); }
__device__ __forceinline__ float wave_sum(float v) {
#pragma unroll
  for (int o = 32; o > 0; o >>= 1) v += __shfl_xor(v, o, 64);
  return v;
}
__device__ __forceinline__ f32x16 mfma32(bf16x8 a, bf16x8 b, f32x16 c) {
  return __builtin_amdgcn_mfma_f32_32x32x16_bf16(a, b, c, 0, 0, 0);
}
__device__ __forceinline__ f32x16 zero16() {
  f32x16 z;
#pragma unroll
  for (int i = 0; i < 16; ++i) z[i] = 0.f;
  return z;
}
__device__ __forceinline__ int pslot(int i) { return (int)((0xCBA2918765430ull >> (4 * i)) & 15ull); }
__device__ __forceinline__ u16* piece(const Params& p, int i) { return (u16*)(p.ws + WS_PIECE + (size_t)pslot(i) * PIECE_SZ); }
__device__ __forceinline__ u16* slotp(const Params& p, int sl) { return (u16*)(p.ws + WS_PIECE + (size_t)sl * PIECE_SZ); }
__device__ __forceinline__ const float* xrow(const Params& p, int l, int grow) {
  if (grow < 16384) return (l == 0 ? p.x : (const float*)p.out) + (size_t)grow * 1024;
  return (l == 0 ? p.ctx : (const float*)(p.ws + WS_XC)) + (size_t)(grow - 16384) * 1024;
}
__device__ __forceinline__ int which_of(int grow) { return grow < 8192 ? 0 : (grow < 16384 ? 1 : 2); }
__device__ __forceinline__ int perm16(int s) { return (s & ~15) | (((s >> 2) & 1) << 3) | (((s >> 3) & 1) << 2) | (s & 3); }

__device__ __attribute__((always_inline)) void phase_s0(const Params& p) {
  const int tid = threadIdx.x;
  float* mod = (float*)(p.ws + WS_MOD);
  for (int it = blockIdx.x; it < 2 * 12 * 16; it += gridDim.x) {
    const int l = it / 192, rem = it % 192, nch = rem / 16, kch = rem % 16;
    const int kh = tid >> 8, n = nch * 256 + (tid & 255);
    const int k0 = kch * 64 + kh * 32;
    const float* W = p.w_mod + (size_t)l * 1024 * 3072;
    float a0 = 0.f, a1 = 0.f, a2 = 0.f;
#pragma unroll 8
    for (int k = k0; k < k0 + 32; ++k) {
      const float w = W[(size_t)k * 3072 + n];
      a0 += silu_f(p.c[k]) * w;
      a1 += silu_f(p.c[1024 + k]) * w;
      a2 += silu_f(p.c_ctx[k]) * w;
    }
    if (kch == 0 && kh == 0) {
      const float bb = p.b_mod[l * 3072 + n];
      a0 += bb; a1 += bb; a2 += bb;
    }
    atomicAdd(&mod[(l * 3 + 0) * 3072 + n], a0);
    atomicAdd(&mod[(l * 3 + 1) * 3072 + n], a1);
    atomicAdd(&mod[(l * 3 + 2) * 3072 + n], a2);
  }
  const int gi = blockIdx.x * NTHR + tid;
  if (gi < 2048) {
    const int v = gi >> 4, f = gi & 15;
    const float inv = (float)exp(-(double)f * (9.210340371976184 / 16.0));
    const float angf = (float)v * inv;
    double a = (double)angf;
    const double twopi = 6.283185307179586476925;
    a -= twopi * floor(a / twopi + 0.5);
    const double a2 = a * a;
    double ts = a, tc = 1.0, sn = a, cs = 1.0;
    for (int i = 1; i <= 14; ++i) {
      tc = -tc * a2 / (double)((2 * i - 1) * (2 * i));
      ts = -ts * a2 / (double)((2 * i) * (2 * i + 1));
      cs += tc; sn += ts;
    }
    float* rt = (float*)(p.ws + WS_ROPE);
    rt[gi * 2] = (float)cs;
    rt[gi * 2 + 1] = (float)sn;
  }
}

__device__ __attribute__((always_inline)) void conv_tile(const float* __restrict__ src, int ld, int k0, int col0, int nvalid, bool perm,
                          u16* __restrict__ dst, int ldd, int n0, unsigned char* smem) {
  u16* t = (u16*)smem;
  const int tid = opaque_tid();
#pragma unroll
  for (int i = 0; i < 2; ++i) {
    const int idx = tid + NTHR * i;
    const int kk = idx >> 4, c4 = idx & 15;
    v4f v = {0.f, 0.f, 0.f, 0.f};
    if (4 * c4 < nvalid) v = *(const v4f*)(src + (size_t)(k0 + kk) * ld + col0 + 4 * c4);
#pragma unroll
    for (int e = 0; e < 4; ++e) {
      const int j = 4 * c4 + e;
      const int jp = perm ? ((j & 1) ? 32 + (j >> 1) : (j >> 1)) : j;
      t[jp * 72 + kk] = f2bf(v[e]);
    }
  }
  __syncthreads();
  {
    const int n = tid >> 3, ch = tid & 7;
    const v4u v = *(const v4u*)(t + n * 72 + ch * 8);
    *(v4u*)(dst + (size_t)(n0 + n) * ldd + k0 + ch * 8) = v;
  }
  __syncthreads();
}

__device__ __attribute__((always_inline)) void phase_s1(const Params& p, int l, unsigned char* smem) {
  const int tid = threadIdx.x, lane = tid & 63, wave = tid >> 6;
  const float* mod = (const float*)(p.ws + WS_MOD) + (size_t)l * 3 * 3072;
  const float* g = p.norm_g + l * 1024;
  u16* H = (u16*)(p.ws + WS_H);
  float* rstd = (float*)(p.ws + WS_RSTD);
  if (blockIdx.x == 0) {
    float* gs = (float*)(p.ws + WS_GS);
    float* sh = (float*)(p.ws + WS_SH);
    for (int i = tid; i < 3072; i += NTHR) {
      const int w = i >> 10, k = i & 1023;
      gs[i] = g[k] * (1.f + mod[w * 3072 + 1024 + k]);
      sh[i] = mod[w * 3072 + k];
    }
  }
  for (int row = blockIdx.x * 8 + wave; row < R_TOT; row += gridDim.x * 8) {
    const float* xr = xrow(p, l, row);
    const int w = which_of(row);
    v4f v[4];
    float ss = 0.f;
#pragma unroll
    for (int j = 0; j < 4; ++j) {
      v[j] = *(const v4f*)(xr + lane * 4 + 256 * j);
      ss += v[j][0] * v[j][0] + v[j][1] * v[j][1] + v[j][2] * v[j][2] + v[j][3] * v[j][3];
    }
    ss = wave_sum(ss);
    const float rs = rsqrtf(ss * (1.f / 1024.f) + 1e-6f);
    if (lane == 0) rstd[row] = rs;
#pragma unroll
    for (int j = 0; j < 4; ++j) {
      const int k = lane * 4 + 256 * j;
      const v4f gg = *(const v4f*)(g + k);
      const v4f sc = *(const v4f*)(mod + w * 3072 + 1024 + k);
      const v4f sf = *(const v4f*)(mod + w * 3072 + k);
      float o[4];
#pragma unroll
      for (int e = 0; e < 4; ++e) o[e] = v[j][e] * rs * gg[e] * (1.f + sc[e]) + sf[e];
      v2u pk;
      pk[0] = pk2(o[0], o[1]);
      pk[1] = pk2(o[2], o[3]);
      *(v2u*)(H + (size_t)row * 1024 + k) = pk;
    }
  }
  u16* WTI = (u16*)(p.ws + WS_WT_IN);
  u16* WTB = (u16*)(p.ws + WS_WT_BR);
  u16* WTO = (u16*)(p.ws + WS_WT_OUT);
  const float* win = p.w_in + (size_t)l * 1024 * 9744;
  for (int it = blockIdx.x; it < 2464 + 384 + 256; it += gridDim.x) {
    if (it < 2464) {
      const int nb = it % 154, kb = it / 154;
      const int n0 = nb * 64;
      int col0 = n0, nvalid = 64;
      bool perm = n0 < 1024;
      if (n0 >= 4608 && n0 < 9728) col0 = n0 + 16;
      else if (n0 == 9728) { col0 = 4608; nvalid = 16; }
      else if (n0 > 9728) { col0 = 0; nvalid = 0; }
      conv_tile(win, 9744, kb * 64, col0, nvalid, perm, WTI, 1024, n0, smem);
    } else if (it < 2464 + 384) {
      const int j = it - 2464;
      const int n = j / 128, r = j % 128, db = r / 8, wb = r % 8;
      conv_tile(p.w_br + ((size_t)l * 3 + n) * 512 * 1024, 1024, wb * 64, db * 64, 64, false,
                WTB + (size_t)n * 1024 * 512, 512, db * 64, smem);
    } else {
      const int j = it - 2464 - 384;
      const int db = j / 16, kb = j % 16;
      conv_tile(p.w_out + (size_t)l * 1024 * 1024, 1024, kb * 64, db * 64, 64, false, WTO, 1024, db * 64, smem);
    }
  }
}

template <int AMODE, int MI>
__device__ __forceinline__ void gemm_core(f32x16 (&acc)[MI][2], const u16* __restrict__ A, int lda,
                                          const float* __restrict__ Ax, const float* __restrict__ rstd,
                                          const float* __restrict__ gs, const float* __restrict__ sh,
                                          const u16* __restrict__ B, int K, unsigned char* smem) {
  constexpr int AROWS = 128 * MI;
  u16* As = (u16*)smem;
  u16* Bs = (u16*)(smem + 73728);
  const int tid = opaque_tid(), lane = tid & 63, wave = tid >> 6;
  const int wm = wave >> 1, wn = wave & 1, r = lane & 31, hh = lane >> 5;
  const int lrow = tid >> 3, c8 = tid & 7;
  v4u ra[2][2 * MI], rb[2][2];
  float rs4[2 * MI];
  if (AMODE == 1) {
#pragma unroll
    for (int i = 0; i < 2 * MI; ++i) rs4[i] = rstd[lrow + 64 * i];
  }
  const int KT = K >> 6;
#define GEMM_LOAD(set, k0)                                                                        \
  {                                                                                               \
    if (AMODE == 0) {                                                                             \
      _Pragma("unroll") for (int i = 0; i < 2 * MI; ++i)                                          \
        ra[set][i] = *(const v4u*)(A + (size_t)(lrow + 64 * i) * lda + (k0) + c8 * 8);            \
    } else {                                                                                      \
      const v4f g0 = *(const v4f*)(gs + (k0) + c8 * 8), g1 = *(const v4f*)(gs + (k0) + c8 * 8 + 4); \
      const v4f s0 = *(const v4f*)(sh + (k0) + c8 * 8), s1 = *(const v4f*)(sh + (k0) + c8 * 8 + 4); \
      _Pragma("unroll") for (int i = 0; i < 2 * MI; ++i) {                                        \
        const float* xp = Ax + (size_t)(lrow + 64 * i) * 1024 + (k0) + c8 * 8;                    \
        const v4f x0 = *(const v4f*)xp, x1 = *(const v4f*)(xp + 4);                               \
        const float rr = rs4[i];                                                                  \
        ra[set][i][0] = pk2(x0[0] * rr * g0[0] + s0[0], x0[1] * rr * g0[1] + s0[1]);              \
        ra[set][i][1] = pk2(x0[2] * rr * g0[2] + s0[2], x0[3] * rr * g0[3] + s0[3]);              \
        ra[set][i][2] = pk2(x1[0] * rr * g1[0] + s1[0], x1[1] * rr * g1[1] + s1[1]);              \
        ra[set][i][3] = pk2(x1[2] * rr * g1[2] + s1[2], x1[3] * rr * g1[3] + s1[3]);              \
      }                                                                                           \
    }                                                                                             \
    _Pragma("unroll") for (int i = 0; i < 2; ++i)                                                 \
        rb[set][i] = *(const v4u*)(B + (size_t)(lrow + 64 * i) * K + (k0) + c8 * 8);              \
  }
#define GEMM_STORE(set, buf)                                                                      \
  {                                                                                               \
    _Pragma("unroll") for (int i = 0; i < 2 * MI; ++i)                                            \
        *(v4u*)(As + (buf) * AROWS * 72 + (lrow + 64 * i) * 72 + c8 * 8) = ra[set][i];            \
    _Pragma("unroll") for (int i = 0; i < 2; ++i)                                                 \
        *(v4u*)(Bs + (buf) * 128 * 72 + (lrow + 64 * i) * 72 + c8 * 8) = rb[set][i];              \
  }
#define GEMM_COMPUTE(cur)                                                                         \
  {                                                                                               \
    const u16* Ab = As + (cur) * AROWS * 72 + (32 * MI * wm + r) * 72 + 8 * hh;                   \
    const u16* Bb = Bs + (cur) * 128 * 72 + (64 * wn + r) * 72 + 8 * hh;                          \
    _Pragma("unroll") for (int ks = 0; ks < 4; ++ks) {                                            \
      const bf16x8 b0 = *(const bf16x8*)(Bb + ks * 16);                                           \
      const bf16x8 b1 = *(const bf16x8*)(Bb + 32 * 72 + ks * 16);                                 \
      _Pragma("unroll") for (int i = 0; i < MI; ++i) {                                            \
        const bf16x8 a0 = *(const bf16x8*)(Ab + i * 32 * 72 + ks * 16);                           \
        acc[i][0] = mfma32(a0, b0, acc[i][0]);                                                    \
        acc[i][1] = mfma32(a0, b1, acc[i][1]);                                                    \
      }                                                                                           \
    }                                                                                             \
  }
  GEMM_LOAD(0, 0);
  GEMM_LOAD(1, 64);
  GEMM_STORE(0, 0);
  __syncthreads();
  for (int kt = 0; kt < KT; kt += 2) {
    if (kt + 2 < KT) GEMM_LOAD(0, (kt + 2) * 64);
    GEMM_COMPUTE(0);
    GEMM_STORE(1, 1);
    __syncthreads();
    if (kt + 3 < KT) GEMM_LOAD(1, (kt + 3) * 64);
    GEMM_COMPUTE(1);
    if (kt + 2 < KT) GEMM_STORE(0, 0);
    __syncthreads();
  }
#undef GEMM_COMPUTE
#undef GEMM_LOAD
#undef GEMM_STORE
}

template <int LEAN>
__device__ __forceinline__ void gemm_core256(f32x16 (&acc)[2][4], const u16* __restrict__ A, int lda,
                                             const u16* __restrict__ B, int K, unsigned char* smem) {
  u16* As = (u16*)smem;
  u16* Bs = (u16*)(smem + 73728);
  const int tid = opaque_tid(), lane = tid & 63, wave = tid >> 6;
  const int wm = wave >> 1, wn = wave & 1, r = lane & 31, hh = lane >> 5;
  const int lrow = tid >> 3, c8 = tid & 7;
  v4u ra[4], rb[4];
  const int KT = K >> 6;
#define G2_LOAD(k0)                                                                               \
  {                                                                                               \
    _Pragma("unroll") for (int i = 0; i < 4; ++i) {                                               \
      ra[i] = *(const v4u*)(A + (size_t)(lrow + 64 * i) * lda + (k0) + c8 * 8);                   \
      rb[i] = *(const v4u*)(B + (size_t)(lrow + 64 * i) * K + (k0) + c8 * 8);                     \
    }                                                                                             \
  }
#define G2_STORE(buf)                                                                             \
  {                                                                                               \
    _Pragma("unroll") for (int i = 0; i < 4; ++i) {                                               \
      *(v4u*)(As + (buf) * 256 * 72 + (lrow + 64 * i) * 72 + c8 * 8) = ra[i];                     \
      *(v4u*)(Bs + (buf) * 256 * 72 + (lrow + 64 * i) * 72 + c8 * 8) = rb[i];                     \
    }                                                                                             \
  }
  G2_LOAD(0);
  G2_STORE(0);
  __syncthreads();
  if (KT > 1) G2_LOAD(64);
  for (int kt = 0; kt < KT; ++kt) {
    const int cur = kt & 1;
    const u16* Ab = As + cur * 256 * 72 + (64 * wm + r) * 72 + 8 * hh;
    const u16* Bb = Bs + cur * 256 * 72 + (128 * wn + r) * 72 + 8 * hh;
#pragma unroll
    for (int ks = 0; ks < 4; ++ks) {
      if (LEAN) __builtin_amdgcn_sched_barrier(0);
      const bf16x8 a0 = *(const bf16x8*)(Ab + ks * 16);
      const bf16x8 a1 = *(const bf16x8*)(Ab + 32 * 72 + ks * 16);
#pragma unroll
      for (int j = 0; j < 4; ++j) {
        const bf16x8 b0 = *(const bf16x8*)(Bb + j * 32 * 72 + ks * 16);
        acc[0][j] = mfma32(a0, b0, acc[0][j]);
        acc[1][j] = mfma32(a1, b0, acc[1][j]);
      }
    }
    if (kt + 1 < KT) {
      G2_STORE(cur ^ 1);
      if (kt + 2 < KT) G2_LOAD((kt + 2) * 64);
    }
    __syncthreads();
  }
#undef G2_LOAD
#undef G2_STORE
}

__device__ __forceinline__ void s2_store64(const Params& p, int grp, const f32x16& a0, const f32x16& a1, int rowbase, int fb64,
                                           bool latent, int b, int keyb, int r, int hh, const float* __restrict__ rope) {
  if (grp == P_VTA || grp == P_VTB || grp == P_VTC) {
    gu16* VT = (gu16*)piece(p, grp);
#pragma unroll
    for (int j = 0; j < 2; ++j) {
      const int f = fb64 + 32 * j + r;
#pragma unroll
      for (int q = 0; q < 4; ++q) {
        const int key = keyb + 16 * (q >> 1) + 4 * (hh * 2 + (q & 1));
        v2u pk;
        if (j == 0) { pk[0] = pk2(a0[4 * q], a0[4 * q + 1]); pk[1] = pk2(a0[4 * q + 2], a0[4 * q + 3]); }
        else { pk[0] = pk2(a1[4 * q], a1[4 * q + 1]); pk[1] = pk2(a1[4 * q + 2], a1[4 * q + 3]); }
        *(gv2u*)(VT + ((size_t)(b * 512 + f)) * NKEY + key) = pk;
      }
    }
  } else {
    gu16* D = (gu16*)piece(p, grp);
    const bool rot = latent && (grp == P_QA || grp == P_KA);
    const float qs = (grp == P_QA || grp == P_QC) ? 0.18033688011112042f : 1.f;
#pragma unroll
    for (int e = 0; e < 16; ++e) {
      const int row = rowbase + (e & 3) + 8 * (e >> 2) + 4 * hh;
      float v0 = a0[e], v1 = a1[e];
      if (rot) {
        const int t = row & 8191;
        const int vv = (r < 16) ? (t >> 6) : (t & 63);
        const float cs = rope[(vv * 16 + (r & 15)) * 2], sn = rope[(vv * 16 + (r & 15)) * 2 + 1];
        const float o0 = v0 * cs - v1 * sn, o1 = v0 * sn + v1 * cs;
        v0 = o0; v1 = o1;
      }
      D[(size_t)row * 512 + fb64 + r] = f2bf(v0 * qs);
      D[(size_t)row * 512 + fb64 + 32 + r] = f2bf(v1 * qs);
    }
  }
}

__device__ __attribute__((always_inline)) void phase_s2(const Params& p, int l, unsigned char* smem) {
  const int tid = opaque_tid(), lane = tid & 63, wave = tid >> 6;
  const int wm = wave >> 1, wn = wave & 1, r = lane & 31, hh = lane >> 5;
  const u16* H = (const u16*)(p.ws + WS_H);
  const u16* WTI = (const u16*)(p.ws + WS_WT_IN);
  const float* rope = (const float*)(p.ws + WS_ROPE);
  float* G = (float*)(p.ws + WS_G);
  {
    const bool xs = (gridDim.x & 7) == 0;
    const int nb = xs ? (gridDim.x >> 3) : gridDim.x;
    const int xcd = xs ? (blockIdx.x & 7) : 0, slot = xs ? (blockIdx.x >> 3) : blockIdx.x;
    const int nx = xs ? 8 : 1;
    const int seg0 = (1716 * xcd) / nx, seg1 = (1716 * (xcd + 1)) / nx;
#pragma unroll 1
    for (int L = seg0 + slot; L < seg1; L += nb) {
      int rt, ct;
      if (L < 1664) { const int g = L / 208, rem = L % 208; ct = rem >> 3; rt = 8 * g + (rem & 7); }
      else { const int rem = L - 1664; ct = rem >> 1; rt = 64 + (rem & 1); }
      const int row0 = rt * 256, n0 = ct * 256;
      f32x16 acc[2][4];
#pragma unroll
      for (int i = 0; i < 2; ++i)
#pragma unroll
        for (int j = 0; j < 4; ++j) acc[i][j] = zero16();
      gemm_core256<0>(acc, H + (size_t)row0 * 1024, 1024, WTI + (size_t)n0 * 1024, 1024, smem);
      const bool latent = row0 < 16384;
      const int b = latent ? (row0 >> 13) : ((row0 - 16384) >> 8);
      const int keybase = latent ? (row0 & 8191) : 8192;
      const int grp = n0 >> 9;
      const int fbase = (n0 & 511) + 128 * wn;
#pragma unroll
      for (int i = 0; i < 2; ++i)
#pragma unroll
        for (int g2 = 0; g2 < 2; ++g2)
          s2_store64(p, grp, acc[i][2 * g2], acc[i][2 * g2 + 1], row0 + 64 * wm + 32 * i, fbase + 64 * g2, latent, b,
                     keybase + 64 * wm + 32 * i, r, hh, rope);
    }
  }
#pragma unroll 1
  for (int rt = blockIdx.x; rt < 66; rt += gridDim.x) {
    const int row0 = rt * 256;
    f32x16 acc[2][2];
    acc[0][0] = zero16(); acc[0][1] = zero16(); acc[1][0] = zero16(); acc[1][1] = zero16();
    gemm_core<0, 2>(acc, H + (size_t)row0 * 1024, 1024, nullptr, nullptr, nullptr, nullptr, WTI + (size_t)9728 * 1024, 1024, smem);
    if (wn == 0) {
#pragma unroll
      for (int i = 0; i < 2; ++i)
#pragma unroll
        for (int e = 0; e < 16; ++e) {
          const int row = row0 + 64 * wm + 32 * i + (e & 3) + 8 * (e >> 2) + 4 * hh;
          if (r < 16) G[(size_t)row * 16 + r] = acc[i][0][e];
        }
    }
  }
}

__device__ __attribute__((always_inline)) void attn_item(const Params& p, int l, int b, int h, int qgrow0, int kt0, int kt1, unsigned char* smem) {
  u16* Ks = (u16*)smem;
  u16* Vs = (u16*)(smem + 34816);
  const int tid = opaque_tid(), lane = tid & 63, wave = tid >> 6;
  const int c = wave & 1, qg = wave >> 1, r = lane & 31, hh = lane >> 5;
  u16* QA = piece(p, P_QA);
  const u16* KA = piece(p, P_KA);
  const u16* VT = piece(p, P_VTA);
  const u16* ZA = piece(p, P_ZA);
  const float lam_init = 0.8f - 0.6f * expf(-0.3f * (float)l);
  float lam;
  {
    const float* lq = p.lam_q + l * 128;
    const float* lk = p.lam_k + l * 128;
    const float s0 = wave_sum(lq[lane] * lk[lane]);
    const float s1 = wave_sum(lq[64 + lane] * lk[64 + lane]);
    lam = expf(s0) - expf(s1) + lam_init;
  }
  const int qrow = qgrow0 + qg * 32 + r;
  bf16x8 qf[4];
#pragma unroll
  for (int ks = 0; ks < 4; ++ks) qf[ks] = *(const bf16x8*)(QA + (size_t)qrow * 512 + h * 128 + c * 64 + ks * 16 + hh * 8);
  f32x16 O[4];
#pragma unroll
  for (int i = 0; i < 4; ++i) O[i] = zero16();
  float m = -1e30f, lsum = 0.f;
  const int krow_l = tid >> 4, kc16 = tid & 15;
  const int vrow_l = tid >> 3, vc8 = tid & 7;
  v4u rk[2], rv[2];
#define ATT_LOADK(kt)                                                                             \
  {                                                                                               \
    const int key0 = (kt) * 64;                                                                   \
    const int gbase = (key0 < 8192) ? (b * 8192 + key0) : (16384 + b * 256 + key0 - 8192);        \
    _Pragma("unroll") for (int i = 0; i < 2; ++i)                                                 \
      rk[i] = *(const v4u*)(KA + (size_t)(gbase + krow_l + 32 * i) * 512 + h * 128 + kc16 * 8);   \
  }
#define ATT_LOADV(kt)                                                                             \
  {                                                                                               \
    const int key0 = (kt) * 64;                                                                   \
    _Pragma("unroll") for (int i = 0; i < 2; ++i)                                                 \
      rv[i] = *(const v4u*)(VT + ((size_t)(b * 512 + h * 128 + vrow_l + 64 * i)) * NKEY + key0 + vc8 * 8); \
  }
#define ATT_STOREK(buf)                                                                           \
  {                                                                                               \
    _Pragma("unroll") for (int i = 0; i < 2; ++i)                                                 \
      *(v4u*)(Ks + (buf) * 64 * 136 + (krow_l + 32 * i) * 136 + kc16 * 8) = rk[i];                \
  }
#define ATT_STOREV(buf)                                                                           \
  {                                                                                               \
    _Pragma("unroll") for (int i = 0; i < 2; ++i)                                                 \
      *(v4u*)(Vs + (buf) * 128 * 72 + (vrow_l + 64 * i) * 72 + vc8 * 8) = rv[i];                  \
  }
#define ATT_QK(Sx, buf)                                                                           \
  {                                                                                               \
    _Pragma("unroll") for (int kk = 0; kk < 2; ++kk) {                                            \
      Sx[kk] = zero16();                                                                          \
      _Pragma("unroll") for (int ks = 0; ks < 4; ++ks) {                                          \
        const bf16x8 kf = *(const bf16x8*)(Ks + (buf) * 64 * 136 + (32 * kk + r) * 136 + c * 64 + ks * 16 + hh * 8); \
        Sx[kk] = mfma32(kf, qf[ks], Sx[kk]);                                                      \
      }                                                                                           \
    }                                                                                             \
  }
  ATT_LOADK(kt0);
  ATT_LOADV(kt0);
  ATT_STOREK(0);
  ATT_STOREV(0);
  if (kt0 + 1 < kt1) { ATT_LOADK(kt0 + 1); ATT_STOREK(1); }
  __syncthreads();
  f32x16 S[2], Sn[2];
  ATT_QK(S, 0);
  if (kt0 + 2 < kt1) ATT_LOADK(kt0 + 2);
  if (kt0 + 1 < kt1) ATT_LOADV(kt0 + 1);
  for (int kt = kt0; kt < kt1; ++kt) {
    const int cur = (kt - kt0) & 1;
    if (kt + 1 < kt1) ATT_QK(Sn, cur ^ 1);
    float mx = -1e30f;
#pragma unroll
    for (int kk = 0; kk < 2; ++kk)
#pragma unroll
      for (int e = 0; e < 16; ++e) mx = fmaxf(mx, S[kk][e]);
    mx = fmaxf(mx, __shfl_xor(mx, 32, 64));
    const float mnew = fmaxf(m, mx);
    if (__builtin_amdgcn_ballot_w64(mnew > m) != 0ull) {
      const float alpha = ex2(m - mnew);
      lsum *= alpha;
#pragma unroll
      for (int i = 0; i < 4; ++i)
#pragma unroll
        for (int e = 0; e < 16; ++e) O[i][e] *= alpha;
    }
    m = mnew;
    bf16x8 pf[4];
#pragma unroll
    for (int kk = 0; kk < 2; ++kk)
#pragma unroll
      for (int s2 = 0; s2 < 2; ++s2) {
        v4u pkd;
#pragma unroll
        for (int jj = 0; jj < 4; ++jj) {
          const float p0 = ex2(S[kk][8 * s2 + 2 * jj] - mnew);
          const float p1 = ex2(S[kk][8 * s2 + 2 * jj + 1] - mnew);
          lsum += p0 + p1;
          pkd[jj] = pk2(p0, p1);
        }
        pf[2 * kk + s2] = (bf16x8)pkd;
      }
#pragma unroll
    for (int dvt = 0; dvt < 4; ++dvt)
#pragma unroll
      for (int s = 0; s < 4; ++s) {
        const bf16x8 vf = *(const bf16x8*)(Vs + cur * 128 * 72 + (32 * dvt + r) * 72 + 16 * s + 8 * hh);
        O[dvt] = mfma32(vf, pf[s], O[dvt]);
      }
    if (kt + 2 < kt1) ATT_STOREK(cur);
    if (kt + 1 < kt1) ATT_STOREV(cur ^ 1);
    if (kt + 3 < kt1) ATT_LOADK(kt + 3);
    if (kt + 2 < kt1) ATT_LOADV(kt + 2);
    __syncthreads();
    S[0] = Sn[0];
    S[1] = Sn[1];
  }
#undef ATT_LOADK
#undef ATT_LOADV
#undef ATT_STOREK
#undef ATT_STOREV
#undef ATT_QK
  const float ltot = lsum + __shfl_xor(lsum, 32, 64);
  const float inv = 1.f / ltot;
  float* X = (float*)smem;
  if (c == 1) {
#pragma unroll
    for (int dvt = 0; dvt < 4; ++dvt)
#pragma unroll
      for (int e = 0; e < 16; ++e) X[(qg * 128 + 32 * dvt + (e & 3) + 8 * (e >> 2) + 4 * hh) * 32 + r] = O[dvt][e] * inv;
  }
  __syncthreads();
  if (c == 0) {
    float ss = 0.f;
#pragma unroll
    for (int dvt = 0; dvt < 4; ++dvt)
#pragma unroll
      for (int e = 0; e < 16; ++e) {
        const float o = O[dvt][e] * inv - lam * X[(qg * 128 + 32 * dvt + (e & 3) + 8 * (e >> 2) + 4 * hh) * 32 + r];
        O[dvt][e] = o;
        ss += o * o;
      }
    ss += __shfl_xor(ss, 32, 64);
    const float rinv = rsqrtf(ss * (1.f / 128.f) + 1e-6f) * (1.f - lam_init);
    const float* dg = p.da_g + l * 128;
#pragma unroll
    for (int dvt = 0; dvt < 4; ++dvt)
#pragma unroll
      for (int g = 0; g < 4; ++g) {
        const int dv0 = 32 * dvt + 8 * g + 4 * hh;
        const size_t off = (size_t)qrow * 512 + h * 128 + dv0;
        const v2u z = *(const v2u*)(ZA + off);
        const float y0 = O[dvt][4 * g] * rinv * dg[dv0] * silu_f(bflo(z[0]));
        const float y1 = O[dvt][4 * g + 1] * rinv * dg[dv0 + 1] * silu_f(bfhi(z[0]));
        const float y2 = O[dvt][4 * g + 2] * rinv * dg[dv0 + 2] * silu_f(bflo(z[1]));
        const float y3 = O[dvt][4 * g + 3] * rinv * dg[dv0 + 3] * silu_f(bfhi(z[1]));
        v2u o;
        o[0] = pk2(y0, y1);
        o[1] = pk2(y2, y3);
        *(v2u*)(QA + off) = o;
      }
  }
  __syncthreads();
}

__device__ __attribute__((always_inline)) void natten_item(const Params& p, int l, int b, int rr, int qgrow, int i0, unsigned char* smem) {
  float* rp = (float*)smem;
  const int tid = opaque_tid(), lane = tid & 63, head = tid >> 6;
  const int r = lane & 31, hh = lane >> 5;
  for (int i = tid; i < 3720; i += NTHR) rp[i] = p.rpb[(size_t)l * 3720 + i];
  __syncthreads();
  u16* QC = piece(p, P_QC);
  const u16* KC = piece(p, P_KC);
  const u16* VT = piece(p, P_VTC);
  const u16* ZC = piece(p, P_ZC);
  const int rs = min(max(rr - 4, 0), 120);
  bf16x8 qf[2][4];
#pragma unroll
  for (int qt = 0; qt < 2; ++qt)
#pragma unroll
    for (int ks = 0; ks < 4; ++ks)
      qf[qt][ks] = *(const bf16x8*)(QC + (size_t)(qgrow + 32 * qt + r) * 512 + head * 64 + ks * 16 + hh * 8);
  f32x16 O[2][2];
  O[0][0] = zero16(); O[0][1] = zero16(); O[1][0] = zero16(); O[1][1] = zero16();
  float m[2] = {-1e30f, -1e30f}, lsum[2] = {0.f, 0.f};
  const float L2E = 1.4426950408889634f;
  for (int i = i0; i < 12; ++i) {
    const bool local = i < 8;
    const int krow = rs + i;
    const int kg0 = local ? (b * 8192 + krow * 64) : (16384 + b * 256 + (i - 8) * 64);
    const int key0 = local ? krow * 64 : 8192 + (i - 8) * 64;
    f32x16 S[2][2];
    S[0][0] = zero16(); S[0][1] = zero16(); S[1][0] = zero16(); S[1][1] = zero16();
#pragma unroll
    for (int kk = 0; kk < 2; ++kk)
#pragma unroll
      for (int ks = 0; ks < 4; ++ks) {
        const bf16x8 kf = *(const bf16x8*)(KC + (size_t)(kg0 + 32 * kk + r) * 512 + head * 64 + ks * 16 + hh * 8);
        S[kk][0] = mfma32(kf, qf[0][ks], S[kk][0]);
        S[kk][1] = mfma32(kf, qf[1][ks], S[kk][1]);
      }
    bf16x8 pf[2][4];
#pragma unroll
    for (int qt = 0; qt < 2; ++qt) {
      const int qcol = 32 * qt + r;
      const int cs = min(max(qcol - 8, 0), 48);
      const float* rprow = rp + (head * 15 + (local ? (krow - rr + 7) : 0)) * 31 + 15 - qcol;
      float mx = -1e30f;
#pragma unroll
      for (int kk = 0; kk < 2; ++kk)
#pragma unroll
        for (int e = 0; e < 16; ++e) {
          const int kcol = 32 * kk + (e & 3) + 8 * (e >> 2) + 4 * hh;
          float s = S[kk][qt][e];
          if (local) {
            const bool valid = (kcol >= cs) && (kcol < cs + 16);
            const int ci = min(max(kcol, cs), cs + 15);
            s = valid ? (s + rprow[ci] * L2E) : -1e30f;
          }
          S[kk][qt][e] = s;
          mx = fmaxf(mx, s);
        }
      mx = fmaxf(mx, __shfl_xor(mx, 32, 64));
      const float mnew = fmaxf(m[qt], mx);
      if (__builtin_amdgcn_ballot_w64(mnew > m[qt]) != 0ull) {
        const float alpha = ex2(m[qt] - mnew);
        lsum[qt] *= alpha;
#pragma unroll
        for (int dvt = 0; dvt < 2; ++dvt)
#pragma unroll
          for (int e = 0; e < 16; ++e) O[dvt][qt][e] *= alpha;
      }
      m[qt] = mnew;
#pragma unroll
      for (int kk = 0; kk < 2; ++kk)
#pragma unroll
        for (int s2 = 0; s2 < 2; ++s2) {
          v4u pkd;
#pragma unroll
          for (int jj = 0; jj < 4; ++jj) {
            const float p0 = ex2(S[kk][qt][8 * s2 + 2 * jj] - mnew);
            const float p1 = ex2(S[kk][qt][8 * s2 + 2 * jj + 1] - mnew);
            lsum[qt] += p0 + p1;
            pkd[jj] = pk2(p0, p1);
          }
          pf[qt][2 * kk + s2] = (bf16x8)pkd;
        }
    }
#pragma unroll
    for (int dvt = 0; dvt < 2; ++dvt)
#pragma unroll
      for (int s = 0; s < 4; ++s) {
        const bf16x8 vf = *(const bf16x8*)(VT + ((size_t)(b * 512 + head * 64 + 32 * dvt + r)) * NKEY + key0 + 16 * s + 8 * hh);
        O[dvt][0] = mfma32(vf, pf[0][s], O[dvt][0]);
        O[dvt][1] = mfma32(vf, pf[1][s], O[dvt][1]);
      }
  }
#pragma unroll
  for (int qt = 0; qt < 2; ++qt) {
    const float inv = 1.f / (lsum[qt] + __shfl_xor(lsum[qt], 32, 64));
    const int qrow = qgrow + 32 * qt + r;
#pragma unroll
    for (int dvt = 0; dvt < 2; ++dvt)
#pragma unroll
      for (int g = 0; g < 4; ++g) {
        const int dv0 = 32 * dvt + 8 * g + 4 * hh;
        const size_t off = (size_t)qrow * 512 + head * 64 + dv0;
        const v2u z = *(const v2u*)(ZC + off);
        v2u o;
        o[0] = pk2(O[dvt][qt][4 * g] * inv * silu_f(bflo(z[0])), O[dvt][qt][4 * g + 1] * inv * silu_f(bfhi(z[0])));
        o[1] = pk2(O[dvt][qt][4 * g + 2] * inv * silu_f(bflo(z[1])), O[dvt][qt][4 * g + 3] * inv * silu_f(bfhi(z[1])));
        *(v2u*)(QC + off) = o;
      }
  }
  __syncthreads();
}

__device__ __forceinline__ float logsigmoid_f(float x) { return fminf(x, 0.f) - log1pf(__expf(-fabsf(x))); }
__device__ __forceinline__ int chunk_grow0(int b, int P) { return P < 2 ? 16384 + b * 256 + 128 * P : b * 8192 + 128 * (P - 2); }
__device__ __forceinline__ int chunk_key0(int P) { return P < 2 ? 8192 + 128 * P : 128 * (P - 2); }

__device__ __forceinline__ void mlstm_gates(const Params& p, int l, int head, int grow0, float* lf, float* li) {
  const int tid = opaque_tid();
  if (tid < 256) {
    const int d = tid >> 7, s = tid & 127;
    const float* G = (const float*)(p.ws + WS_G) + (size_t)(grow0 + s) * 16;
    const float gi = G[d * 8 + head] + p.gate_b[l * 16 + d * 8 + head];
    const float gf = G[d * 8 + 4 + head] + p.gate_b[l * 16 + d * 8 + 4 + head];
    li[d * 128 + s] = gi;
    lf[d * 128 + s] = logsigmoid_f(gf);
  }
}

__device__ __forceinline__ void conv8(const Params& p, int l, const u16* src, int grow, int fcol, int ch0, bool hasprev,
                                      bool hasnext, float scale, float (&o)[8]) {
  const v4u zero = {0u, 0u, 0u, 0u};
  const v4u xm = hasprev ? *(const v4u*)(src + (size_t)(grow - 1) * 512 + fcol) : zero;
  const v4u x0 = *(const v4u*)(src + (size_t)grow * 512 + fcol);
  const v4u xp = hasnext ? *(const v4u*)(src + (size_t)(grow + 1) * 512 + fcol) : zero;
  const float* cw = p.conv_w + (size_t)l * 3 * 1024 + ch0;
  const float* cb = p.conv_b + (size_t)l * 1024 + ch0;
#pragma unroll
  for (int e = 0; e < 8; ++e) {
    const float a = (e & 1) ? bfhi(xm[e >> 1]) : bflo(xm[e >> 1]);
    const float bq = (e & 1) ? bfhi(x0[e >> 1]) : bflo(x0[e >> 1]);
    const float cq = (e & 1) ? bfhi(xp[e >> 1]) : bflo(xp[e >> 1]);
    const float y = a * cw[e] + bq * cw[1024 + e] + cq * cw[2048 + e] + cb[e];
    o[e] = silu_f(y) * scale;
  }
}

__device__ __attribute__((always_inline)) void mlstm_b1_item(const Params& p, int l, int b, int head, int P, unsigned char* smem) {
  u16* kwT = (u16*)smem;
  float* lf = (float*)(smem + 69632);
  float* li = lf + 256;
  float* wS = li + 256;
  const int tid = opaque_tid(), lane = tid & 63, wave = tid >> 6;
  const int r = lane & 31, hh = lane >> 5;
  const int grow0 = chunk_grow0(b, P), key0 = chunk_key0(P);
  float* BL = (float*)(p.ws + WS_BL);
  float* DN = (float*)(p.ws + WS_DN);
  u16* CST = (u16*)(p.ws + WS_H);
  mlstm_gates(p, l, head, grow0, lf, li);
  __syncthreads();
  if (tid < 256) {
    const int d = tid >> 7, s = tid & 127;
    float tot = 0.f, bs = 0.f;
    for (int j = 0; j < 128; ++j) {
      const float v = lf[d * 128 + j];
      tot += v;
      if (d == 0 ? (j <= s) : (j >= s)) bs += v;
    }
    wS[d * 128 + s] = __expf(tot - bs + li[d * 128 + s]);
    if (s == 0) BL[((b * 4 + head) * 2 + d) * 66 + P] = tot;
  }
  __syncthreads();
  const u16* KB = piece(p, P_KB);
#pragma unroll 1
  for (int i = 0; i < 4; ++i) {
    const int u = tid + NTHR * i;
    const int s = u >> 4, dg = u & 15;
    const bool hasprev = !((P == 0 || P == 2) && s == 0);
    const bool hasnext = !((P == 1 || P == 65) && s == 127);
    float kc[8];
    conv8(p, l, KB, grow0 + s, head * 128 + dg * 8, 512 + head * 128 + dg * 8, hasprev, hasnext, 0.08838834764831845f, kc);
    const int ps = perm16(s);
    const float w0 = wS[s], w1 = wS[128 + s];
#pragma unroll
    for (int e = 0; e < 8; ++e) {
      kwT[(dg * 8 + e) * 136 + ps] = f2bf(kc[e] * w0);
      kwT[(128 + dg * 8 + e) * 136 + ps] = f2bf(kc[e] * w1);
    }
  }
  __syncthreads();
  {
    const int d = wave >> 2, dvt = wave & 3;
    const u16* VT = piece(p, P_VTB);
    bf16x8 vf[8];
#pragma unroll
    for (int s8 = 0; s8 < 8; ++s8)
      vf[s8] = *(const bf16x8*)(VT + ((size_t)(b * 512 + head * 128 + 32 * dvt + r)) * NKEY + key0 + 16 * s8 + 8 * hh);
    const int chain = (b * 4 + head) * 2 + d;
    u16* dst = CST + ((size_t)(chain * 66 + P)) * 16384;
#pragma unroll
    for (int dkt = 0; dkt < 4; ++dkt) {
      f32x16 acc = zero16();
#pragma unroll
      for (int s8 = 0; s8 < 8; ++s8) {
        const bf16x8 kf = *(const bf16x8*)(kwT + (d * 128 + 32 * dkt + r) * 136 + 16 * s8 + 8 * hh);
        acc = mfma32(vf[s8], kf, acc);
      }
#pragma unroll
      for (int e = 0; e < 16; ++e) {
        const int dv = 32 * dvt + (e & 3) + 8 * (e >> 2) + 4 * hh;
        dst[dv * 128 + 32 * dkt + r] = f2bf(acc[e]);
      }
    }
  }
  if (tid < 256) {
    const int d = tid >> 7, dk = tid & 127;
    float s = 0.f;
    for (int j = 0; j < 128; ++j) s += bf2f(kwT[(d * 128 + dk) * 136 + j]);
    DN[(((b * 4 + head) * 2 + d) * 66 + P) * 128 + dk] = s;
  }
  __syncthreads();
}

__device__ __attribute__((always_inline)) void phase_b2(const Params& p) {
  const int gid = blockIdx.x * NTHR + threadIdx.x;
  const float* BL = (const float*)(p.ws + WS_BL);
  if (gid < 131072) {
    const int chain = gid >> 13, e2 = gid & 8191;
    const int d = chain & 1;
    unsigned* base = (unsigned*)(p.ws + WS_H) + (size_t)chain * 66 * 8192 + e2;
    float c0 = 0.f, c1 = 0.f;
    for (int i0 = 0; i0 < 66; i0 += 6) {
      unsigned v[6];
      float a[6];
#pragma unroll
      for (int j = 0; j < 6; ++j) {
        const int i = i0 + j;
        const int P = d == 0 ? i : (i < 2 ? 1 - i : 67 - i);
        v[j] = base[(size_t)P * 8192];
        a[j] = __expf(BL[chain * 66 + P]);
      }
#pragma unroll
      for (int j = 0; j < 6; ++j) {
        const int i = i0 + j;
        const int P = d == 0 ? i : (i < 2 ? 1 - i : 67 - i);
        base[(size_t)P * 8192] = pk2(c0, c1);
        c0 = a[j] * c0 + bflo(v[j]);
        c1 = a[j] * c1 + bfhi(v[j]);
      }
    }
  }
  if (gid < 2048) {
    const int chain = gid >> 7, dk = gid & 127;
    const int d = chain & 1;
    const float* DN = (const float*)(p.ws + WS_DN);
    float* NP = (float*)(p.ws + WS_NPREV);
    float run = 0.f;
    for (int i = 0; i < 66; ++i) {
      const int P = d == 0 ? i : (i < 2 ? 1 - i : 67 - i);
      NP[(chain * 66 + P) * 128 + dk] = run;
      run = __expf(BL[chain * 66 + P]) * run + DN[(chain * 66 + P) * 128 + dk];
    }
  }
}

__device__ __attribute__((always_inline)) void mlstm_b3_item(const Params& p, int l, int b, int head, int P, unsigned char* smem) {
  u16* qS = (u16*)smem;
  u16* kS = (u16*)(smem + 34816);
  u16* pS = (u16*)(smem + 69632);
  float* fb = (float*)(smem + 104448);
  float* lf = fb;
  float* li = fb + 256;
  float* bc = fb + 512;
  float* colsum = fb + 768;
  float* nS = fb + 1280;
  float* nq = fb + 1536;
  float* cfs = fb + 1792;
  float* hsq = fb + 2048;
  const int tid = opaque_tid(), lane = tid & 63, wave = tid >> 6;
  const int r = lane & 31, hh = lane >> 5;
  const int grow0 = chunk_grow0(b, P), key0 = chunk_key0(P);
  const int chainF = (b * 4 + head) * 2, chainB = chainF + 1;
  mlstm_gates(p, l, head, grow0, lf, li);
  __syncthreads();
  if (tid < 256) {
    const int d = tid >> 7, s = tid & 127;
    float bs = 0.f;
    for (int j = 0; j < 128; ++j) {
      const float v = lf[d * 128 + j];
      if (d == 0 ? (j <= s) : (j >= s)) bs += v;
    }
    bc[d * 128 + s] = bs;
    nS[d * 128 + s] = ((const float*)(p.ws + WS_NPREV))[((chainF + d) * 66 + P) * 128 + s];
  }
  {
    const u16* QB = piece(p, P_QB);
    const u16* KB = piece(p, P_KB);
#pragma unroll 1
    for (int i = 0; i < 4; ++i) {
      const int u = tid + NTHR * i;
      const int s = u >> 4, dg = u & 15;
      const bool hasprev = !((P == 0 || P == 2) && s == 0);
      const bool hasnext = !((P == 1 || P == 65) && s == 127);
      float o[8];
      conv8(p, l, QB, grow0 + s, head * 128 + dg * 8, head * 128 + dg * 8, hasprev, hasnext, 1.f, o);
      v4u pk;
      pk[0] = pk2(o[0], o[1]); pk[1] = pk2(o[2], o[3]); pk[2] = pk2(o[4], o[5]); pk[3] = pk2(o[6], o[7]);
      *(v4u*)(qS + s * 136 + dg * 8) = pk;
      conv8(p, l, KB, grow0 + s, head * 128 + dg * 8, 512 + head * 128 + dg * 8, hasprev, hasnext, 0.08838834764831845f, o);
      pk[0] = pk2(o[0], o[1]); pk[1] = pk2(o[2], o[3]); pk[2] = pk2(o[4], o[5]); pk[3] = pk2(o[6], o[7]);
      *(v4u*)(kS + s * 136 + dg * 8) = pk;
    }
  }
  __syncthreads();
  if (tid < 256) {
    const int d = tid >> 7, t = tid & 127;
    float s = 0.f;
    for (int k = 0; k < 128; ++k) s += nS[d * 128 + k] * bf2f(qS[t * 136 + k]);
    nq[d * 128 + t] = s;
  }
  f32x16 Pf[2], Pb[2];
  {
    const int tt = wave & 3, sh = wave >> 2;
    const int t = 32 * tt + r;
    bf16x8 qf[8];
#pragma unroll
    for (int ks = 0; ks < 8; ++ks) qf[ks] = *(const bf16x8*)(qS + t * 136 + 16 * ks + 8 * hh);
    const float bFt = bc[t], bBt = bc[128 + t];
    float csf = 0.f, csb = 0.f;
#pragma unroll
    for (int st2 = 0; st2 < 2; ++st2) {
      const int stile = 2 * sh + st2;
      f32x16 S = zero16();
#pragma unroll
      for (int ks = 0; ks < 8; ++ks) {
        const bf16x8 kf = *(const bf16x8*)(kS + (32 * stile + r) * 136 + 16 * ks + 8 * hh);
        S = mfma32(kf, qf[ks], S);
      }
#pragma unroll
      for (int e = 0; e < 16; ++e) {
        const int s = 32 * stile + (e & 3) + 8 * (e >> 2) + 4 * hh;
        const float raw = S[e];
        const float pf_ = (s <= t) ? raw * __expf(bFt - bc[s] + li[s]) : 0.f;
        const float pb_ = (s >= t) ? raw * __expf(bBt - bc[128 + s] + li[128 + s]) : 0.f;
        Pf[st2][e] = pf_;
        Pb[st2][e] = pb_;
        csf += pf_;
        csb += pb_;
      }
    }
    csf += __shfl_xor(csf, 32, 64);
    csb += __shfl_xor(csb, 32, 64);
    if (hh == 0) {
      colsum[(0 * 2 + sh) * 128 + t] = csf;
      colsum[(1 * 2 + sh) * 128 + t] = csb;
    }
  }
  __syncthreads();
  {
    const int tt = wave & 3, sh = wave >> 2;
    const int t = 32 * tt + r;
    const float eF = __expf(bc[t]), eB = __expf(bc[128 + t]);
    const float denF = eF * nq[t] + colsum[0 * 128 + t] + colsum[1 * 128 + t];
    const float denB = eB * nq[128 + t] + colsum[2 * 128 + t] + colsum[3 * 128 + t];
    const float invF = 1.f / fmaxf(fabsf(denF), 1.f);
    const float invB = 1.f / fmaxf(fabsf(denB), 1.f);
    if (sh == 0 && hh == 0) {
      cfs[t] = eF * invF;
      cfs[128 + t] = eB * invB;
    }
#pragma unroll
    for (int st2 = 0; st2 < 2; ++st2) {
      const int stile = 2 * sh + st2;
#pragma unroll
      for (int g = 0; g < 4; ++g) {
        v2u pk;
        pk[0] = pk2(Pf[st2][4 * g] * invF + Pb[st2][4 * g] * invB, Pf[st2][4 * g + 1] * invF + Pb[st2][4 * g + 1] * invB);
        pk[1] = pk2(Pf[st2][4 * g + 2] * invF + Pb[st2][4 * g + 2] * invB, Pf[st2][4 * g + 3] * invF + Pb[st2][4 * g + 3] * invB);
        const int pos = 32 * stile + 16 * (g >> 1) + 4 * (hh * 2 + (g & 1));
        *(v2u*)(pS + t * 136 + pos) = pk;
      }
    }
  }
  __syncthreads();
  const int dvt = wave & 3, tp = wave >> 2;
  f32x16 hacc[2];
  {
    const u16* VT = piece(p, P_VTB);
    const u16* CST = (const u16*)(p.ws + WS_H);
    f32x16 aP[2], aF[2], aB[2];
#pragma unroll
    for (int t2 = 0; t2 < 2; ++t2) { aP[t2] = zero16(); aF[t2] = zero16(); aB[t2] = zero16(); }
#pragma unroll
    for (int s8 = 0; s8 < 8; ++s8) {
      const bf16x8 vf = *(const bf16x8*)(VT + ((size_t)(b * 512 + head * 128 + 32 * dvt + r)) * NKEY + key0 + 16 * s8 + 8 * hh);
#pragma unroll
      for (int t2 = 0; t2 < 2; ++t2) {
        const bf16x8 pf_ = *(const bf16x8*)(pS + (32 * (2 * tp + t2) + r) * 136 + 16 * s8 + 8 * hh);
        aP[t2] = mfma32(vf, pf_, aP[t2]);
      }
    }
    const u16* cF = CST + ((size_t)(chainF * 66 + P)) * 16384 + (32 * dvt + r) * 128 + 8 * hh;
    const u16* cB = CST + ((size_t)(chainB * 66 + P)) * 16384 + (32 * dvt + r) * 128 + 8 * hh;
#pragma unroll
    for (int ks = 0; ks < 8; ++ks) {
      const bf16x8 f1 = *(const bf16x8*)(cF + 16 * ks);
      const bf16x8 f2 = *(const bf16x8*)(cB + 16 * ks);
#pragma unroll
      for (int t2 = 0; t2 < 2; ++t2) {
        const bf16x8 qf = *(const bf16x8*)(qS + (32 * (2 * tp + t2) + r) * 136 + 16 * ks + 8 * hh);
        aF[t2] = mfma32(f1, qf, aF[t2]);
        aB[t2] = mfma32(f2, qf, aB[t2]);
      }
    }
#pragma unroll
    for (int t2 = 0; t2 < 2; ++t2) {
      const int t = 32 * (2 * tp + t2) + r;
      const float cf = cfs[t], cb = cfs[128 + t];
      float ss = 0.f;
#pragma unroll
      for (int e = 0; e < 16; ++e) {
        const float hv = aP[t2][e] + cf * aF[t2][e] + cb * aB[t2][e];
        hacc[t2][e] = hv;
        ss += hv * hv;
      }
      ss += __shfl_xor(ss, 32, 64);
      if (hh == 0) hsq[dvt * 128 + t] = ss;
    }
  }
  __syncthreads();
  {
    u16* OB = piece(p, P_OB);
    const u16* ZB = piece(p, P_ZB);
    const float* mg = p.ml_g + l * 128;
#pragma unroll
    for (int t2 = 0; t2 < 2; ++t2) {
      const int t = 32 * (2 * tp + t2) + r;
      const float rinv = rsqrtf((hsq[t] + hsq[128 + t] + hsq[256 + t] + hsq[384 + t]) * (1.f / 128.f) + 1e-6f);
#pragma unroll
      for (int g = 0; g < 4; ++g) {
        const int dv0 = 32 * dvt + 8 * g + 4 * hh;
        const size_t off = (size_t)(grow0 + t) * 512 + head * 128 + dv0;
        const v2u ov = *(const v2u*)(OB + off);
        const v2u zv = *(const v2u*)(ZB + off);
        const float y0 = sigmoid_f(bflo(ov[0])) * hacc[t2][4 * g] * rinv * mg[dv0] * silu_f(bflo(zv[0]));
        const float y1 = sigmoid_f(bfhi(ov[0])) * hacc[t2][4 * g + 1] * rinv * mg[dv0 + 1] * silu_f(bfhi(zv[0]));
        const float y2 = sigmoid_f(bflo(ov[1])) * hacc[t2][4 * g + 2] * rinv * mg[dv0 + 2] * silu_f(bflo(zv[1]));
        const float y3 = sigmoid_f(bfhi(ov[1])) * hacc[t2][4 * g + 3] * rinv * mg[dv0 + 3] * silu_f(bfhi(zv[1]));
        v2u o;
        o[0] = pk2(y0, y1);
        o[1] = pk2(y2, y3);
        *(v2u*)(OB + off) = o;
      }
    }
  }
  __syncthreads();
}

__device__ __attribute__((always_inline)) void phase_s3(const Params& p, int l, unsigned char* smem) {
  const int nActx = (l == 0) ? 16 : 0, nCctx = (l == 0) ? 8 : 0;
  if ((gridDim.x & 7) == 0) {
    const int xcd = blockIdx.x & 7, slot = blockIdx.x >> 3, nb = gridDim.x >> 3;
#pragma unroll 1
    for (int q = slot; q < 64 + (nActx >> 3); q += nb) {
      const int b = xcd >> 2, h = xcd & 3;
      if (q < 64) attn_item(p, l, b, h, b * 8192 + q * 128, 0, 132, smem);
      else attn_item(p, l, b, h, 16384 + b * 256 + (q - 64) * 128, 128, 132, smem);
    }
  } else {
#pragma unroll 1
    for (int j = blockIdx.x; j < 512 + nActx; j += gridDim.x) {
      if (j < 512) {
        const int b = j >> 8, h = (j >> 6) & 3, qb = j & 63;
        attn_item(p, l, b, h, b * 8192 + qb * 128, 0, 132, smem);
      } else {
        const int jj = j - 512;
        const int b = jj >> 3, h = (jj >> 1) & 3, qh = jj & 1;
        attn_item(p, l, b, h, 16384 + b * 256 + qh * 128, 128, 132, smem);
      }
    }
  }
#pragma unroll 1
  for (int j = (blockIdx.x + gridDim.x - 32) % gridDim.x; j < 528; j += gridDim.x) {
    const int b = j / 264, rem = j % 264, head = rem / 66, P = rem % 66;
    mlstm_b1_item(p, l, b, head, P, smem);
  }
#pragma unroll 1
  for (int j = (blockIdx.x + gridDim.x - 64) % gridDim.x; j < 256 + nCctx; j += gridDim.x) {
    if (j < 256) natten_item(p, l, j >> 7, j & 127, (j >> 7) * 8192 + (j & 127) * 64, 0, smem);
    else natten_item(p, l, (j - 256) >> 2, 0, 16384 + ((j - 256) >> 2) * 256 + ((j - 256) & 3) * 64, 8, smem);
  }
}

__device__ __attribute__((always_inline)) void h2_rows(const Params& p, int l) {
  const int tid = opaque_tid(), lane = tid & 63, wave = tid >> 6;
  u16* H2 = slotp(p, 3);
  const float* rstd = (const float*)(p.ws + WS_RSTD);
  for (int row = blockIdx.x * 8 + wave; row < R_TOT; row += gridDim.x * 8) {
    const float* xr = xrow(p, l, row);
    const int w = which_of(row);
    const float* gs = (const float*)(p.ws + WS_GS) + w * 1024;
    const float* sh = (const float*)(p.ws + WS_SH) + w * 1024;
    const float rs = rstd[row];
#pragma unroll
    for (int j = 0; j < 4; ++j) {
      const int k = lane * 4 + 256 * j;
      const v4f v = *(const v4f*)(xr + k);
      const v4f g = *(const v4f*)(gs + k);
      const v4f sf = *(const v4f*)(sh + k);
      v2u pk;
      pk[0] = pk2(v[0] * rs * g[0] + sf[0], v[1] * rs * g[1] + sf[1]);
      pk[1] = pk2(v[2] * rs * g[2] + sf[2], v[3] * rs * g[3] + sf[3]);
      *(v2u*)(H2 + (size_t)row * 1024 + k) = pk;
    }
  }
}

__device__ __attribute__((always_inline)) void phase_s5(const Params& p, int l, unsigned char* smem) {
  h2_rows(p, l);
  const int P0 = (l == 0) ? 0 : 2;
  const int nP = 66 - P0;
  for (int it = (blockIdx.x + gridDim.x - 96) % gridDim.x; it < 8 * nP; it += gridDim.x) {
    const int bh = it / nP, P = P0 + it % nP;
    mlstm_b3_item(p, l, bh >> 2, bh & 3, P, smem);
  }
}

__device__ __forceinline__ void s6a_tile(const Params& p, int rt, int ct, unsigned char* smem) {
  const int tid = opaque_tid(), lane = tid & 63, wave = tid >> 6;
  const int wm = wave >> 1, wn = wave & 1, r = lane & 31, hh = lane >> 5;
  const u16* H2 = slotp(p, 3);
  const u16* WTI = (const u16*)(p.ws + WS_WT_IN);
  u16* G = slotp(p, 5);
  const int row0 = rt * 256;
  f32x16 acc[2][2];
  acc[0][0] = zero16(); acc[0][1] = zero16(); acc[1][0] = zero16(); acc[1][1] = zero16();
  gemm_core<0, 2>(acc, H2 + (size_t)row0 * 1024, 1024, nullptr, nullptr, nullptr, nullptr,
                  WTI + (size_t)(6656 + ct * 128) * 1024, 1024, smem);
  u16* Gn = G + (size_t)(ct >> 3) * R_TOT * 1024;
  const int d0 = (ct & 7) * 128 + 64 * wn + r;
#pragma unroll
  for (int i = 0; i < 2; ++i)
#pragma unroll
    for (int e = 0; e < 16; ++e) {
      const int row = row0 + 64 * wm + 32 * i + (e & 3) + 8 * (e >> 2) + 4 * hh;
      gu16* rp = (gu16*)Gn + (size_t)row * 1024 + d0;
      asm volatile("" : "+v"(rp));
      rp[0] = f2bf(sigmoid_f(acc[i][0][e]));
      rp[32] = f2bf(sigmoid_f(acc[i][1][e]));
    }
}

__device__ __forceinline__ void s6a_tile256(const Params& p, int rt, int ct, unsigned char* smem) {
  const int tid = opaque_tid(), lane = tid & 63, wave = tid >> 6;
  const int wm = wave >> 1, wn = wave & 1, r = lane & 31, hh = lane >> 5;
  const u16* H2 = slotp(p, 3);
  const u16* WTI = (const u16*)(p.ws + WS_WT_IN);
  u16* G = slotp(p, 5);
  const int row0 = rt * 256;
  f32x16 acc[2][4];
#pragma unroll
  for (int i = 0; i < 2; ++i)
#pragma unroll
    for (int j = 0; j < 4; ++j) acc[i][j] = zero16();
  gemm_core256<1>(acc, H2 + (size_t)row0 * 1024, 1024, WTI + (size_t)(6656 + ct * 256) * 1024, 1024, smem);
  u16* Gn = G + (size_t)(ct >> 2) * R_TOT * 1024;
  const int d0 = (ct & 3) * 256 + 128 * wn + r;
#pragma unroll
  for (int i = 0; i < 2; ++i)
#pragma unroll
    for (int e = 0; e < 16; ++e) {
      const int row = row0 + 64 * wm + 32 * i + (e & 3) + 8 * (e >> 2) + 4 * hh;
      gu16* rp = (gu16*)Gn + (size_t)row * 1024 + d0;
      asm volatile("" : "+v"(rp));
#pragma unroll
      for (int j = 0; j < 4; ++j) {
        float v = acc[i][j][e];
        asm volatile("" : "+v"(v));
        rp[32 * j] = f2bf(sigmoid_f(v));
      }
    }
}

__device__ __attribute__((always_inline)) void phase_s6a(const Params& p, int l, unsigned char* smem) {
  {
    const bool xs = (gridDim.x & 7) == 0;
    const int nb = xs ? (gridDim.x >> 3) : gridDim.x;
    const int xcd = xs ? (blockIdx.x & 7) : 0, slot = xs ? (blockIdx.x >> 3) : blockIdx.x;
    const int seg0 = xs ? 96 * xcd : 0, seg1 = xs ? 96 * (xcd + 1) : 768;
#pragma unroll 1
    for (int L = seg0 + slot; L < seg1; L += nb) {
      const int g = L / 96, rem = L % 96;
      s6a_tile256(p, 8 * g + (rem & 7), rem >> 3, smem);
    }
  }
  if (l == 0) {
#pragma unroll 1
    for (int it = blockIdx.x; it < 48; it += gridDim.x) s6a_tile(p, 64 + (it & 1), it >> 1, smem);
  }
}

template <int MI>
__device__ __forceinline__ void s6b_tile(const Params& p, int row0, int ct, unsigned char* smem) {
  const int tid = opaque_tid(), lane = tid & 63, wave = tid >> 6;
  const int wm = wave >> 1, wn = wave & 1, r = lane & 31, hh = lane >> 5;
  const u16* WTB = (const u16*)(p.ws + WS_WT_BR);
  const u16* G = slotp(p, 5);
  u16* M = (u16*)(p.ws + WS_H);
  f32x16 tot[MI][2];
#pragma unroll
  for (int i = 0; i < MI; ++i) { tot[i][0] = zero16(); tot[i][1] = zero16(); }
#pragma unroll 1
  for (int n = 0; n < 3; ++n) {
    f32x16 ap[MI][2];
#pragma unroll
    for (int i = 0; i < MI; ++i) { ap[i][0] = zero16(); ap[i][1] = zero16(); }
    gemm_core<0, MI>(ap, slotp(p, n) + (size_t)row0 * 512, 512, nullptr, nullptr, nullptr, nullptr,
                     WTB + (size_t)(n * 1024 + ct * 128) * 512, 512, smem);
    const u16* Gn = G + (size_t)n * R_TOT * 1024;
#pragma unroll
    for (int i = 0; i < MI; ++i)
#pragma unroll
      for (int e = 0; e < 16; ++e) {
        const int row = row0 + 32 * MI * wm + 32 * i + (e & 3) + 8 * (e >> 2) + 4 * hh;
        const gu16* rp = (const gu16*)Gn + (size_t)row * 1024 + ct * 128 + 64 * wn + r;
        asm volatile("" : "+v"(rp));
        tot[i][0][e] += bf2f(rp[0]) * ap[i][0][e];
        tot[i][1][e] += bf2f(rp[32]) * ap[i][1][e];
      }
  }
#pragma unroll
  for (int i = 0; i < MI; ++i)
#pragma unroll
    for (int e = 0; e < 16; ++e) {
      const int row = row0 + 32 * MI * wm + 32 * i + (e & 3) + 8 * (e >> 2) + 4 * hh;
      gu16* rp = (gu16*)M + (size_t)row * 1024 + ct * 128 + 64 * wn + r;
      asm volatile("" : "+v"(rp));
      rp[0] = f2bf(tot[i][0][e]);
      rp[32] = f2bf(tot[i][1][e]);
    }
}

__device__ __attribute__((always_inline)) void phase_s6b(const Params& p, int l, unsigned char* smem) {
  {
    const bool xs = (gridDim.x & 7) == 0;
    const int nb = xs ? (gridDim.x >> 3) : gridDim.x;
    const int xcd = xs ? (blockIdx.x & 7) : 0, slot = xs ? (blockIdx.x >> 3) : blockIdx.x;
    const int seg0 = xs ? 128 * xcd : 0, seg1 = xs ? 128 * (xcd + 1) : 1024;
#pragma unroll 1
    for (int L = seg0 + slot; L < seg1; L += nb) {
      const int g = L >> 7, rem = L & 127, ct = rem >> 4, rt = 16 * g + (rem & 15);
      s6b_tile<1>(p, rt * 128, ct, smem);
    }
  }
  if (l == 0) {
#pragma unroll 1
    for (int it = blockIdx.x; it < 32; it += gridDim.x) s6b_tile<1>(p, 16384 + (it & 3) * 128, it >> 2, smem);
  }
}

template <int MI>
__device__ __forceinline__ void s7_tile(const Params& p, int l, int row0, int ct, unsigned char* smem) {
  const int tid = opaque_tid(), lane = tid & 63, wave = tid >> 6;
  const int wm = wave >> 1, wn = wave & 1, r = lane & 31, hh = lane >> 5;
  const u16* WTO = (const u16*)(p.ws + WS_WT_OUT);
  const u16* M = (const u16*)(p.ws + WS_H);
  const float* mod = (const float*)(p.ws + WS_MOD) + (size_t)l * 3 * 3072;
  const int w = which_of(row0);
  f32x16 acc[MI][2];
#pragma unroll
  for (int i = 0; i < MI; ++i) { acc[i][0] = zero16(); acc[i][1] = zero16(); }
  gemm_core<0, MI>(acc, M + (size_t)row0 * 1024, 1024, nullptr, nullptr, nullptr, nullptr, WTO + (size_t)(ct * 128) * 1024, 1024, smem);
  const float* xs_ = xrow(p, l, row0);
  float* xd = (row0 < 16384) ? (p.out + (size_t)row0 * 1024) : ((float*)(p.ws + WS_XC) + (size_t)(row0 - 16384) * 1024);
  const int col0 = ct * 128 + 64 * wn + r;
  const float g0 = mod[w * 3072 + 2048 + col0], g1 = mod[w * 3072 + 2048 + col0 + 32];
#pragma unroll
  for (int i = 0; i < MI; ++i)
#pragma unroll
    for (int e = 0; e < 16; ++e) {
      const size_t off = (size_t)(32 * MI * wm + 32 * i + (e & 3) + 8 * (e >> 2) + 4 * hh) * 1024 + col0;
      const gfloat* sp = (const gfloat*)xs_ + off;
      gfloat* dp = (gfloat*)xd + off;
      asm volatile("" : "+v"(sp), "+v"(dp));
      dp[0] = sp[0] + g0 * acc[i][0][e];
      dp[32] = sp[32] + g1 * acc[i][1][e];
    }
}

__device__ __attribute__((always_inline)) void phase_s7(const Params& p, int l, unsigned char* smem) {
  {
    const bool xs = (gridDim.x & 7) == 0;
    const int nb = xs ? (gridDim.x >> 3) : gridDim.x;
    const int xcd = xs ? (blockIdx.x & 7) : 0, slot = xs ? (blockIdx.x >> 3) : blockIdx.x;
    const int seg0 = xs ? 64 * xcd : 0, seg1 = xs ? 64 * (xcd + 1) : 512;
#pragma unroll 1
    for (int L = seg0 + slot; L < seg1; L += nb) {
      const int g = L >> 6, rem = L & 63;
      s7_tile<2>(p, l, (8 * g + (rem & 7)) * 256, rem >> 3, smem);
    }
  }
  if (l == 0) {
#pragma unroll 1
    for (int it = blockIdx.x; it < 32; it += gridDim.x) s7_tile<1>(p, l, 16384 + (it & 3) * 128, it >> 2, smem);
  }
}

__device__ __attribute__((always_inline)) void phase_final(const Params& p) {
  const int tid = threadIdx.x, lane = tid & 63, wave = tid >> 6;
  for (int row = blockIdx.x * 8 + wave; row < 16384; row += gridDim.x * 8) {
    float* xr = p.out + (size_t)row * 1024;
    v4f v[4];
    float ss = 0.f;
#pragma unroll
    for (int j = 0; j < 4; ++j) {
      v[j] = *(const v4f*)(xr + lane * 4 + 256 * j);
      ss += v[j][0] * v[j][0] + v[j][1] * v[j][1] + v[j][2] * v[j][2] + v[j][3] * v[j][3];
    }
    ss = wave_sum(ss);
    const float rs = rsqrtf(ss * (1.f / 1024.f) + 1e-6f);
#pragma unroll
    for (int j = 0; j < 4; ++j) {
      const v4f g = *(const v4f*)(p.final_g + lane * 4 + 256 * j);
      v4f o;
#pragma unroll
      for (int e = 0; e < 4; ++e) o[e] = v[j][e] * rs * g[e];
      *(v4f*)(xr + lane * 4 + 256 * j) = o;
    }
  }
}

#define XB_TMO      128
#define XB_XCNT(j)  (256  + 64 * (j))
#define XB_XSUB(j)  (1280 + 64 * (j))
#define XB_XGEN(j)  (2304 + 64 * (j))
#define XB_TOP      3328
#define XB_TOPGEN   3392
#define XCD_BAR_WORDS 3456
#define XB_SPIN_CAP (1u << 18)
#define LAS __attribute__((address_space(3)))

__device__ __forceinline__ unsigned xb_ld(unsigned* p)              { return __hip_atomic_load(p, __ATOMIC_RELAXED, __HIP_MEMORY_SCOPE_AGENT); }
__device__ __forceinline__ unsigned xb_add(unsigned* p, unsigned v) { return __hip_atomic_fetch_add(p, v, __ATOMIC_RELAXED, __HIP_MEMORY_SCOPE_AGENT); }
__device__ __forceinline__ unsigned xb_xcc_id() { return (unsigned)__builtin_amdgcn_s_getreg((3 << 11) | 20) & 0xFu; }
#define XB_SPIN(cond, bar) do { unsigned _sp = 0; while (cond) { __builtin_amdgcn_s_sleep(1); \
    if ((++_sp & 255u) == 0u) { if (xb_ld(&(bar)[XB_TMO])) break; if (_sp > XB_SPIN_CAP) { atomicAdd(&(bar)[XB_TMO], 1u); break; } } } } while (0)

struct XcdBarrier {
    unsigned* bar; unsigned x;
    volatile LAS unsigned* st;
};

__device__ __forceinline__ XcdBarrier xcd_barrier_post(unsigned* bar, volatile LAS unsigned* st) {
    XcdBarrier b; b.bar = bar; b.x = xb_xcc_id(); b.st = st;
    if (threadIdx.x == 0) (void)xb_add(&bar[XB_XCNT(b.x)], 1u);
    return b;
}
__device__ __forceinline__ void xcd_barrier_complete(unsigned* bar, unsigned x, unsigned& nloc, unsigned& nx) {
    const unsigned G = gridDim.x * gridDim.y * gridDim.z;
    unsigned sum, cnt, mine, sp = 0u;
    for (;;) {
        sum = 0u; cnt = 0u; mine = 0u;
#pragma unroll
        for (unsigned j = 0; j < 16; ++j) { const unsigned c = xb_ld(&bar[XB_XCNT(j)]); sum += c; cnt += (c > 0u) ? 1u : 0u; mine = (j == x) ? c : mine; }
        if (sum == G) break;
        __builtin_amdgcn_s_sleep(1);
        if ((++sp & 255u) == 0u) { if (xb_ld(&bar[XB_TMO])) break; if (sp > XB_SPIN_CAP) { atomicAdd(&bar[XB_TMO], 1u); break; } }
    }
    nloc = mine > 0u ? mine : 1u; nx = cnt > 0u ? cnt : 1u;
}

__device__ __forceinline__ void xcd_barrier(const XcdBarrier& b) {
    asm volatile("s_waitcnt vmcnt(0)" ::: "memory");
    __syncthreads();
    if (threadIdx.x == 0) {
        unsigned* bar = b.bar;
        __builtin_amdgcn_s_waitcnt(0);
        unsigned nloc = b.st[0], nx = b.st[1];
        if (nloc == 0u) { xcd_barrier_complete(bar, b.x, nloc, nx); b.st[0] = nloc; b.st[1] = nx; }
        const unsigned old = xb_add(&bar[XB_XSUB(b.x)], 1u);
        const unsigned gen = old / nloc;
        if (old + 1u == (gen + 1u) * nloc) {
            __builtin_amdgcn_fence(__ATOMIC_RELEASE, "agent");
            asm volatile("s_waitcnt vmcnt(0)" ::: "memory");
            const unsigned og = xb_add(&bar[XB_TOP], 1u);
            const unsigned tg = og / nx;
            if (og + 1u == (tg + 1u) * nx) xb_add(&bar[XB_TOPGEN], 1u);
            else XB_SPIN(xb_ld(&bar[XB_TOPGEN]) == tg, bar);
            __builtin_amdgcn_fence(__ATOMIC_ACQUIRE, "agent");
            xb_add(&bar[XB_XGEN(b.x)], 1u);
            asm volatile("s_waitcnt vmcnt(0)" ::: "memory");
        } else {
            XB_SPIN(xb_ld(&bar[XB_XGEN(b.x)]) == gen, bar);
            __builtin_amdgcn_fence(__ATOMIC_ACQUIRE, "agent");
            asm volatile("s_waitcnt vmcnt(0)" ::: "memory");
        }
    }
    __syncthreads();
}


__global__ void __launch_bounds__(NTHR) fwd_megakernel(Params p) {
  extern __shared__ __attribute__((aligned(16))) unsigned char smem[];
  cg::grid_group grid = cg::this_grid();
  __shared__ uint4 xb_words;
  if (threadIdx.x == 0) xb_words = make_uint4(0u, 0u, 0u, 0u);
  __syncthreads();
  XcdBarrier xbar = xcd_barrier_post((unsigned*)(p.ws + WS_BAR), (volatile LAS unsigned*)&xb_words);
#define PH(k, call)                                  \
  if (p.ph_lo <= (k) && (k) < p.ph_hi) {             \
    call;                                            \
    if ((k) + 1 < p.ph_hi) { if ((k) == 0) grid.sync(); else xcd_barrier(xbar); }  \
  }
  PH(0, phase_s0(p))
  PH(1, phase_s1(p, 0, smem))
  PH(2, phase_s2(p, 0, smem))
  PH(3, phase_s3(p, 0, smem))
  PH(4, phase_b2(p))
  PH(5, phase_s5(p, 0, smem))
  PH(6, phase_s6a(p, 0, smem))
  PH(7, phase_s6b(p, 0, smem))
  PH(8, phase_s7(p, 0, smem))
  PH(9, phase_s1(p, 1, smem))
  PH(10, phase_s2(p, 1, smem))
  PH(11, phase_s3(p, 1, smem))
  PH(12, phase_b2(p))
  PH(13, phase_s5(p, 1, smem))
  PH(14, phase_s6a(p, 1, smem))
  PH(15, phase_s6b(p, 1, smem))
  PH(16, phase_s7(p, 1, smem))
  PH(17, phase_final(p))
#undef PH
}

extern "C" void kernel_launch(void* const* d_in, const int* in_sizes, int n_in, void* d_out, int out_size,
                              void* d_ws, size_t ws_size, hipStream_t stream) {
  static int grid_blocks = 0;
  if (grid_blocks == 0) {
    if (n_in != 19 || ws_size < WS_END) {
      fprintf(stderr, "kernel_launch: unexpected n_in %d or ws_size %zu (< %llu)\n", n_in, ws_size, (unsigned long long)WS_END);
      grid_blocks = -1;
      return;
    }
    int dev = 0, cus = 0, per_cu = 0;
    hipGetDevice(&dev);
    hipDeviceGetAttribute(&cus, hipDeviceAttributeMultiprocessorCount, dev);
    if (hipFuncSetAttribute((const void*)fwd_megakernel, hipFuncAttributeMaxDynamicSharedMemorySize, LDS_BYTES) != hipSuccess) {
      fprintf(stderr, "kernel_launch: hipFuncSetAttribute failed\n");
      grid_blocks = -1;
      return;
    }
    hipOccupancyMaxActiveBlocksPerMultiprocessor(&per_cu, (const void*)fwd_megakernel, NTHR, LDS_BYTES);
    if (per_cu < 1) { fprintf(stderr, "kernel_launch: occupancy query says %d blocks/CU\n", per_cu); per_cu = 1; }
    (void)hipGetLastError();
    grid_blocks = cus;
  }
  if (grid_blocks < 0) return;
  hipMemsetAsync((char*)d_ws + WS_MOD, 0, 73728, stream);
  hipMemsetAsync((char*)d_ws + WS_BAR, 0, 13824, stream);
  Params p{};
  p.x = (const float*)d_in[0]; p.c = (const float*)d_in[1]; p.ctx = (const float*)d_in[2]; p.c_ctx = (const float*)d_in[3];
  p.w_mod = (const float*)d_in[4]; p.b_mod = (const float*)d_in[5]; p.norm_g = (const float*)d_in[6]; p.w_in = (const float*)d_in[7];
  p.lam_q = (const float*)d_in[8]; p.lam_k = (const float*)d_in[9]; p.da_g = (const float*)d_in[10];
  p.conv_w = (const float*)d_in[11]; p.conv_b = (const float*)d_in[12]; p.gate_b = (const float*)d_in[13]; p.ml_g = (const float*)d_in[14];
  p.rpb = (const float*)d_in[15]; p.w_br = (const float*)d_in[16]; p.w_out = (const float*)d_in[17]; p.final_g = (const float*)d_in[18];
  p.out = (float*)d_out; p.ws = (unsigned char*)d_ws;
#if MULTI_LAUNCH
  for (int ph = 0; ph < NPHASE; ++ph) {
    p.ph_lo = ph; p.ph_hi = ph + 1;
    hipLaunchKernelGGL(fwd_megakernel, dim3(grid_blocks), dim3(NTHR), LDS_BYTES, stream, p);
  }
#else
  p.ph_lo = 0; p.ph_hi = NPHASE;
  void* args[] = {&p};
  hipError_t e = hipLaunchCooperativeKernel((void*)fwd_megakernel, dim3(grid_blocks), dim3(NTHR), args, LDS_BYTES, stream);
  if (e != hipSuccess) fprintf(stderr, "cooperative launch failed: %s (grid %d)\n", hipGetErrorString(e), grid_blocks);
#endif
}
```

```cpp
#include <hip/hip_runtime.h>
#include <hip/hip_cooperative_groups.h>
#include <cstdio>
namespace cg = cooperative_groups;

#ifndef MULTI_LAUNCH
#define MULTI_LAUNCH 0
#endif

typedef unsigned short u16;
typedef __attribute__((ext_vector_type(8))) short bf16x8;
typedef __attribute__((ext_vector_type(16))) float f32x16;
typedef __attribute__((ext_vector_type(4))) unsigned int v4u;
typedef __attribute__((ext_vector_type(2))) unsigned int v2u;
typedef __attribute__((ext_vector_type(4))) float v4f;

#define R_TOT 16896
#define NKEY 8448
#define NPAD 9856
#define NTHR 512
#define LDS_BYTES 147456
#define NPHASE 18

#define WS_WT_IN 0ull
#define WS_WT_BR 20185088ull
#define WS_WT_OUT 23330816ull
#define WS_H 25427968ull
#define WS_PIECE 60030976ull
#define PIECE_SZ 17301504ull
#define WS_XC 284950528ull
#define WS_G 287047680ull
#define WS_MOD 289410816ull
#define WS_ROPE 288202752ull
#define WS_RSTD 288219136ull
#define WS_DN 288286720ull
#define WS_NPREV 288827392ull
#define WS_BL 289368064ull
#define WS_GS 289372416ull
#define WS_SH 289384704ull
#define WS_BAR 289396992ull
#define WS_END 289484544ull

enum { P_QA = 0, P_KA, P_VTA, P_ZA, P_QB, P_KB, P_VTB, P_OB, P_ZB, P_QC, P_KC, P_VTC, P_ZC };

#define GAS __attribute__((address_space(1)))
typedef GAS u16 gu16;
typedef GAS float gfloat;
typedef GAS v2u gv2u;
typedef GAS v4f gv4f;
struct Params {
  const float *x, *c, *ctx, *c_ctx, *w_mod, *b_mod, *norm_g, *w_in, *lam_q, *lam_k, *da_g,
      *conv_w, *conv_b, *gate_b, *ml_g, *rpb, *w_br, *w_out, *final_g;
  float* out;
  unsigned char* ws;
  int ph_lo, ph_hi;
};

__device__ __forceinline__ int opaque_tid() { int t = threadIdx.x; asm volatile("" : "+v"(t)); return t; }
__device__ __forceinline__ u16 f2bf(float f) {
  unsigned u = __float_as_uint(f);
  u += 0x7fffu + ((u >> 16) & 1u);
  return (u16)(u >> 16);
}
__device__ __forceinline__ float bf2f(u16 h) { return __uint_as_float(((unsigned)h) << 16); }
typedef __attribute__((ext_vector_type(2))) __bf16 bf16x2_t;
typedef __attribute__((ext_vector_type(2))) float f32x2_t;
__device__ __forceinline__ unsigned pk2(float a, float b) { f32x2_t v = {a, b}; bf16x2_t r = __builtin_convertvector(v, bf16x2_t); return __builtin_bit_cast(unsigned, r); }
__device__ __forceinline__ float bflo(unsigned u) { return __uint_as_float(u << 16); }
__device__ __forceinline__ float bfhi(unsigned u) { return __uint_as_float(u & 0xffff0000u); }
__device__ __forceinline__ float silu_f(float x) { return x / (1.f + __expf(-x)); }
__device__ __forceinline__ float sigmoid_f(float x) { return 1.f / (1.f + __expf(-x)); }
__device__ __forceinline__ float ex2(float x) { return __builtin_amdgcn_exp2f(x); }
__device__ __forceinline__ float wave_sum(float v) {
#pragma unroll
  for (int o = 32; o > 0; o >>= 1) v += __shfl_xor(v, o, 64);
  return v;
}
__device__ __forceinline__ f32x16 mfma32(bf16x8 a, bf16x8 b, f32x16 c) {
  return __builtin_amdgcn_mfma_f32_32x32x16_bf16(a, b, c, 0, 0, 0);
}
__device__ __forceinline__ f32x16 zero16() {
  f32x16 z;
#pragma unroll
  for (int i = 0; i < 16; ++i) z[i] = 0.f;
  return z;
}
__device__ __forceinline__ int pslot(int i) { return (int)((0xCBA2918765430ull >> (4 * i)) & 15ull); }
__device__ __forceinline__ u16* piece(const Params& p, int i) { return (u16*)(p.ws + WS_PIECE + (size_t)pslot(i) * PIECE_SZ); }
__device__ __forceinline__ u16* slotp(const Params& p, int sl) { return (u16*)(p.ws + WS_PIECE + (size_t)sl * PIECE_SZ); }
__device__ __forceinline__ const float* xrow(const Params& p, int l, int grow) {
  if (grow < 16384) return (l == 0 ? p.x : (const float*)p.out) + (size_t)grow * 1024;
  return (l == 0 ? p.ctx : (const float*)(p.ws + WS_XC)) + (size_t)(grow - 16384) * 1024;
}
__device__ __forceinline__ int which_of(int grow) { return grow < 8192 ? 0 : (grow < 16384 ? 1 : 2); }
__device__ __forceinline__ int perm16(int s) { return (s & ~15) | (((s >> 2) & 1) << 3) | (((s >> 3) & 1) << 2) | (s & 3); }

__device__ __attribute__((always_inline)) void phase_s0(const Params& p) {
  const int tid = threadIdx.x;
  float* mod = (float*)(p.ws + WS_MOD);
  for (int it = blockIdx.x; it < 2 * 12 * 16; it += gridDim.x) {
    const int l = it / 192, rem = it % 192, nch = rem / 16, kch = rem % 16;
    const int kh = tid >> 8, n = nch * 256 + (tid & 255);
    const int k0 = kch * 64 + kh * 32;
    const float* W = p.w_mod + (size_t)l * 1024 * 3072;
    float a0 = 0.f, a1 = 0.f, a2 = 0.f;
#pragma unroll 8
    for (int k = k0; k < k0 + 32; ++k) {
      const float w = W[(size_t)k * 3072 + n];
      a0 += silu_f(p.c[k]) * w;
      a1 += silu_f(p.c[1024 + k]) * w;
      a2 += silu_f(p.c_ctx[k]) * w;
    }
    if (kch == 0 && kh == 0) {
      const float bb = p.b_mod[l * 3072 + n];
      a0 += bb; a1 += bb; a2 += bb;
    }
    atomicAdd(&mod[(l * 3 + 0) * 3072 + n], a0);
    atomicAdd(&mod[(l * 3 + 1) * 3072 + n], a1);
    atomicAdd(&mod[(l * 3 + 2) * 3072 + n], a2);
  }
  const int gi = blockIdx.x * NTHR + tid;
  if (gi < 2048) {
    const int v = gi >> 4, f = gi & 15;
    const float inv = (float)exp(-(double)f * (9.210340371976184 / 16.0));
    const float angf = (float)v * inv;
    double a = (double)angf;
    const double twopi = 6.283185307179586476925;
    a -= twopi * floor(a / twopi + 0.5);
    const double a2 = a * a;
    double ts = a, tc = 1.0, sn = a, cs = 1.0;
    for (int i = 1; i <= 14; ++i) {
      tc = -tc * a2 / (double)((2 * i - 1) * (2 * i));
      ts = -ts * a2 / (double)((2 * i) * (2 * i + 1));
      cs += tc; sn += ts;
    }
    float* rt = (float*)(p.ws + WS_ROPE);
    rt[gi * 2] = (float)cs;
    rt[gi * 2 + 1] = (float)sn;
  }
}

__device__ __attribute__((always_inline)) void conv_tile(const float* __restrict__ src, int ld, int k0, int col0, int nvalid, bool perm,
                          u16* __restrict__ dst, int ldd, int n0, unsigned char* smem) {
  u16* t = (u16*)smem;
  const int tid = opaque_tid();
#pragma unroll
  for (int i = 0; i < 2; ++i) {
    const int idx = tid + NTHR * i;
    const int kk = idx >> 4, c4 = idx & 15;
    v4f v = {0.f, 0.f, 0.f, 0.f};
    if (4 * c4 < nvalid) v = *(const v4f*)(src + (size_t)(k0 + kk) * ld + col0 + 4 * c4);
#pragma unroll
    for (int e = 0; e < 4; ++e) {
      const int j = 4 * c4 + e;
      const int jp = perm ? (32 * (j >> 5) + 8 * (((j >> 1) & 15) >> 2) + 4 * (j & 1) + ((j >> 1) & 3)) : j;
      t[jp * 72 + kk] = f2bf(v[e]);
    }
  }
  __syncthreads();
  {
    const int n = tid >> 3, ch = tid & 7;
    const v4u v = *(const v4u*)(t + n * 72 + ch * 8);
    *(v4u*)(dst + (size_t)(n0 + n) * ldd + k0 + ch * 8) = v;
  }
  __syncthreads();
}

__device__ __attribute__((always_inline)) void phase_s1(const Params& p, int l, unsigned char* smem) {
  const int tid = threadIdx.x, lane = tid & 63, wave = tid >> 6;
  const float* mod = (const float*)(p.ws + WS_MOD) + (size_t)l * 3 * 3072;
  const float* g = p.norm_g + l * 1024;
  u16* H = (u16*)(p.ws + WS_H);
  float* rstd = (float*)(p.ws + WS_RSTD);
  if (blockIdx.x == 0) {
    float* gs = (float*)(p.ws + WS_GS);
    float* sh = (float*)(p.ws + WS_SH);
    for (int i = tid; i < 3072; i += NTHR) {
      const int w = i >> 10, k = i & 1023;
      gs[i] = g[k] * (1.f + mod[w * 3072 + 1024 + k]);
      sh[i] = mod[w * 3072 + k];
    }
  }
#pragma unroll 2
  for (int row = blockIdx.x * 8 + wave; row < R_TOT; row += gridDim.x * 8) {
    const float* xr = xrow(p, l, row);
    const int w = which_of(row);
    v4f v[4];
    float ss = 0.f;
#pragma unroll
    for (int j = 0; j < 4; ++j) {
      v[j] = *(const v4f*)(xr + lane * 4 + 256 * j);
      ss += v[j][0] * v[j][0] + v[j][1] * v[j][1] + v[j][2] * v[j][2] + v[j][3] * v[j][3];
    }
    ss = wave_sum(ss);
    const float rs = rsqrtf(ss * (1.f / 1024.f) + 1e-6f);
    if (lane == 0) rstd[row] = rs;
#pragma unroll
    for (int j = 0; j < 4; ++j) {
      const int k = lane * 4 + 256 * j;
      const v4f gg = *(const v4f*)(g + k);
      const v4f sc = *(const v4f*)(mod + w * 3072 + 1024 + k);
      const v4f sf = *(const v4f*)(mod + w * 3072 + k);
      float o[4];
#pragma unroll
      for (int e = 0; e < 4; ++e) o[e] = v[j][e] * rs * gg[e] * (1.f + sc[e]) + sf[e];
      v2u pk;
      pk[0] = pk2(o[0], o[1]);
      pk[1] = pk2(o[2], o[3]);
      *(v2u*)(H + (size_t)row * 1024 + k) = pk;
    }
  }
  u16* WTI = (u16*)(p.ws + WS_WT_IN);
  u16* WTB = (u16*)(p.ws + WS_WT_BR);
  u16* WTO = (u16*)(p.ws + WS_WT_OUT);
  const float* win = p.w_in + (size_t)l * 1024 * 9744;
  for (int it = blockIdx.x; it < 2464 + 384 + 256; it += gridDim.x) {
    if (it < 2464) {
      const int nb = it % 154, kb = it / 154;
      const int n0 = nb * 64;
      int col0 = n0, nvalid = 64;
      bool perm = n0 < 1024;
      if (n0 >= 4608 && n0 < 9728) col0 = n0 + 16;
      else if (n0 == 9728) { col0 = 4608; nvalid = 16; }
      else if (n0 > 9728) { col0 = 0; nvalid = 0; }
      conv_tile(win, 9744, kb * 64, col0, nvalid, perm, WTI, 1024, n0, smem);
    } else if (it < 2464 + 384) {
      const int j = it - 2464;
      const int n = j / 128, r = j % 128, db = r / 8, wb = r % 8;
      conv_tile(p.w_br + ((size_t)l * 3 + n) * 512 * 1024, 1024, wb * 64, db * 64, 64, false,
                WTB + (size_t)n * 1024 * 512, 512, db * 64, smem);
    } else {
      const int j = it - 2464 - 384;
      const int db = j / 16, kb = j % 16;
      conv_tile(p.w_out + (size_t)l * 1024 * 1024, 1024, kb * 64, db * 64, 64, false, WTO, 1024, db * 64, smem);
    }
  }
}

template <int AMODE, int MI>
__device__ __forceinline__ void gemm_core(f32x16 (&acc)[MI][2], const u16* __restrict__ A, int lda,
                                          const float* __restrict__ Ax, const float* __restrict__ rstd,
                                          const float* __restrict__ gs, const float* __restrict__ sh,
                                          const u16* __restrict__ B, int K, unsigned char* smem) {
  constexpr int AROWS = 128 * MI;
  u16* As = (u16*)smem;
  u16* Bs = (u16*)(smem + 73728);
  const int tid = opaque_tid(), lane = tid & 63, wave = tid >> 6;
  const int wm = wave >> 1, wn = wave & 1, r = lane & 31, hh = lane >> 5;
  const int lrow = tid >> 3, c8 = tid & 7;
  v4u ra[2][2 * MI], rb[2][2];
  float rs4[2 * MI];
  if (AMODE == 1) {
#pragma unroll
    for (int i = 0; i < 2 * MI; ++i) rs4[i] = rstd[lrow + 64 * i];
  }
  const int KT = K >> 6;
#define GEMM_LOAD(set, k0)                                                                        \
  {                                                                                               \
    if (AMODE == 0) {                                                                             \
      _Pragma("unroll") for (int i = 0; i < 2 * MI; ++i)                                          \
        ra[set][i] = *(const v4u*)(A + (size_t)(lrow + 64 * i) * lda + (k0) + c8 * 8);            \
    } else {                                                                                      \
      const v4f g0 = *(const v4f*)(gs + (k0) + c8 * 8), g1 = *(const v4f*)(gs + (k0) + c8 * 8 + 4); \
      const v4f s0 = *(const v4f*)(sh + (k0) + c8 * 8), s1 = *(const v4f*)(sh + (k0) + c8 * 8 + 4); \
      _Pragma("unroll") for (int i = 0; i < 2 * MI; ++i) {                                        \
        const float* xp = Ax + (size_t)(lrow + 64 * i) * 1024 + (k0) + c8 * 8;                    \
        const v4f x0 = *(const v4f*)xp, x1 = *(const v4f*)(xp + 4);                               \
        const float rr = rs4[i];                                                                  \
        ra[set][i][0] = pk2(x0[0] * rr * g0[0] + s0[0], x0[1] * rr * g0[1] + s0[1]);              \
        ra[set][i][1] = pk2(x0[2] * rr * g0[2] + s0[2], x0[3] * rr * g0[3] + s0[3]);              \
        ra[set][i][2] = pk2(x1[0] * rr * g1[0] + s1[0], x1[1] * rr * g1[1] + s1[1]);              \
        ra[set][i][3] = pk2(x1[2] * rr * g1[2] + s1[2], x1[3] * rr * g1[3] + s1[3]);              \
      }                                                                                           \
    }                                                                                             \
    _Pragma("unroll") for (int i = 0; i < 2; ++i)                                                 \
        rb[set][i] = *(const v4u*)(B + (size_t)(lrow + 64 * i) * K + (k0) + c8 * 8);              \
  }
#define GEMM_STORE(set, buf)                                                                      \
  {                                                                                               \
    _Pragma("unroll") for (int i = 0; i < 2 * MI; ++i)                                            \
        *(v4u*)(As + (buf) * AROWS * 72 + (lrow + 64 * i) * 72 + c8 * 8) = ra[set][i];            \
    _Pragma("unroll") for (int i = 0; i < 2; ++i)                                                 \
        *(v4u*)(Bs + (buf) * 128 * 72 + (lrow + 64 * i) * 72 + c8 * 8) = rb[set][i];              \
  }
#define GEMM_COMPUTE(cur)                                                                         \
  {                                                                                               \
    const u16* Ab = As + (cur) * AROWS * 72 + (32 * MI * wm + r) * 72 + 8 * hh;                   \
    const u16* Bb = Bs + (cur) * 128 * 72 + (64 * wn + r) * 72 + 8 * hh;                          \
    _Pragma("unroll") for (int ks = 0; ks < 4; ++ks) {                                            \
      const bf16x8 b0 = *(const bf16x8*)(Bb + ks * 16);                                           \
      const bf16x8 b1 = *(const bf16x8*)(Bb + 32 * 72 + ks * 16);                                 \
      _Pragma("unroll") for (int i = 0; i < MI; ++i) {                                            \
        const bf16x8 a0 = *(const bf16x8*)(Ab + i * 32 * 72 + ks * 16);                           \
        acc[i][0] = mfma32(a0, b0, acc[i][0]);                                                    \
        acc[i][1] = mfma32(a0, b1, acc[i][1]);                                                    \
      }                                                                                           \
    }                                                                                             \
  }
  GEMM_LOAD(0, 0);
  GEMM_LOAD(1, 64);
  GEMM_STORE(0, 0);
  __syncthreads();
  for (int kt = 0; kt < KT; kt += 2) {
    if (kt + 2 < KT) GEMM_LOAD(0, (kt + 2) * 64);
    GEMM_COMPUTE(0);
    GEMM_STORE(1, 1);
    __syncthreads();
    if (kt + 3 < KT) GEMM_LOAD(1, (kt + 3) * 64);
    GEMM_COMPUTE(1);
    if (kt + 2 < KT) GEMM_STORE(0, 0);
    __syncthreads();
  }
#undef GEMM_COMPUTE
#undef GEMM_LOAD
#undef GEMM_STORE
}

__device__ __forceinline__ void gemm_core_lean2(f32x16 (&acc)[2][2], const u16* __restrict__ A, int lda,
                                                const u16* __restrict__ B, int K, unsigned char* smem) {
  u16* As = (u16*)smem;
  u16* Bs = (u16*)(smem + 73728);
  const int tid = opaque_tid(), lane = tid & 63, wave = tid >> 6;
  const int wm = wave >> 1, wn = wave & 1, r = lane & 31, hh = lane >> 5;
  const int lrow = tid >> 3, c8 = tid & 7;
  v4u ra[4], rb[2];
  const int KT = K >> 6;
#define GL_LOAD(k0)                                                                               \
  {                                                                                               \
    _Pragma("unroll") for (int i = 0; i < 4; ++i)                                                 \
      ra[i] = *(const v4u*)(A + (size_t)(lrow + 64 * i) * lda + (k0) + c8 * 8);                   \
    _Pragma("unroll") for (int i = 0; i < 2; ++i)                                                 \
      rb[i] = *(const v4u*)(B + (size_t)(lrow + 64 * i) * K + (k0) + c8 * 8);                     \
  }
#define GL_STORE(buf)                                                                             \
  {                                                                                               \
    _Pragma("unroll") for (int i = 0; i < 4; ++i)                                                 \
      *(v4u*)(As + (buf) * 256 * 72 + (lrow + 64 * i) * 72 + c8 * 8) = ra[i];                     \
    _Pragma("unroll") for (int i = 0; i < 2; ++i)                                                 \
      *(v4u*)(Bs + (buf) * 128 * 72 + (lrow + 64 * i) * 72 + c8 * 8) = rb[i];                     \
  }
  GL_LOAD(0);
  GL_STORE(0);
  __syncthreads();
  if (KT > 1) GL_LOAD(64);
  for (int kt = 0; kt < KT; ++kt) {
    const int cur = kt & 1;
    const u16* Ab = As + cur * 256 * 72 + (64 * wm + r) * 72 + 8 * hh;
    const u16* Bb = Bs + cur * 128 * 72 + (64 * wn + r) * 72 + 8 * hh;
#pragma unroll
    for (int ks = 0; ks < 4; ++ks) {
      __builtin_amdgcn_sched_barrier(0);
      const bf16x8 a0 = *(const bf16x8*)(Ab + ks * 16);
      const bf16x8 a1 = *(const bf16x8*)(Ab + 32 * 72 + ks * 16);
      const bf16x8 b0 = *(const bf16x8*)(Bb + ks * 16);
      const bf16x8 b1 = *(const bf16x8*)(Bb + 32 * 72 + ks * 16);
      acc[0][0] = mfma32(a0, b0, acc[0][0]);
      acc[0][1] = mfma32(a0, b1, acc[0][1]);
      acc[1][0] = mfma32(a1, b0, acc[1][0]);
      acc[1][1] = mfma32(a1, b1, acc[1][1]);
    }
    if (kt + 1 < KT) {
      GL_STORE(cur ^ 1);
      if (kt + 2 < KT) GL_LOAD((kt + 2) * 64);
    }
    __syncthreads();
  }
#undef GL_LOAD
#undef GL_STORE
}

template <int LEAN>
__device__ __forceinline__ void gemm_core256(f32x16 (&acc)[2][4], const u16* __restrict__ A, int lda,
                                             const u16* __restrict__ B, int K, unsigned char* smem) {
  u16* As = (u16*)smem;
  u16* Bs = (u16*)(smem + 73728);
  const int tid = opaque_tid(), lane = tid & 63, wave = tid >> 6;
  const int wm = wave >> 1, wn = wave & 1, r = lane & 31, hh = lane >> 5;
  const int lrow = tid >> 3, c8 = tid & 7;
  v4u ra[4], rb[4];
  const int KT = K >> 6;
#define G2_LOAD(k0)                                                                               \
  {                                                                                               \
    _Pragma("unroll") for (int i = 0; i < 4; ++i) {                                               \
      ra[i] = *(const v4u*)(A + (size_t)(lrow + 64 * i) * lda + (k0) + c8 * 8);                   \
      rb[i] = *(const v4u*)(B + (size_t)(lrow + 64 * i) * K + (k0) + c8 * 8);                     \
    }                                                                                             \
  }
#define G2_STORE(buf)                                                                             \
  {                                                                                               \
    _Pragma("unroll") for (int i = 0; i < 4; ++i) {                                               \
      *(v4u*)(As + (buf) * 256 * 72 + (lrow + 64 * i) * 72 + c8 * 8) = ra[i];                     \
      *(v4u*)(Bs + (buf) * 256 * 72 + (lrow + 64 * i) * 72 + c8 * 8) = rb[i];                     \
    }                                                                                             \
  }
  G2_LOAD(0);
  G2_STORE(0);
  __syncthreads();
  if (KT > 1) G2_LOAD(64);
  for (int kt = 0; kt < KT; ++kt) {
    const int cur = kt & 1;
    const u16* Ab = As + cur * 256 * 72 + (64 * wm + r) * 72 + 8 * hh;
    const u16* Bb = Bs + cur * 256 * 72 + (128 * wn + r) * 72 + 8 * hh;
#pragma unroll
    for (int ks = 0; ks < 4; ++ks) {
      if (LEAN) __builtin_amdgcn_sched_barrier(0);
      const bf16x8 a0 = *(const bf16x8*)(Ab + ks * 16);
      const bf16x8 a1 = *(const bf16x8*)(Ab + 32 * 72 + ks * 16);
#pragma unroll
      for (int j = 0; j < 4; ++j) {
        const bf16x8 b0 = *(const bf16x8*)(Bb + j * 32 * 72 + ks * 16);
        acc[0][j] = mfma32(a0, b0, acc[0][j]);
        acc[1][j] = mfma32(a1, b0, acc[1][j]);
      }
    }
    if (kt + 1 < KT) {
      G2_STORE(cur ^ 1);
      if (kt + 2 < KT) G2_LOAD((kt + 2) * 64);
    }
    __syncthreads();
  }
#undef G2_LOAD
#undef G2_STORE
}

namespace pg8 {
#define PG8_LAS __attribute__((address_space(3)))
typedef unsigned short bf16_t;
typedef short bf16x8 __attribute__((ext_vector_type(8)));
typedef float f32x4 __attribute__((ext_vector_type(4)));
typedef unsigned u32x4 __attribute__((ext_vector_type(4)));
constexpr int BM = 256, BK = 64, HALF = 128, HTB = HALF * BK * 2  , STAGE_BYTES = 8 * HTB, NXCD = 8, WGM = 8;

__host__ __device__ __forceinline__ int lds_byte(int r, int c) { const int st = (r >> 4) * 2 + (c >> 5), rr = r & 15, cc = c & 31, ob = rr * 64 + cc * 2; return st * 1024 + (ob ^ (((ob >> 9) & 1) << 5)); }
__host__ __device__ __forceinline__ void stage_rc(int b, int& R, int& C) { const int st = b / 1024, sb = b % 1024, swz = sb ^ (((sb >> 9) & 1) << 5); R = (st >> 1) * 16 + swz / 64; C = (st & 1) * 32 + (swz % 64) / 2; }
__host__ __device__ __forceinline__ int perm32(int rho) { const int n = rho >> 4, i = rho & 15; return 8 * (i >> 2) + 4 * n + (i & 3); }

struct Unit { int pm, pn; };
struct Gemm { const bf16_t* A; const bf16_t* Bt; int M, N, K; };

template <class Epi, class Sched, bool STAMP = false>
__device__ __forceinline__ void gemm_phase(PG8_LAS unsigned char* lds, const Gemm g, const Sched& S, const Epi& E, unsigned long long* stamps) {
    const int tid = threadIdx.x, wid = __builtin_amdgcn_readfirstlane(tid >> 6), lane = tid & 63, wr = wid >> 2, wc = wid & 3, fr = lane & 15, fq = lane >> 4;
    const int K = g.K, nt = K / BK;
    int ts_lo = 0, ts_hi = 0, nts = 0; const unsigned long long rt_entry = STAMP ? (unsigned long long)wall_clock64() : 0ull;
#define PG8_STAMP() do { if (STAMP && wid == 0 && nts < 64) { const unsigned long long _c = (unsigned long long)clock64(); \
        ts_lo = (lane == nts) ? (int)(unsigned)_c : ts_lo; ts_hi = (lane == nts) ? (int)(unsigned)(_c >> 32) : ts_hi; ++nts; } } while (0)
    PG8_STAMP();
    unsigned voffA[2], voffB[2];
#pragma unroll
    for (int i = 0; i < 2; ++i) { int R, C; stage_rc(tid * 16 + i * 8192, R, C); const int Rb = Epi::PERM ? ((R & ~31) + perm32(R & 31)) : R;
        voffA[i] = (unsigned)(R * K + C) * 2u; voffB[i] = (unsigned)(Rb * K + C) * 2u; }
    const size_t kstep = (size_t)(BK * 2);
    const size_t hstep = (size_t)HALF * K * 2;
    const size_t tstep = 2 * hstep;
    const unsigned ldsw = (unsigned)wid * 1024u;
    const int aoff = lds_byte(wr * 64 + fr, fq * 8), boff = lds_byte(wc * 32 + fr, fq * 8);
#define PG8_SA(b, h) (((b) * 2 + (h)) * HTB)
#define PG8_SB(b, h) ((4 + (b) * 2 + (h)) * HTB)
#define PG8_STAGE(bufoff, gbase, voff) do { _Pragma("unroll") for (int _i = 0; _i < 2; ++_i) \
        __builtin_amdgcn_global_load_lds((const unsigned*)((const char*)(gbase) + (voff)[_i]), (PG8_LAS unsigned*)(lds + (bufoff) + ldsw + _i * 8192), 16, 0, 0); } while (0)
#define PG8_LDA(dst, b, h) do { _Pragma("unroll") for (int m = 0; m < 4; ++m) _Pragma("unroll") for (int k = 0; k < 2; ++k) dst[m][k] = *(const PG8_LAS bf16x8*)(lds + PG8_SA(b, h) + aoff + m * 2048 + k * 1024); } while (0)
#define PG8_LDB(dst, b, h) do { _Pragma("unroll") for (int n = 0; n < 2; ++n) _Pragma("unroll") for (int k = 0; k < 2; ++k) dst[n][k] = *(const PG8_LAS bf16x8*)(lds + PG8_SB(b, h) + boff + n * 2048 + k * 1024); } while (0)
#define PG8_MMA(ai, bj, At, Bt) do { __builtin_amdgcn_s_setprio(1); _Pragma("unroll") for (int m = 0; m < 4; ++m) _Pragma("unroll") for (int n = 0; n < 2; ++n) _Pragma("unroll") for (int k = 0; k < 2; ++k) \
        acc[ai][bj][m][n] = __builtin_amdgcn_mfma_f32_16x16x32_bf16(Bt[n][k], At[m][k], acc[ai][bj][m][n], 0, 0, 0); __builtin_amdgcn_s_setprio(0); } while (0)
#define PG8_WAIT_V(n) asm volatile("s_waitcnt vmcnt(" #n ")" ::: "memory")
#define PG8_WAIT_L(n) asm volatile("s_waitcnt lgkmcnt(" #n ")" ::: "memory")
#define PG8_BAR __builtin_amdgcn_s_barrier()
#define PG8_SCHED __builtin_amdgcn_sched_barrier(0)
    Unit cur, nxt; int ui = 0;
    if (!S.next(0, cur)) return;
    f32x4 acc[2][2][4][2];
#pragma unroll
    for (int a = 0; a < 2; ++a)
#pragma unroll
        for (int b = 0; b < 2; ++b)
#pragma unroll
            for (int m = 0; m < 4; ++m)
#pragma unroll
                for (int n = 0; n < 2; ++n) acc[a][b][m][n] = (f32x4){0.f, 0.f, 0.f, 0.f};
    bf16x8 At[4][2], B0[2][2], B1[2][2];
    const char* cA = (const char*)g.A + (size_t)cur.pm * tstep; const char* cB = (const char*)g.Bt + (size_t)cur.pn * tstep;
    S.a_ready(cur);
    PG8_STAGE(PG8_SB(0, 0), cB, voffB); PG8_STAGE(PG8_SA(0, 0), cA, voffA); PG8_STAGE(PG8_SB(0, 1), cB + hstep, voffB); PG8_STAGE(PG8_SA(0, 1), cA + hstep, voffA);
    if (wr == 1) PG8_BAR;
    PG8_WAIT_V(4); PG8_BAR;
    PG8_STAGE(PG8_SB(1, 0), cB + kstep, voffB); PG8_STAGE(PG8_SA(1, 0), cA + kstep, voffA); PG8_STAGE(PG8_SB(1, 1), cB + hstep + kstep, voffB);
    PG8_WAIT_V(6); PG8_BAR;
    PG8_STAMP();
    for (;;) {
        const bool has_next = S.next(ui + 1, nxt);
        const char* nA = has_next ? (const char*)g.A + (size_t)nxt.pm * tstep : cA; const char* nB = has_next ? (const char*)g.Bt + (size_t)nxt.pn * tstep : cB;
        for (int t = 0; t < nt; t += 2) {
            const bool last = (t == nt - 2);
            const char* a1 = cA + (size_t)(t + 1) * kstep;
            const char* a2 = last ? nA : cA + (size_t)(t + 2) * kstep; const char* b2 = last ? nB : cB + (size_t)(t + 2) * kstep;
            const char* a3 = a2 + kstep; const char* b3 = b2 + kstep;
            if (last && has_next) S.a_ready(nxt);
            PG8_LDB(B0, 0, 0); PG8_SCHED; PG8_LDA(At, 0, 0); PG8_STAGE(PG8_SA(1, 1), a1 + hstep, voffA);
            PG8_WAIT_L(8); PG8_BAR; PG8_WAIT_L(0); PG8_MMA(0, 0, At, B0); PG8_BAR; PG8_SCHED;
            PG8_LDB(B1, 0, 1); PG8_STAGE(PG8_SB(0, 0), b2, voffB);
            PG8_BAR; PG8_WAIT_L(0); PG8_MMA(0, 1, At, B1); PG8_BAR;
            PG8_LDA(At, 0, 1); PG8_STAGE(PG8_SA(0, 0), a2, voffA);
            PG8_BAR; PG8_WAIT_L(0); PG8_MMA(1, 0, At, B0); PG8_BAR; PG8_SCHED;
            PG8_STAGE(PG8_SB(0, 1), b2 + hstep, voffB);
            PG8_WAIT_V(6); PG8_BAR; PG8_MMA(1, 1, At, B1); PG8_BAR;
            PG8_LDB(B0, 1, 0); PG8_SCHED; PG8_LDA(At, 1, 0); PG8_STAGE(PG8_SA(0, 1), a2 + hstep, voffA);
            PG8_WAIT_L(8); PG8_BAR; PG8_WAIT_L(0); PG8_MMA(0, 0, At, B0); PG8_BAR; PG8_SCHED;
            PG8_LDB(B1, 1, 1); PG8_STAGE(PG8_SB(1, 0), b3, voffB);
            PG8_BAR; PG8_WAIT_L(0); PG8_MMA(0, 1, At, B1); PG8_BAR;
            PG8_LDA(At, 1, 1); PG8_STAGE(PG8_SA(1, 0), a3, voffA);
            PG8_BAR; PG8_WAIT_L(0); PG8_MMA(1, 0, At, B0); PG8_BAR; PG8_SCHED;
            PG8_STAGE(PG8_SB(1, 1), b3 + hstep, voffB);
            PG8_WAIT_V(6); PG8_BAR; PG8_MMA(1, 1, At, B1); PG8_BAR;
        }
        PG8_STAMP();
        if constexpr (!Epi::AFTER_DRAIN) { E(acc, cur, wr, wc, fr, fq); S.done(cur); }
        PG8_STAMP();
        if (!has_next) break;
#pragma unroll
        for (int a = 0; a < 2; ++a)
#pragma unroll
            for (int b = 0; b < 2; ++b)
#pragma unroll
                for (int m = 0; m < 4; ++m)
#pragma unroll
                    for (int n = 0; n < 2; ++n) acc[a][b][m][n] = (f32x4){0.f, 0.f, 0.f, 0.f};
        cur = nxt; cA = nA; cB = nB; ++ui;
    }
    PG8_WAIT_V(0);
    if (wr == 0) PG8_BAR;
    PG8_BAR;
    if constexpr (Epi::AFTER_DRAIN) { E.fused(acc, cur, wr, wc, fr, fq, lds, wid, lane); S.done(cur); }
    PG8_STAMP();
    if (STAMP && wid == 0) { stamps[lane] = lane < nts ? (((unsigned long long)(unsigned)ts_hi << 32) | (unsigned)ts_lo) : 0ull;
        if (lane == 62) stamps[62] = rt_entry; if (lane == 63) stamps[63] = (unsigned long long)wall_clock64(); }
#undef PG8_STAMP
#undef PG8_SA
#undef PG8_SB
#undef PG8_STAGE
#undef PG8_LDA
#undef PG8_LDB
#undef PG8_MMA
#undef PG8_WAIT_V
#undef PG8_WAIT_L
#undef PG8_BAR
#undef PG8_SCHED
}
}

struct SegOrder {
  int seg0, seg1, slot, nb, mode;
  __device__ __forceinline__ bool next(int i, pg8::Unit& u) const {
    const int L = seg0 + slot + i * nb;
    if (L >= seg1) return false;
    if (mode == 0) {
      if (L < 1664) { const int g = L / 208, rem = L % 208; u.pn = rem >> 3; u.pm = 8 * g + (rem & 7); }
      else { const int rem = L - 1664; u.pn = rem >> 1; u.pm = 64 + (rem & 1); }
    } else if (mode == 3) {
      int j;
      if (L < 1280) { const int g = L / 160, rem = L % 160; j = rem >> 3; u.pm = 8 * g + (rem & 7); }
      else { const int rem = L - 1280; j = rem >> 1; u.pm = 64 + (rem & 1); }
      const int grp = (int)((0xCA98754310ull >> (4 * (j >> 1))) & 15ull);
      u.pn = 2 * grp + (j & 1);
    } else {
      const int per = (mode == 1) ? 96 : 32;
      const int g = L / per, rem = L % per;
      u.pn = rem >> 3; u.pm = 8 * g + (rem & 7);
    }
    return true;
  }
  __device__ __forceinline__ void a_ready(const pg8::Unit&) const {}
  __device__ __forceinline__ void done(const pg8::Unit&) const {}
};
__device__ __forceinline__ SegOrder make_order(int total, int mode) {
  SegOrder S;
  const bool xs = (gridDim.x & 7) == 0;
  const int nx = xs ? 8 : 1, xcd = xs ? (blockIdx.x & 7) : 0;
  S.nb = xs ? (gridDim.x >> 3) : gridDim.x;
  S.slot = xs ? (blockIdx.x >> 3) : blockIdx.x;
  S.seg0 = (total * xcd) / nx; S.seg1 = (total * (xcd + 1)) / nx; S.mode = mode;
  return S;
}

struct EpiS2 {
  static constexpr bool PERM = true, AFTER_DRAIN = false;
  const Params& p; const float* rope;
  __device__ __forceinline__ void operator()(const pg8::f32x4 (&acc)[2][2][4][2], const pg8::Unit& u, int wr, int wc, int fr, int fq) const {
    const int row0 = u.pm * 256;
    const bool latent = row0 < 16384;
    const int b = latent ? (row0 >> 13) : ((row0 - 16384) >> 8);
    const int keybase = latent ? (row0 & 8191) : 8192;
    const int grp = u.pn >> 1;
    const int fo0 = (u.pn & 1) * 256 + 32 * wc + 8 * fq;
    gu16* D = (gu16*)piece(p, grp);
    const gfloat* ropeg = (const gfloat*)rope;
    if (grp == P_VTA || grp == P_VTB || grp == P_VTC) {
      const int ps = perm16(fr);
#pragma unroll
      for (int ai = 0; ai < 2; ++ai)
#pragma unroll
        for (int m = 0; m < 4; ++m) {
          gu16* kp = D + (size_t)(b * 512 + fo0) * NKEY + keybase + 128 * ai + 64 * wr + 16 * m + ps;
          asm volatile("" : "+v"(kp));
#pragma unroll
          for (int bj = 0; bj < 2; ++bj)
#pragma unroll
            for (int n = 0; n < 2; ++n)
#pragma unroll
              for (int i = 0; i < 4; ++i) kp[(size_t)(128 * bj + 4 * n + i) * NKEY] = f2bf(acc[ai][bj][m][n][i]);
        }
    } else {
      const bool rot = latent && (grp == P_QA || grp == P_KA);
      const float qs = (grp == P_QA || grp == P_QC) ? 0.18033688011112042f : 1.f;
#pragma unroll
      for (int ai = 0; ai < 2; ++ai)
#pragma unroll
        for (int m = 0; m < 4; ++m) {
          const int row = row0 + 128 * ai + 64 * wr + 16 * m + fr;
          gu16* rp = D + (size_t)row * 512 + fo0;
          asm volatile("" : "+v"(rp));
          float cs[4] = {1.f, 1.f, 1.f, 1.f}, sn[4] = {0.f, 0.f, 0.f, 0.f};
          if (rot) {
            const int t = row & 8191;
            const int vv = (wc & 1) ? (t & 63) : (t >> 6);
            const v4f c01 = *(const gv4f*)(ropeg + (vv * 16 + 4 * fq) * 2);
            const v4f c23 = *(const gv4f*)(ropeg + (vv * 16 + 4 * fq) * 2 + 4);
            cs[0] = c01[0]; sn[0] = c01[1]; cs[1] = c01[2]; sn[1] = c01[3];
            cs[2] = c23[0]; sn[2] = c23[1]; cs[3] = c23[2]; sn[3] = c23[3];
          }
#pragma unroll
          for (int bj = 0; bj < 2; ++bj) {
            float o0[4], o1[4];
#pragma unroll
            for (int i = 0; i < 4; ++i) {
              const float x1 = acc[ai][bj][m][0][i], x2 = acc[ai][bj][m][1][i];
              o0[i] = (x1 * cs[i] - x2 * sn[i]) * qs;
              o1[i] = (x1 * sn[i] + x2 * cs[i]) * qs;
            }
            v4u a;
            a[0] = pk2(o0[0], o0[1]); a[1] = pk2(o0[2], o0[3]);
            a[2] = pk2(o1[0], o1[1]); a[3] = pk2(o1[2], o1[3]);
            *(GAS v4u*)(rp + 128 * bj) = a;
          }
        }
    }
  }
};

struct EpiVT {
  static constexpr bool PERM = false, AFTER_DRAIN = false;
  const Params& p;
  __device__ __forceinline__ void operator()(const pg8::f32x4 (&acc)[2][2][4][2], const pg8::Unit& u, int wr, int wc, int fr, int fq) const {
    const int grp = u.pm >> 1;
    const bool latent = u.pn < 64;
    const int b = latent ? (u.pn >> 5) : (u.pn - 64);
    const int keybase = latent ? ((u.pn & 31) * 256) : 8192;
    gu16* D = (gu16*)piece(p, grp);
    const int cq = ((fq & 1) << 1) | (fq >> 1);
#pragma unroll
    for (int ai = 0; ai < 2; ++ai)
#pragma unroll
      for (int m = 0; m < 4; ++m) {
        const int f = (u.pm & 1) * 256 + 128 * ai + 64 * wr + 16 * m + fr;
        gu16* rp = D + (size_t)(b * 512 + f) * NKEY + keybase + 32 * wc + 4 * cq;
        asm volatile("" : "+v"(rp));
#pragma unroll
        for (int bj = 0; bj < 2; ++bj)
#pragma unroll
          for (int n = 0; n < 2; ++n) {
            const pg8::f32x4 v = acc[ai][bj][m][n];
            v2u o;
            o[0] = pk2(v[0], v[1]); o[1] = pk2(v[2], v[3]);
            *(gv2u*)(rp + 128 * bj + 16 * n) = o;
          }
      }
  }
};

struct VtOrder {
  int seg0, seg1, slot, nb;
  __device__ __forceinline__ bool next(int i, pg8::Unit& u) const {
    const int L = seg0 + slot + i * nb;
    if (L >= seg1) return false;
    int j6, rt;
    if (L < 384) { const int g = L / 48, rem = L % 48; j6 = rem >> 3; rt = 8 * g + (rem & 7); }
    else { const int rem = L - 384; j6 = rem >> 1; rt = 64 + (rem & 1); }
    const int grp = (j6 >> 1) == 0 ? P_VTA : ((j6 >> 1) == 1 ? P_VTB : P_VTC);
    u.pm = 2 * grp + (j6 & 1); u.pn = rt;
    return true;
  }
  __device__ __forceinline__ void a_ready(const pg8::Unit&) const {}
  __device__ __forceinline__ void done(const pg8::Unit&) const {}
};

struct EpiS6a {
  static constexpr bool PERM = true, AFTER_DRAIN = false;
  u16* G;
  __device__ __forceinline__ void operator()(const pg8::f32x4 (&acc)[2][2][4][2], const pg8::Unit& u, int wr, int wc, int fr, int fq) const {
    gu16* Gn = (gu16*)G + (size_t)(u.pn >> 2) * R_TOT * 1024;
    const int d0 = (u.pn & 3) * 256 + 32 * wc + 8 * fq;
#pragma unroll
    for (int ai = 0; ai < 2; ++ai)
#pragma unroll
      for (int m = 0; m < 4; ++m) {
        gu16* rp = Gn + (size_t)(u.pm * 256 + 128 * ai + 64 * wr + 16 * m + fr) * 1024 + d0;
        asm volatile("" : "+v"(rp));
#pragma unroll
        for (int bj = 0; bj < 2; ++bj) {
          const pg8::f32x4 v0 = acc[ai][bj][m][0], v1 = acc[ai][bj][m][1];
          v4u o;
          o[0] = pk2(sigmoid_f(v0[0]), sigmoid_f(v0[1]));
          o[1] = pk2(sigmoid_f(v0[2]), sigmoid_f(v0[3]));
          o[2] = pk2(sigmoid_f(v1[0]), sigmoid_f(v1[1]));
          o[3] = pk2(sigmoid_f(v1[2]), sigmoid_f(v1[3]));
          *(GAS v4u*)(rp + 128 * bj) = o;
        }
      }
  }
};

struct EpiS7 {
  static constexpr bool PERM = false, AFTER_DRAIN = false;
  const float* xsrc; float* xdst; const float* gate;
  const float* mod;
  __device__ __forceinline__ void operator()(const pg8::f32x4 (&acc)[2][2][4][2], const pg8::Unit& u, int wr, int wc, int fr, int fq) const {
    const int row0 = u.pm * 256;
    const gfloat* gp = (const gfloat*)mod + which_of(row0) * 3072 + 2048 + u.pn * 256 + 32 * wc + 4 * fq;
    v4f gv[2][2];
#pragma unroll
    for (int bj = 0; bj < 2; ++bj)
#pragma unroll
      for (int n = 0; n < 2; ++n) gv[bj][n] = *(const gv4f*)(gp + 128 * bj + 16 * n);
#pragma unroll
    for (int ai = 0; ai < 2; ++ai)
#pragma unroll
      for (int m = 0; m < 4; ++m) {
        const size_t off = (size_t)(row0 + 128 * ai + 64 * wr + 16 * m + fr) * 1024 + u.pn * 256 + 32 * wc + 4 * fq;
        const gfloat* sp = (const gfloat*)xsrc + off;
        gfloat* dp = (gfloat*)xdst + off;
        asm volatile("" : "+v"(sp), "+v"(dp));
#pragma unroll
        for (int bj = 0; bj < 2; ++bj)
#pragma unroll
          for (int n = 0; n < 2; ++n) {
            const v4f xv = *(const gv4f*)(sp + 128 * bj + 16 * n);
            const pg8::f32x4 a = acc[ai][bj][m][n];
            v4f o;
#pragma unroll
            for (int i = 0; i < 4; ++i) o[i] = xv[i] + gv[bj][n][i] * a[i];
            *(gv4f*)(dp + 128 * bj + 16 * n) = o;
          }
      }
  }
};

__device__ __forceinline__ void s2_store64(const Params& p, int grp, const f32x16& a0, const f32x16& a1, int rowbase, int fb64,
                                           bool latent, int b, int keyb, int r, int hh, const float* __restrict__ rope) {
  if (grp == P_VTA || grp == P_VTB || grp == P_VTC) {
    gu16* VT = (gu16*)piece(p, grp);
#pragma unroll
    for (int j = 0; j < 2; ++j) {
      const int f = fb64 + 32 * j + r;
#pragma unroll
      for (int q = 0; q < 4; ++q) {
        const int key = keyb + 16 * (q >> 1) + 4 * (hh * 2 + (q & 1));
        v2u pk;
        if (j == 0) { pk[0] = pk2(a0[4 * q], a0[4 * q + 1]); pk[1] = pk2(a0[4 * q + 2], a0[4 * q + 3]); }
        else { pk[0] = pk2(a1[4 * q], a1[4 * q + 1]); pk[1] = pk2(a1[4 * q + 2], a1[4 * q + 3]); }
        *(gv2u*)(VT + ((size_t)(b * 512 + f)) * NKEY + key) = pk;
      }
    }
  } else {
    gu16* D = (gu16*)piece(p, grp);
    const bool rot = latent && (grp == P_QA || grp == P_KA);
    const float qs = (grp == P_QA || grp == P_QC) ? 0.18033688011112042f : 1.f;
#pragma unroll
    for (int e = 0; e < 16; ++e) {
      const int row = rowbase + (e & 3) + 8 * (e >> 2) + 4 * hh;
      float v0 = a0[e], v1 = a1[e];
      if (rot) {
        const int t = row & 8191;
        const int vv = (r < 16) ? (t >> 6) : (t & 63);
        const float cs = rope[(vv * 16 + (r & 15)) * 2], sn = rope[(vv * 16 + (r & 15)) * 2 + 1];
        const float o0 = v0 * cs - v1 * sn, o1 = v0 * sn + v1 * cs;
        v0 = o0; v1 = o1;
      }
      D[(size_t)row * 512 + fb64 + r] = f2bf(v0 * qs);
      D[(size_t)row * 512 + fb64 + 32 + r] = f2bf(v1 * qs);
    }
  }
}

__device__ __attribute__((always_inline)) void phase_s2(const Params& p, int l, unsigned char* smem) {
  const int tid = opaque_tid(), lane = tid & 63, wave = tid >> 6;
  const int wm = wave >> 1, wn = wave & 1, r = lane & 31, hh = lane >> 5;
  const u16* H = (const u16*)(p.ws + WS_H);
  const u16* WTI = (const u16*)(p.ws + WS_WT_IN);
  const float* rope = (const float*)(p.ws + WS_ROPE);
  float* G = (float*)(p.ws + WS_G);
  {
    const pg8::Gemm g{H, WTI, R_TOT, 6656, 1024};
    const SegOrder S = make_order(1320, 3);
    const EpiS2 E{p, rope};
    pg8::gemm_phase<EpiS2, SegOrder, false>((PG8_LAS unsigned char*)smem, g, S, E, nullptr);
  }
  {
    const pg8::Gemm g{WTI, H, 6656, R_TOT, 1024};
    const bool xs = (gridDim.x & 7) == 0;
    VtOrder S;
    const int nx = xs ? 8 : 1, xcd = xs ? (blockIdx.x & 7) : 0;
    S.nb = xs ? (gridDim.x >> 3) : gridDim.x;
    S.slot = xs ? (S.nb - 1 - (int)(blockIdx.x >> 3)) : blockIdx.x;
    S.seg0 = (396 * xcd) / nx; S.seg1 = (396 * (xcd + 1)) / nx;
    const EpiVT E{p};
    pg8::gemm_phase<EpiVT, VtOrder, false>((PG8_LAS unsigned char*)smem, g, S, E, nullptr);
  }
#pragma unroll 1
  for (int rt = blockIdx.x; rt < 66; rt += gridDim.x) {
    const int row0 = rt * 256;
    f32x16 acc[2][2];
    acc[0][0] = zero16(); acc[0][1] = zero16(); acc[1][0] = zero16(); acc[1][1] = zero16();
    gemm_core<0, 2>(acc, H + (size_t)row0 * 1024, 1024, nullptr, nullptr, nullptr, nullptr, WTI + (size_t)9728 * 1024, 1024, smem);
    if (wn == 0) {
#pragma unroll
      for (int i = 0; i < 2; ++i)
#pragma unroll
        for (int e = 0; e < 16; ++e) {
          const int row = row0 + 64 * wm + 32 * i + (e & 3) + 8 * (e >> 2) + 4 * hh;
          if (r < 16) G[(size_t)row * 16 + r] = acc[i][0][e];
        }
    }
  }
}

__device__ __attribute__((always_inline)) void attn_item(const Params& p, int l, int b, int h, int qgrow0, int kt0, int kt1, unsigned char* smem) {
  u16* Ks = (u16*)smem;
  u16* Vs = (u16*)(smem + 34816);
  const int tid = opaque_tid(), lane = tid & 63, wave = tid >> 6;
  const int c = wave & 1, qg = wave >> 1, r = lane & 31, hh = lane >> 5;
  u16* QA = piece(p, P_QA);
  const u16* KA = piece(p, P_KA);
  const u16* VT = piece(p, P_VTA);
  const u16* ZA = piece(p, P_ZA);
  const float lam_init = 0.8f - 0.6f * expf(-0.3f * (float)l);
  float lam;
  {
    const float* lq = p.lam_q + l * 128;
    const float* lk = p.lam_k + l * 128;
    const float s0 = wave_sum(lq[lane] * lk[lane]);
    const float s1 = wave_sum(lq[64 + lane] * lk[64 + lane]);
    lam = expf(s0) - expf(s1) + lam_init;
  }
  const int qrow = qgrow0 + qg * 32 + r;
  bf16x8 qf[4];
#pragma unroll
  for (int ks = 0; ks < 4; ++ks) qf[ks] = *(const bf16x8*)(QA + (size_t)qrow * 512 + h * 128 + c * 64 + ks * 16 + hh * 8);
  f32x16 O[4];
#pragma unroll
  for (int i = 0; i < 4; ++i) O[i] = zero16();
  float m = -1e30f, lsum = 0.f;
  const int krow_l = tid >> 4, kc16 = tid & 15;
  const int vrow_l = tid >> 3, vc8 = tid & 7;
  v4u rk[2], rv[2];
#define ATT_LOADK(kt)                                                                             \
  {                                                                                               \
    const int key0 = (kt) * 64;                                                                   \
    const int gbase = (key0 < 8192) ? (b * 8192 + key0) : (16384 + b * 256 + key0 - 8192);        \
    _Pragma("unroll") for (int i = 0; i < 2; ++i)                                                 \
      rk[i] = *(const v4u*)(KA + (size_t)(gbase + krow_l + 32 * i) * 512 + h * 128 + kc16 * 8);   \
  }
#define ATT_LOADV(kt)                                                                             \
  {                                                                                               \
    const int key0 = (kt) * 64;                                                                   \
    _Pragma("unroll") for (int i = 0; i < 2; ++i)                                                 \
      rv[i] = *(const v4u*)(VT + ((size_t)(b * 512 + h * 128 + vrow_l + 64 * i)) * NKEY + key0 + vc8 * 8); \
  }
#define ATT_STOREK(buf)                                                                           \
  {                                                                                               \
    _Pragma("unroll") for (int i = 0; i < 2; ++i)                                                 \
      *(v4u*)(Ks + (buf) * 64 * 136 + (krow_l + 32 * i) * 136 + kc16 * 8) = rk[i];                \
  }
#define ATT_STOREV(buf)                                                                           \
  {                                                                                               \
    _Pragma("unroll") for (int i = 0; i < 2; ++i)                                                 \
      *(v4u*)(Vs + (buf) * 128 * 72 + (vrow_l + 64 * i) * 72 + vc8 * 8) = rv[i];                  \
  }
#define ATT_QK(Sx, buf)                                                                           \
  {                                                                                               \
    _Pragma("unroll") for (int kk = 0; kk < 2; ++kk) {                                            \
      Sx[kk] = zero16();                                                                          \
      _Pragma("unroll") for (int ks = 0; ks < 4; ++ks) {                                          \
        const bf16x8 kf = *(const bf16x8*)(Ks + (buf) * 64 * 136 + (32 * kk + r) * 136 + c * 64 + ks * 16 + hh * 8); \
        Sx[kk] = mfma32(kf, qf[ks], Sx[kk]);                                                      \
      }                                                                                           \
    }                                                                                             \
  }
  ATT_LOADK(kt0);
  ATT_LOADV(kt0);
  ATT_STOREK(0);
  ATT_STOREV(0);
  if (kt0 + 1 < kt1) { ATT_LOADK(kt0 + 1); ATT_STOREK(1); }
  __syncthreads();
  f32x16 S[2], Sn[2];
  ATT_QK(S, 0);
  if (kt0 + 2 < kt1) ATT_LOADK(kt0 + 2);
  if (kt0 + 1 < kt1) ATT_LOADV(kt0 + 1);
  for (int kt = kt0; kt < kt1; ++kt) {
    const int cur = (kt - kt0) & 1;
    if (kt + 1 < kt1) ATT_QK(Sn, cur ^ 1);
    float mx = -1e30f;
#pragma unroll
    for (int kk = 0; kk < 2; ++kk)
#pragma unroll
      for (int e = 0; e < 16; ++e) mx = fmaxf(mx, S[kk][e]);
    mx = fmaxf(mx, __shfl_xor(mx, 32, 64));
    const float mnew = fmaxf(m, mx);
    if (__builtin_amdgcn_ballot_w64(mnew > m) != 0ull) {
      const float alpha = ex2(m - mnew);
      lsum *= alpha;
#pragma unroll
      for (int i = 0; i < 4; ++i)
#pragma unroll
        for (int e = 0; e < 16; ++e) O[i][e] *= alpha;
    }
    m = mnew;
    bf16x8 pf[4];
#pragma unroll
    for (int kk = 0; kk < 2; ++kk)
#pragma unroll
      for (int s2 = 0; s2 < 2; ++s2) {
        v4u pkd;
#pragma unroll
        for (int jj = 0; jj < 4; ++jj) {
          const float p0 = ex2(S[kk][8 * s2 + 2 * jj] - mnew);
          const float p1 = ex2(S[kk][8 * s2 + 2 * jj + 1] - mnew);
          lsum += p0 + p1;
          pkd[jj] = pk2(p0, p1);
        }
        pf[2 * kk + s2] = (bf16x8)pkd;
      }
#pragma unroll
    for (int dvt = 0; dvt < 4; ++dvt)
#pragma unroll
      for (int s = 0; s < 4; ++s) {
        const bf16x8 vf = *(const bf16x8*)(Vs + cur * 128 * 72 + (32 * dvt + r) * 72 + 16 * s + 8 * hh);
        O[dvt] = mfma32(vf, pf[s], O[dvt]);
      }
    if (kt + 2 < kt1) ATT_STOREK(cur);
    if (kt + 1 < kt1) ATT_STOREV(cur ^ 1);
    if (kt + 3 < kt1) ATT_LOADK(kt + 3);
    if (kt + 2 < kt1) ATT_LOADV(kt + 2);
    __syncthreads();
    S[0] = Sn[0];
    S[1] = Sn[1];
  }
#undef ATT_LOADK
#undef ATT_LOADV
#undef ATT_STOREK
#undef ATT_STOREV
#undef ATT_QK
  const float ltot = lsum + __shfl_xor(lsum, 32, 64);
  const float inv = 1.f / ltot;
  float* X = (float*)smem;
  if (c == 1) {
#pragma unroll
    for (int dvt = 0; dvt < 4; ++dvt)
#pragma unroll
      for (int e = 0; e < 16; ++e) X[(qg * 128 + 32 * dvt + (e & 3) + 8 * (e >> 2) + 4 * hh) * 32 + r] = O[dvt][e] * inv;
  }
  __syncthreads();
  if (c == 0) {
    float ss = 0.f;
#pragma unroll
    for (int dvt = 0; dvt < 4; ++dvt)
#pragma unroll
      for (int e = 0; e < 16; ++e) {
        const float o = O[dvt][e] * inv - lam * X[(qg * 128 + 32 * dvt + (e & 3) + 8 * (e >> 2) + 4 * hh) * 32 + r];
        O[dvt][e] = o;
        ss += o * o;
      }
    ss += __shfl_xor(ss, 32, 64);
    const float rinv = rsqrtf(ss * (1.f / 128.f) + 1e-6f) * (1.f - lam_init);
    const float* dg = p.da_g + l * 128;
#pragma unroll
    for (int dvt = 0; dvt < 4; ++dvt)
#pragma unroll
      for (int g = 0; g < 4; ++g) {
        const int dv0 = 32 * dvt + 8 * g + 4 * hh;
        const size_t off = (size_t)qrow * 512 + h * 128 + dv0;
        const v2u z = *(const v2u*)(ZA + off);
        const float y0 = O[dvt][4 * g] * rinv * dg[dv0] * silu_f(bflo(z[0]));
        const float y1 = O[dvt][4 * g + 1] * rinv * dg[dv0 + 1] * silu_f(bfhi(z[0]));
        const float y2 = O[dvt][4 * g + 2] * rinv * dg[dv0 + 2] * silu_f(bflo(z[1]));
        const float y3 = O[dvt][4 * g + 3] * rinv * dg[dv0 + 3] * silu_f(bfhi(z[1]));
        v2u o;
        o[0] = pk2(y0, y1);
        o[1] = pk2(y2, y3);
        *(v2u*)(QA + off) = o;
      }
  }
  __syncthreads();
}

__device__ __attribute__((always_inline)) void natten_item(const Params& p, int l, int b, int rr, int qgrow, int i0, unsigned char* smem) {
  float* rp = (float*)smem;
  const int tid = opaque_tid(), lane = tid & 63, head = tid >> 6;
  const int r = lane & 31, hh = lane >> 5;
  for (int i = tid; i < 3720; i += NTHR) rp[i] = p.rpb[(size_t)l * 3720 + i];
  __syncthreads();
  u16* QC = piece(p, P_QC);
  const u16* KC = piece(p, P_KC);
  const u16* VT = piece(p, P_VTC);
  const u16* ZC = piece(p, P_ZC);
  const int rs = min(max(rr - 4, 0), 120);
  bf16x8 qf[2][4];
#pragma unroll
  for (int qt = 0; qt < 2; ++qt)
#pragma unroll
    for (int ks = 0; ks < 4; ++ks)
      qf[qt][ks] = *(const bf16x8*)(QC + (size_t)(qgrow + 32 * qt + r) * 512 + head * 64 + ks * 16 + hh * 8);
  f32x16 O[2][2];
  O[0][0] = zero16(); O[0][1] = zero16(); O[1][0] = zero16(); O[1][1] = zero16();
  float m[2] = {-1e30f, -1e30f}, lsum[2] = {0.f, 0.f};
  const float L2E = 1.4426950408889634f;
  bf16x8 kfn[2][4];
  {
    const int kgp = (i0 < 8) ? (b * 8192 + (rs + i0) * 64) : (16384 + b * 256 + (i0 - 8) * 64);
#pragma unroll
    for (int kk = 0; kk < 2; ++kk)
#pragma unroll
      for (int ks = 0; ks < 4; ++ks)
        kfn[kk][ks] = *(const bf16x8*)(KC + (size_t)(kgp + 32 * kk + r) * 512 + head * 64 + ks * 16 + hh * 8);
  }
#pragma unroll 1
  for (int i = i0; i < 12; ++i) {
    const bool local = i < 8;
    const int krow = rs + i;
    const int key0 = local ? krow * 64 : 8192 + (i - 8) * 64;
    bf16x8 kfc[2][4];
#pragma unroll
    for (int kk = 0; kk < 2; ++kk)
#pragma unroll
      for (int ks = 0; ks < 4; ++ks) kfc[kk][ks] = kfn[kk][ks];
    if (i + 1 < 12) {
      const int kg1 = (i + 1 < 8) ? (b * 8192 + (krow + 1) * 64) : (16384 + b * 256 + (i - 7) * 64);
#pragma unroll
      for (int kk = 0; kk < 2; ++kk)
#pragma unroll
        for (int ks = 0; ks < 4; ++ks)
          kfn[kk][ks] = *(const bf16x8*)(KC + (size_t)(kg1 + 32 * kk + r) * 512 + head * 64 + ks * 16 + hh * 8);
    }
    f32x16 S[2][2];
    S[0][0] = zero16(); S[0][1] = zero16(); S[1][0] = zero16(); S[1][1] = zero16();
#pragma unroll
    for (int kk = 0; kk < 2; ++kk)
#pragma unroll
      for (int ks = 0; ks < 4; ++ks) {
        S[kk][0] = mfma32(kfc[kk][ks], qf[0][ks], S[kk][0]);
        S[kk][1] = mfma32(kfc[kk][ks], qf[1][ks], S[kk][1]);
      }
    bf16x8 pf[2][4];
#pragma unroll
    for (int qt = 0; qt < 2; ++qt) {
      const int qcol = 32 * qt + r;
      const int cs = min(max(qcol - 8, 0), 48);
      const float* rprow = rp + (head * 15 + (local ? (krow - rr + 7) : 0)) * 31 + 15 - qcol;
      float mx = -1e30f;
#pragma unroll
      for (int kk = 0; kk < 2; ++kk)
#pragma unroll
        for (int e = 0; e < 16; ++e) {
          const int kcol = 32 * kk + (e & 3) + 8 * (e >> 2) + 4 * hh;
          float s = S[kk][qt][e];
          if (local) {
            const bool valid = (kcol >= cs) && (kcol < cs + 16);
            const int ci = min(max(kcol, cs), cs + 15);
            s = valid ? (s + rprow[ci] * L2E) : -1e30f;
          }
          S[kk][qt][e] = s;
          mx = fmaxf(mx, s);
        }
      mx = fmaxf(mx, __shfl_xor(mx, 32, 64));
      const float mnew = fmaxf(m[qt], mx);
      if (__builtin_amdgcn_ballot_w64(mnew > m[qt]) != 0ull) {
        const float alpha = ex2(m[qt] - mnew);
        lsum[qt] *= alpha;
#pragma unroll
        for (int dvt = 0; dvt < 2; ++dvt)
#pragma unroll
          for (int e = 0; e < 16; ++e) O[dvt][qt][e] *= alpha;
      }
      m[qt] = mnew;
#pragma unroll
      for (int kk = 0; kk < 2; ++kk)
#pragma unroll
        for (int s2 = 0; s2 < 2; ++s2) {
          v4u pkd;
#pragma unroll
          for (int jj = 0; jj < 4; ++jj) {
            const float p0 = ex2(S[kk][qt][8 * s2 + 2 * jj] - mnew);
            const float p1 = ex2(S[kk][qt][8 * s2 + 2 * jj + 1] - mnew);
            lsum[qt] += p0 + p1;
            pkd[jj] = pk2(p0, p1);
          }
          pf[qt][2 * kk + s2] = (bf16x8)pkd;
        }
    }
#pragma unroll
    for (int dvt = 0; dvt < 2; ++dvt)
#pragma unroll
      for (int s = 0; s < 4; ++s) {
        const bf16x8 vf = *(const bf16x8*)(VT + ((size_t)(b * 512 + head * 64 + 32 * dvt + r)) * NKEY + key0 + 16 * s + 8 * hh);
        O[dvt][0] = mfma32(vf, pf[0][s], O[dvt][0]);
        O[dvt][1] = mfma32(vf, pf[1][s], O[dvt][1]);
      }
  }
#pragma unroll
  for (int qt = 0; qt < 2; ++qt) {
    const float inv = 1.f / (lsum[qt] + __shfl_xor(lsum[qt], 32, 64));
    const int qrow = qgrow + 32 * qt + r;
#pragma unroll
    for (int dvt = 0; dvt < 2; ++dvt)
#pragma unroll
      for (int g = 0; g < 4; ++g) {
        const int dv0 = 32 * dvt + 8 * g + 4 * hh;
        const size_t off = (size_t)qrow * 512 + head * 64 + dv0;
        const v2u z = *(const v2u*)(ZC + off);
        v2u o;
        o[0] = pk2(O[dvt][qt][4 * g] * inv * silu_f(bflo(z[0])), O[dvt][qt][4 * g + 1] * inv * silu_f(bfhi(z[0])));
        o[1] = pk2(O[dvt][qt][4 * g + 2] * inv * silu_f(bflo(z[1])), O[dvt][qt][4 * g + 3] * inv * silu_f(bfhi(z[1])));
        *(v2u*)(QC + off) = o;
      }
  }
  __syncthreads();
}

__device__ __forceinline__ float logsigmoid_f(float x) { return fminf(x, 0.f) - log1pf(__expf(-fabsf(x))); }
__device__ __forceinline__ int chunk_grow0(int b, int P) { return P < 2 ? 16384 + b * 256 + 128 * P : b * 8192 + 128 * (P - 2); }
__device__ __forceinline__ int chunk_key0(int P) { return P < 2 ? 8192 + 128 * P : 128 * (P - 2); }

__device__ __forceinline__ void mlstm_gates(const Params& p, int l, int head, int grow0, float* lf, float* li) {
  const int tid = opaque_tid();
  if (tid < 256) {
    const int d = tid >> 7, s = tid & 127;
    const float* G = (const float*)(p.ws + WS_G) + (size_t)(grow0 + s) * 16;
    const float gi = G[d * 8 + head] + p.gate_b[l * 16 + d * 8 + head];
    const float gf = G[d * 8 + 4 + head] + p.gate_b[l * 16 + d * 8 + 4 + head];
    li[d * 128 + s] = gi;
    lf[d * 128 + s] = logsigmoid_f(gf);
  }
}

__device__ __forceinline__ void conv8(const Params& p, int l, const u16* src, int grow, int fcol, int ch0, bool hasprev,
                                      bool hasnext, float scale, float (&o)[8]) {
  const v4u zero = {0u, 0u, 0u, 0u};
  const v4u xm = hasprev ? *(const v4u*)(src + (size_t)(grow - 1) * 512 + fcol) : zero;
  const v4u x0 = *(const v4u*)(src + (size_t)grow * 512 + fcol);
  const v4u xp = hasnext ? *(const v4u*)(src + (size_t)(grow + 1) * 512 + fcol) : zero;
  const float* cw = p.conv_w + (size_t)l * 3 * 1024 + ch0;
  const float* cb = p.conv_b + (size_t)l * 1024 + ch0;
#pragma unroll
  for (int e = 0; e < 8; ++e) {
    const float a = (e & 1) ? bfhi(xm[e >> 1]) : bflo(xm[e >> 1]);
    const float bq = (e & 1) ? bfhi(x0[e >> 1]) : bflo(x0[e >> 1]);
    const float cq = (e & 1) ? bfhi(xp[e >> 1]) : bflo(xp[e >> 1]);
    const float y = a * cw[e] + bq * cw[1024 + e] + cq * cw[2048 + e] + cb[e];
    o[e] = silu_f(y) * scale;
  }
}

__device__ __attribute__((always_inline)) void mlstm_b1_item(const Params& p, int l, int b, int head, int P, unsigned char* smem) {
  u16* kwT = (u16*)smem;
  float* lf = (float*)(smem + 69632);
  float* li = lf + 256;
  float* wS = li + 256;
  const int tid = opaque_tid(), lane = tid & 63, wave = tid >> 6;
  const int r = lane & 31, hh = lane >> 5;
  const int grow0 = chunk_grow0(b, P), key0 = chunk_key0(P);
  float* BL = (float*)(p.ws + WS_BL);
  float* DN = (float*)(p.ws + WS_DN);
  u16* CST = (u16*)(p.ws + WS_H);
  bf16x8 vf[8];
  {
    const int dvt0 = wave & 3;
    const u16* VT0 = piece(p, P_VTB);
#pragma unroll
    for (int s8 = 0; s8 < 8; ++s8)
      vf[s8] = *(const bf16x8*)(VT0 + ((size_t)(b * 512 + head * 128 + 32 * dvt0 + r)) * NKEY + key0 + 16 * s8 + 8 * hh);
  }
  mlstm_gates(p, l, head, grow0, lf, li);
  __syncthreads();
  if (tid < 256) {
    const int d = tid >> 7, s = tid & 127;
    float tot = 0.f, bs = 0.f;
    for (int j = 0; j < 128; ++j) {
      const float v = lf[d * 128 + j];
      tot += v;
      if (d == 0 ? (j <= s) : (j >= s)) bs += v;
    }
    wS[d * 128 + s] = __expf(tot - bs + li[d * 128 + s]);
    if (s == 0) BL[((b * 4 + head) * 2 + d) * 66 + P] = tot;
  }
  __syncthreads();
  const u16* KB = piece(p, P_KB);
#pragma unroll 1
  for (int i = 0; i < 4; ++i) {
    const int u = tid + NTHR * i;
    const int s = u >> 4, dg = u & 15;
    const bool hasprev = !((P == 0 || P == 2) && s == 0);
    const bool hasnext = !((P == 1 || P == 65) && s == 127);
    float kc[8];
    conv8(p, l, KB, grow0 + s, head * 128 + dg * 8, 512 + head * 128 + dg * 8, hasprev, hasnext, 0.08838834764831845f, kc);
    const int ps = perm16(s);
    const float w0 = wS[s], w1 = wS[128 + s];
#pragma unroll
    for (int e = 0; e < 8; ++e) {
      kwT[(dg * 8 + e) * 136 + ps] = f2bf(kc[e] * w0);
      kwT[(128 + dg * 8 + e) * 136 + ps] = f2bf(kc[e] * w1);
    }
  }
  __syncthreads();
  {
    const int d = wave >> 2, dvt = wave & 3;
    const int chain = (b * 4 + head) * 2 + d;
    u16* dst = CST + ((size_t)(chain * 66 + P)) * 16384;
#pragma unroll
    for (int dkt = 0; dkt < 4; ++dkt) {
      f32x16 acc = zero16();
#pragma unroll
      for (int s8 = 0; s8 < 8; ++s8) {
        const bf16x8 kf = *(const bf16x8*)(kwT + (d * 128 + 32 * dkt + r) * 136 + 16 * s8 + 8 * hh);
        acc = mfma32(vf[s8], kf, acc);
      }
#pragma unroll
      for (int e = 0; e < 16; ++e) {
        const int dv = 32 * dvt + (e & 3) + 8 * (e >> 2) + 4 * hh;
        dst[dv * 128 + 32 * dkt + r] = f2bf(acc[e]);
      }
    }
  }
  if (tid < 256) {
    const int d = tid >> 7, dk = tid & 127;
    float s = 0.f;
    for (int j = 0; j < 128; ++j) s += bf2f(kwT[(d * 128 + dk) * 136 + j]);
    DN[(((b * 4 + head) * 2 + d) * 66 + P) * 128 + dk] = s;
  }
  __syncthreads();
}

__device__ __attribute__((always_inline)) void phase_b2(const Params& p) {
  const int gid = blockIdx.x * NTHR + threadIdx.x;
  const float* BL = (const float*)(p.ws + WS_BL);
  if (gid < 131072) {
    const int chain = gid >> 13, e2 = gid & 8191;
    const int d = chain & 1;
    unsigned* base = (unsigned*)(p.ws + WS_H) + (size_t)chain * 66 * 8192 + e2;
    float c0 = 0.f, c1 = 0.f;
    for (int i0 = 0; i0 < 66; i0 += 11) {
      unsigned v[11];
      float a[11];
#pragma unroll
      for (int j = 0; j < 11; ++j) {
        const int i = i0 + j;
        const int P = d == 0 ? i : (i < 2 ? 1 - i : 67 - i);
        v[j] = base[(size_t)P * 8192];
        a[j] = __expf(BL[chain * 66 + P]);
      }
#pragma unroll
      for (int j = 0; j < 11; ++j) {
        const int i = i0 + j;
        const int P = d == 0 ? i : (i < 2 ? 1 - i : 67 - i);
        base[(size_t)P * 8192] = pk2(c0, c1);
        c0 = a[j] * c0 + bflo(v[j]);
        c1 = a[j] * c1 + bfhi(v[j]);
      }
    }
  }
  if (gid < 2048) {
    const int chain = gid >> 7, dk = gid & 127;
    const int d = chain & 1;
    const float* DN = (const float*)(p.ws + WS_DN);
    float* NP = (float*)(p.ws + WS_NPREV);
    float run = 0.f;
    for (int i = 0; i < 66; ++i) {
      const int P = d == 0 ? i : (i < 2 ? 1 - i : 67 - i);
      NP[(chain * 66 + P) * 128 + dk] = run;
      run = __expf(BL[chain * 66 + P]) * run + DN[(chain * 66 + P) * 128 + dk];
    }
  }
}

__device__ __attribute__((always_inline)) void mlstm_b3_item(const Params& p, int l, int b, int head, int P, unsigned char* smem) {
  u16* qS = (u16*)smem;
  u16* kS = (u16*)(smem + 34816);
  u16* pS = (u16*)(smem + 69632);
  float* fb = (float*)(smem + 104448);
  float* lf = fb;
  float* li = fb + 256;
  float* bc = fb + 512;
  float* colsum = fb + 768;
  float* nS = fb + 1280;
  float* nq = fb + 1536;
  float* cfs = fb + 1792;
  float* hsq = fb + 2048;
  const int tid = opaque_tid(), lane = tid & 63, wave = tid >> 6;
  const int r = lane & 31, hh = lane >> 5;
  const int grow0 = chunk_grow0(b, P), key0 = chunk_key0(P);
  const int chainF = (b * 4 + head) * 2, chainB = chainF + 1;
  mlstm_gates(p, l, head, grow0, lf, li);
  __syncthreads();
  if (tid < 256) {
    const int d = tid >> 7, s = tid & 127;
    float bs = 0.f;
    for (int j = 0; j < 128; ++j) {
      const float v = lf[d * 128 + j];
      if (d == 0 ? (j <= s) : (j >= s)) bs += v;
    }
    bc[d * 128 + s] = bs;
    nS[d * 128 + s] = ((const float*)(p.ws + WS_NPREV))[((chainF + d) * 66 + P) * 128 + s];
  }
  {
    const u16* QB = piece(p, P_QB);
    const u16* KB = piece(p, P_KB);
#pragma unroll 1
    for (int i = 0; i < 4; ++i) {
      const int u = tid + NTHR * i;
      const int s = u >> 4, dg = u & 15;
      const bool hasprev = !((P == 0 || P == 2) && s == 0);
      const bool hasnext = !((P == 1 || P == 65) && s == 127);
      float o[8];
      conv8(p, l, QB, grow0 + s, head * 128 + dg * 8, head * 128 + dg * 8, hasprev, hasnext, 1.f, o);
      v4u pk;
      pk[0] = pk2(o[0], o[1]); pk[1] = pk2(o[2], o[3]); pk[2] = pk2(o[4], o[5]); pk[3] = pk2(o[6], o[7]);
      *(v4u*)(qS + s * 136 + dg * 8) = pk;
      conv8(p, l, KB, grow0 + s, head * 128 + dg * 8, 512 + head * 128 + dg * 8, hasprev, hasnext, 0.08838834764831845f, o);
      pk[0] = pk2(o[0], o[1]); pk[1] = pk2(o[2], o[3]); pk[2] = pk2(o[4], o[5]); pk[3] = pk2(o[6], o[7]);
      *(v4u*)(kS + s * 136 + dg * 8) = pk;
    }
  }
  __syncthreads();
  if (tid < 256) {
    const int d = tid >> 7, t = tid & 127;
    float s = 0.f;
    for (int k = 0; k < 128; ++k) s += nS[d * 128 + k] * bf2f(qS[t * 136 + k]);
    nq[d * 128 + t] = s;
  }
  bf16x8 vfh[8];
  {
    const u16* VT0 = piece(p, P_VTB);
#pragma unroll
    for (int s8 = 0; s8 < 8; ++s8)
      vfh[s8] = *(const bf16x8*)(VT0 + ((size_t)(b * 512 + head * 128 + 32 * (wave & 3) + r)) * NKEY + key0 + 16 * s8 + 8 * hh);
  }
  f32x16 Pf[2], Pb[2];
  {
    const int tt = wave & 3, sh = wave >> 2;
    const int t = 32 * tt + r;
    bf16x8 qf[8];
#pragma unroll
    for (int ks = 0; ks < 8; ++ks) qf[ks] = *(const bf16x8*)(qS + t * 136 + 16 * ks + 8 * hh);
    const float bFt = bc[t], bBt = bc[128 + t];
    float csf = 0.f, csb = 0.f;
#pragma unroll
    for (int st2 = 0; st2 < 2; ++st2) {
      const int stile = 2 * sh + st2;
      f32x16 S = zero16();
#pragma unroll
      for (int ks = 0; ks < 8; ++ks) {
        const bf16x8 kf = *(const bf16x8*)(kS + (32 * stile + r) * 136 + 16 * ks + 8 * hh);
        S = mfma32(kf, qf[ks], S);
      }
#pragma unroll
      for (int e = 0; e < 16; ++e) {
        const int s = 32 * stile + (e & 3) + 8 * (e >> 2) + 4 * hh;
        const float raw = S[e];
        const float pf_ = (s <= t) ? raw * __expf(bFt - bc[s] + li[s]) : 0.f;
        const float pb_ = (s >= t) ? raw * __expf(bBt - bc[128 + s] + li[128 + s]) : 0.f;
        Pf[st2][e] = pf_;
        Pb[st2][e] = pb_;
        csf += pf_;
        csb += pb_;
      }
    }
    csf += __shfl_xor(csf, 32, 64);
    csb += __shfl_xor(csb, 32, 64);
    if (hh == 0) {
      colsum[(0 * 2 + sh) * 128 + t] = csf;
      colsum[(1 * 2 + sh) * 128 + t] = csb;
    }
  }
  bf16x8 cFh[8], cBh[8];
  {
    const u16* CST0 = (const u16*)(p.ws + WS_H);
    const u16* cF0 = CST0 + ((size_t)(chainF * 66 + P)) * 16384 + (32 * (wave & 3) + r) * 128 + 8 * hh;
    const u16* cB0 = CST0 + ((size_t)(chainB * 66 + P)) * 16384 + (32 * (wave & 3) + r) * 128 + 8 * hh;
#pragma unroll
    for (int ks = 0; ks < 8; ++ks) { cFh[ks] = *(const bf16x8*)(cF0 + 16 * ks); cBh[ks] = *(const bf16x8*)(cB0 + 16 * ks); }
  }
  __syncthreads();
  {
    const int tt = wave & 3, sh = wave >> 2;
    const int t = 32 * tt + r;
    const float eF = __expf(bc[t]), eB = __expf(bc[128 + t]);
    const float denF = eF * nq[t] + colsum[0 * 128 + t] + colsum[1 * 128 + t];
    const float denB = eB * nq[128 + t] + colsum[2 * 128 + t] + colsum[3 * 128 + t];
    const float invF = 1.f / fmaxf(fabsf(denF), 1.f);
    const float invB = 1.f / fmaxf(fabsf(denB), 1.f);
    if (sh == 0 && hh == 0) {
      cfs[t] = eF * invF;
      cfs[128 + t] = eB * invB;
    }
#pragma unroll
    for (int st2 = 0; st2 < 2; ++st2) {
      const int stile = 2 * sh + st2;
#pragma unroll
      for (int g = 0; g < 4; ++g) {
        v2u pk;
        pk[0] = pk2(Pf[st2][4 * g] * invF + Pb[st2][4 * g] * invB, Pf[st2][4 * g + 1] * invF + Pb[st2][4 * g + 1] * invB);
        pk[1] = pk2(Pf[st2][4 * g + 2] * invF + Pb[st2][4 * g + 2] * invB, Pf[st2][4 * g + 3] * invF + Pb[st2][4 * g + 3] * invB);
        const int pos = 32 * stile + 16 * (g >> 1) + 4 * (hh * 2 + (g & 1));
        *(v2u*)(pS + t * 136 + pos) = pk;
      }
    }
  }
  __syncthreads();
  const int dvt = wave & 3, tp = wave >> 2;
  f32x16 hacc[2];
  {
    const u16* VT = piece(p, P_VTB);
    const u16* CST = (const u16*)(p.ws + WS_H);
    f32x16 aP[2], aF[2], aB[2];
#pragma unroll
    for (int t2 = 0; t2 < 2; ++t2) { aP[t2] = zero16(); aF[t2] = zero16(); aB[t2] = zero16(); }
#pragma unroll
    for (int s8 = 0; s8 < 8; ++s8) {
      const bf16x8 vf = vfh[s8];
#pragma unroll
      for (int t2 = 0; t2 < 2; ++t2) {
        const bf16x8 pf_ = *(const bf16x8*)(pS + (32 * (2 * tp + t2) + r) * 136 + 16 * s8 + 8 * hh);
        aP[t2] = mfma32(vf, pf_, aP[t2]);
      }
    }
    const u16* cF = CST + ((size_t)(chainF * 66 + P)) * 16384 + (32 * dvt + r) * 128 + 8 * hh;
    const u16* cB = CST + ((size_t)(chainB * 66 + P)) * 16384 + (32 * dvt + r) * 128 + 8 * hh;
#pragma unroll
    for (int ks = 0; ks < 8; ++ks) {
      const bf16x8 f1 = cFh[ks];
      const bf16x8 f2 = cBh[ks];
#pragma unroll
      for (int t2 = 0; t2 < 2; ++t2) {
        const bf16x8 qf = *(const bf16x8*)(qS + (32 * (2 * tp + t2) + r) * 136 + 16 * ks + 8 * hh);
        aF[t2] = mfma32(f1, qf, aF[t2]);
        aB[t2] = mfma32(f2, qf, aB[t2]);
      }
    }
#pragma unroll
    for (int t2 = 0; t2 < 2; ++t2) {
      const int t = 32 * (2 * tp + t2) + r;
      const float cf = cfs[t], cb = cfs[128 + t];
      float ss = 0.f;
#pragma unroll
      for (int e = 0; e < 16; ++e) {
        const float hv = aP[t2][e] + cf * aF[t2][e] + cb * aB[t2][e];
        hacc[t2][e] = hv;
        ss += hv * hv;
      }
      ss += __shfl_xor(ss, 32, 64);
      if (hh == 0) hsq[dvt * 128 + t] = ss;
    }
  }
  __syncthreads();
  {
    u16* OB = piece(p, P_OB);
    const u16* ZB = piece(p, P_ZB);
    const float* mg = p.ml_g + l * 128;
#pragma unroll
    for (int t2 = 0; t2 < 2; ++t2) {
      const int t = 32 * (2 * tp + t2) + r;
      const float rinv = rsqrtf((hsq[t] + hsq[128 + t] + hsq[256 + t] + hsq[384 + t]) * (1.f / 128.f) + 1e-6f);
#pragma unroll
      for (int g = 0; g < 4; ++g) {
        const int dv0 = 32 * dvt + 8 * g + 4 * hh;
        const size_t off = (size_t)(grow0 + t) * 512 + head * 128 + dv0;
        const v2u ov = *(const v2u*)(OB + off);
        const v2u zv = *(const v2u*)(ZB + off);
        const float y0 = sigmoid_f(bflo(ov[0])) * hacc[t2][4 * g] * rinv * mg[dv0] * silu_f(bflo(zv[0]));
        const float y1 = sigmoid_f(bfhi(ov[0])) * hacc[t2][4 * g + 1] * rinv * mg[dv0 + 1] * silu_f(bfhi(zv[0]));
        const float y2 = sigmoid_f(bflo(ov[1])) * hacc[t2][4 * g + 2] * rinv * mg[dv0 + 2] * silu_f(bflo(zv[1]));
        const float y3 = sigmoid_f(bfhi(ov[1])) * hacc[t2][4 * g + 3] * rinv * mg[dv0 + 3] * silu_f(bfhi(zv[1]));
        v2u o;
        o[0] = pk2(y0, y1);
        o[1] = pk2(y2, y3);
        *(v2u*)(OB + off) = o;
      }
    }
  }
  __syncthreads();
}

__device__ __attribute__((always_inline)) void phase_s3(const Params& p, int l, unsigned char* smem) {
  const int nActx = (l == 0) ? 16 : 0, nCctx = (l == 0) ? 8 : 0;
  if ((gridDim.x & 7) == 0) {
    const int xcd = blockIdx.x & 7, slot = blockIdx.x >> 3, nb = gridDim.x >> 3;
#pragma unroll 1
    for (int q = slot; q < 64 + (nActx >> 3); q += nb) {
      const int b = xcd >> 2, h = xcd & 3;
      if (q < 64) attn_item(p, l, b, h, b * 8192 + q * 128, 0, 132, smem);
      else attn_item(p, l, b, h, 16384 + b * 256 + (q - 64) * 128, 128, 132, smem);
    }
  } else {
#pragma unroll 1
    for (int j = blockIdx.x; j < 512 + nActx; j += gridDim.x) {
      if (j < 512) {
        const int b = j >> 8, h = (j >> 6) & 3, qb = j & 63;
        attn_item(p, l, b, h, b * 8192 + qb * 128, 0, 132, smem);
      } else {
        const int jj = j - 512;
        const int b = jj >> 3, h = (jj >> 1) & 3, qh = jj & 1;
        attn_item(p, l, b, h, 16384 + b * 256 + qh * 128, 128, 132, smem);
      }
    }
  }
#pragma unroll 1
  for (int j = (blockIdx.x + gridDim.x - 32) % gridDim.x; j < 528; j += gridDim.x) {
    const int b = j / 264, rem = j % 264, head = rem / 66, P = rem % 66;
    mlstm_b1_item(p, l, b, head, P, smem);
  }
#pragma unroll 1
  for (int j = (blockIdx.x + gridDim.x - 64) % gridDim.x; j < 256 + nCctx; j += gridDim.x) {
    if (j < 256) natten_item(p, l, j >> 7, j & 127, (j >> 7) * 8192 + (j & 127) * 64, 0, smem);
    else natten_item(p, l, (j - 256) >> 2, 0, 16384 + ((j - 256) >> 2) * 256 + ((j - 256) & 3) * 64, 8, smem);
  }
}

__device__ __attribute__((always_inline)) void h2_rows(const Params& p, int l) {
  const int tid = opaque_tid(), lane = tid & 63, wave = tid >> 6;
  u16* H2 = slotp(p, 3);
  const float* rstd = (const float*)(p.ws + WS_RSTD);
#pragma unroll 2
  for (int row = blockIdx.x * 8 + wave; row < R_TOT; row += gridDim.x * 8) {
    const float* xr = xrow(p, l, row);
    const int w = which_of(row);
    const float* gs = (const float*)(p.ws + WS_GS) + w * 1024;
    const float* sh = (const float*)(p.ws + WS_SH) + w * 1024;
    const float rs = rstd[row];
#pragma unroll
    for (int j = 0; j < 4; ++j) {
      const int k = lane * 4 + 256 * j;
      const v4f v = *(const v4f*)(xr + k);
      const v4f g = *(const v4f*)(gs + k);
      const v4f sf = *(const v4f*)(sh + k);
      v2u pk;
      pk[0] = pk2(v[0] * rs * g[0] + sf[0], v[1] * rs * g[1] + sf[1]);
      pk[1] = pk2(v[2] * rs * g[2] + sf[2], v[3] * rs * g[3] + sf[3]);
      *(v2u*)(H2 + (size_t)row * 1024 + k) = pk;
    }
  }
}

__device__ __attribute__((always_inline)) void phase_s5(const Params& p, int l, unsigned char* smem) {
  h2_rows(p, l);
  const int P0 = (l == 0) ? 0 : 2;
  const int nP = 66 - P0;
  for (int it = (blockIdx.x + gridDim.x - 96) % gridDim.x; it < 8 * nP; it += gridDim.x) {
    const int bh = it / nP, P = P0 + it % nP;
    mlstm_b3_item(p, l, bh >> 2, bh & 3, P, smem);
  }
}

__device__ __forceinline__ void s6a_tile(const Params& p, int rt, int ct, unsigned char* smem) {
  const int tid = opaque_tid(), lane = tid & 63, wave = tid >> 6;
  const int wm = wave >> 1, wn = wave & 1, r = lane & 31, hh = lane >> 5;
  const u16* H2 = slotp(p, 3);
  const u16* WTI = (const u16*)(p.ws + WS_WT_IN);
  u16* G = slotp(p, 5);
  const int row0 = rt * 256;
  f32x16 acc[2][2];
  acc[0][0] = zero16(); acc[0][1] = zero16(); acc[1][0] = zero16(); acc[1][1] = zero16();
  gemm_core<0, 2>(acc, H2 + (size_t)row0 * 1024, 1024, nullptr, nullptr, nullptr, nullptr,
                  WTI + (size_t)(6656 + ct * 128) * 1024, 1024, smem);
  u16* Gn = G + (size_t)(ct >> 3) * R_TOT * 1024;
  const int d0 = (ct & 7) * 128 + 64 * wn + r;
#pragma unroll
  for (int i = 0; i < 2; ++i)
#pragma unroll
    for (int e = 0; e < 16; ++e) {
      const int row = row0 + 64 * wm + 32 * i + (e & 3) + 8 * (e >> 2) + 4 * hh;
      gu16* rp = (gu16*)Gn + (size_t)row * 1024 + d0;
      asm volatile("" : "+v"(rp));
      rp[0] = f2bf(sigmoid_f(acc[i][0][e]));
      rp[32] = f2bf(sigmoid_f(acc[i][1][e]));
    }
}

__device__ __forceinline__ void s6a_tile256(const Params& p, int rt, int ct, unsigned char* smem) {
  const int tid = opaque_tid(), lane = tid & 63, wave = tid >> 6;
  const int wm = wave >> 1, wn = wave & 1, r = lane & 31, hh = lane >> 5;
  const u16* H2 = slotp(p, 3);
  const u16* WTI = (const u16*)(p.ws + WS_WT_IN);
  u16* G = slotp(p, 5);
  const int row0 = rt * 256;
  f32x16 acc[2][4];
#pragma unroll
  for (int i = 0; i < 2; ++i)
#pragma unroll
    for (int j = 0; j < 4; ++j) acc[i][j] = zero16();
  gemm_core256<1>(acc, H2 + (size_t)row0 * 1024, 1024, WTI + (size_t)(6656 + ct * 256) * 1024, 1024, smem);
  u16* Gn = G + (size_t)(ct >> 2) * R_TOT * 1024;
  const int d0 = (ct & 3) * 256 + 128 * wn + r;
#pragma unroll
  for (int i = 0; i < 2; ++i)
#pragma unroll
    for (int e = 0; e < 16; ++e) {
      const int row = row0 + 64 * wm + 32 * i + (e & 3) + 8 * (e >> 2) + 4 * hh;
      gu16* rp = (gu16*)Gn + (size_t)row * 1024 + d0;
      asm volatile("" : "+v"(rp));
#pragma unroll
      for (int j = 0; j < 4; ++j) {
        float v = acc[i][j][e];
        asm volatile("" : "+v"(v));
        rp[32 * j] = f2bf(sigmoid_f(v));
      }
    }
}

__device__ __attribute__((always_inline)) void phase_s6a(const Params& p, int l, unsigned char* smem) {
  {
    const pg8::Gemm g{slotp(p, 3), (const u16*)(p.ws + WS_WT_IN) + (size_t)6656 * 1024, 16384, 3072, 1024};
    const SegOrder S = make_order(768, 1);
    const EpiS6a E{slotp(p, 5)};
    pg8::gemm_phase<EpiS6a, SegOrder, false>((PG8_LAS unsigned char*)smem, g, S, E, nullptr);
  }
  if (l == 0) {
#pragma unroll 1
    for (int it = blockIdx.x; it < 48; it += gridDim.x) s6a_tile(p, 64 + (it & 1), it >> 1, smem);
  }
}

template <int MI>
__device__ __forceinline__ void s6b_tile(const Params& p, int row0, int ct, unsigned char* smem) {
  const int tid = opaque_tid(), lane = tid & 63, wave = tid >> 6;
  const int wm = wave >> 1, wn = wave & 1, r = lane & 31, hh = lane >> 5;
  const u16* WTB = (const u16*)(p.ws + WS_WT_BR);
  const u16* G = slotp(p, 5);
  u16* M = (u16*)(p.ws + WS_H);
  f32x16 tot[MI][2];
#pragma unroll
  for (int i = 0; i < MI; ++i) { tot[i][0] = zero16(); tot[i][1] = zero16(); }
#pragma unroll 1
  for (int n = 0; n < 3; ++n) {
    f32x16 ap[MI][2];
#pragma unroll
    for (int i = 0; i < MI; ++i) { ap[i][0] = zero16(); ap[i][1] = zero16(); }
    if constexpr (MI == 2)
      gemm_core_lean2(ap, slotp(p, n) + (size_t)row0 * 512, 512, WTB + (size_t)(n * 1024 + ct * 128) * 512, 512, smem);
    else
      gemm_core<0, MI>(ap, slotp(p, n) + (size_t)row0 * 512, 512, nullptr, nullptr, nullptr, nullptr,
                       WTB + (size_t)(n * 1024 + ct * 128) * 512, 512, smem);
    const u16* Gn = G + (size_t)n * R_TOT * 1024;
#pragma unroll
    for (int i = 0; i < MI; ++i)
#pragma unroll
      for (int e = 0; e < 16; ++e) {
        const int row = row0 + 32 * MI * wm + 32 * i + (e & 3) + 8 * (e >> 2) + 4 * hh;
        const gu16* rp = (const gu16*)Gn + (size_t)row * 1024 + ct * 128 + 64 * wn + r;
        asm volatile("" : "+v"(rp));
        tot[i][0][e] += bf2f(rp[0]) * ap[i][0][e];
        tot[i][1][e] += bf2f(rp[32]) * ap[i][1][e];
      }
  }
#pragma unroll
  for (int i = 0; i < MI; ++i)
#pragma unroll
    for (int e = 0; e < 16; ++e) {
      const int row = row0 + 32 * MI * wm + 32 * i + (e & 3) + 8 * (e >> 2) + 4 * hh;
      gu16* rp = (gu16*)M + (size_t)row * 1024 + ct * 128 + 64 * wn + r;
      asm volatile("" : "+v"(rp));
      rp[0] = f2bf(tot[i][0][e]);
      rp[32] = f2bf(tot[i][1][e]);
    }
}

__device__ __forceinline__ void s6b_tile_t(const Params& p, int tok0, int ft, unsigned char* smem) {
  const int tid = opaque_tid(), lane = tid & 63, wave = tid >> 6;
  const int wm = wave >> 1, wn = wave & 1, r = lane & 31, hh = lane >> 5;
  const u16* WTB = (const u16*)(p.ws + WS_WT_BR);
  const u16* G = slotp(p, 5);
  u16* M = (u16*)(p.ws + WS_H);
  f32x16 tot[2][2];
  tot[0][0] = zero16(); tot[0][1] = zero16(); tot[1][0] = zero16(); tot[1][1] = zero16();
#pragma unroll 1
  for (int n = 0; n < 3; ++n) {
    f32x16 ap[2][2];
    ap[0][0] = zero16(); ap[0][1] = zero16(); ap[1][0] = zero16(); ap[1][1] = zero16();
    gemm_core_lean2(ap, WTB + (size_t)(n * 1024 + ft * 256) * 512, 512, slotp(p, n) + (size_t)tok0 * 512, 512, smem);
    const gu16* Gn = (const gu16*)G + (size_t)n * R_TOT * 1024;
#pragma unroll
    for (int j = 0; j < 2; ++j) {
      const int tok = tok0 + 64 * wn + 32 * j + r;
      const gu16* gp = Gn + (size_t)tok * 1024 + ft * 256 + 64 * wm + 4 * hh;
      asm volatile("" : "+v"(gp));
#pragma unroll
      for (int i = 0; i < 2; ++i)
#pragma unroll
        for (int g = 0; g < 4; ++g) {
          const v2u gq = *(const gv2u*)(gp + 32 * i + 8 * g);
          tot[i][j][4 * g] += bflo(gq[0]) * ap[i][j][4 * g];
          tot[i][j][4 * g + 1] += bfhi(gq[0]) * ap[i][j][4 * g + 1];
          tot[i][j][4 * g + 2] += bflo(gq[1]) * ap[i][j][4 * g + 2];
          tot[i][j][4 * g + 3] += bfhi(gq[1]) * ap[i][j][4 * g + 3];
        }
    }
  }
#pragma unroll
  for (int j = 0; j < 2; ++j) {
    const int tok = tok0 + 64 * wn + 32 * j + r;
    gu16* mp = (gu16*)M + (size_t)tok * 1024 + ft * 256 + 64 * wm + 4 * hh;
    asm volatile("" : "+v"(mp));
#pragma unroll
    for (int i = 0; i < 2; ++i)
#pragma unroll
      for (int g = 0; g < 4; ++g) {
        v2u o;
        o[0] = pk2(tot[i][j][4 * g], tot[i][j][4 * g + 1]);
        o[1] = pk2(tot[i][j][4 * g + 2], tot[i][j][4 * g + 3]);
        *(gv2u*)(mp + 32 * i + 8 * g) = o;
      }
  }
}

__device__ __attribute__((always_inline)) void phase_s6b(const Params& p, int l, unsigned char* smem) {
  {
    const bool xs = (gridDim.x & 7) == 0;
    const int nb = xs ? (gridDim.x >> 3) : gridDim.x;
    const int xcd = xs ? (blockIdx.x & 7) : 0, slot = xs ? (blockIdx.x >> 3) : blockIdx.x;
    const int seg0 = xs ? 64 * xcd : 0, seg1 = xs ? 64 * (xcd + 1) : 512;
#pragma unroll 1
    for (int L = seg0 + slot; L < seg1; L += nb) {
      const int g = L >> 6, rem = L & 63, ft = rem >> 4, tt = 16 * g + (rem & 15);
      s6b_tile_t(p, tt * 128, ft, smem);
    }
  }
  if (l == 0) {
#pragma unroll 1
    for (int it = blockIdx.x; it < 32; it += gridDim.x) s6b_tile<1>(p, 16384 + (it & 3) * 128, it >> 2, smem);
  }
}

template <int MI>
__device__ __forceinline__ void s7_tile(const Params& p, int l, int row0, int ct, unsigned char* smem) {
  const int tid = opaque_tid(), lane = tid & 63, wave = tid >> 6;
  const int wm = wave >> 1, wn = wave & 1, r = lane & 31, hh = lane >> 5;
  const u16* WTO = (const u16*)(p.ws + WS_WT_OUT);
  const u16* M = (const u16*)(p.ws + WS_H);
  const float* mod = (const float*)(p.ws + WS_MOD) + (size_t)l * 3 * 3072;
  const int w = which_of(row0);
  f32x16 acc[MI][2];
#pragma unroll
  for (int i = 0; i < MI; ++i) { acc[i][0] = zero16(); acc[i][1] = zero16(); }
  gemm_core<0, MI>(acc, M + (size_t)row0 * 1024, 1024, nullptr, nullptr, nullptr, nullptr, WTO + (size_t)(ct * 128) * 1024, 1024, smem);
  const float* xs_ = xrow(p, l, row0);
  float* xd = (row0 < 16384) ? (p.out + (size_t)row0 * 1024) : ((float*)(p.ws + WS_XC) + (size_t)(row0 - 16384) * 1024);
  const int col0 = ct * 128 + 64 * wn + r;
  const float g0 = mod[w * 3072 + 2048 + col0], g1 = mod[w * 3072 + 2048 + col0 + 32];
#pragma unroll
  for (int i = 0; i < MI; ++i)
#pragma unroll
    for (int e = 0; e < 16; ++e) {
      const size_t off = (size_t)(32 * MI * wm + 32 * i + (e & 3) + 8 * (e >> 2) + 4 * hh) * 1024 + col0;
      const gfloat* sp = (const gfloat*)xs_ + off;
      gfloat* dp = (gfloat*)xd + off;
      asm volatile("" : "+v"(sp), "+v"(dp));
      dp[0] = sp[0] + g0 * acc[i][0][e];
      dp[32] = sp[32] + g1 * acc[i][1][e];
    }
}

__device__ __attribute__((always_inline)) void phase_s7(const Params& p, int l, unsigned char* smem) {
  {
    const pg8::Gemm g{(const u16*)(p.ws + WS_H), (const u16*)(p.ws + WS_WT_OUT), 16384, 1024, 1024};
    const SegOrder S = make_order(256, 2);
    const EpiS7 E{(l == 0) ? p.x : (const float*)p.out, p.out, nullptr, (const float*)(p.ws + WS_MOD) + (size_t)l * 3 * 3072};
    pg8::gemm_phase<EpiS7, SegOrder, false>((PG8_LAS unsigned char*)smem, g, S, E, nullptr);
  }
  if (l == 0) {
#pragma unroll 1
    for (int it = blockIdx.x; it < 32; it += gridDim.x) s7_tile<1>(p, l, 16384 + (it & 3) * 128, it >> 2, smem);
  }
}

__device__ __attribute__((always_inline)) void phase_final(const Params& p) {
  const int tid = threadIdx.x, lane = tid & 63, wave = tid >> 6;
#pragma unroll 2
  for (int row = blockIdx.x * 8 + wave; row < 16384; row += gridDim.x * 8) {
    float* xr = p.out + (size_t)row * 1024;
    v4f v[4];
    float ss = 0.f;
#pragma unroll
    for (int j = 0; j < 4; ++j) {
      v[j] = *(const v4f*)(xr + lane * 4 + 256 * j);
      ss += v[j][0] * v[j][0] + v[j][1] * v[j][1] + v[j][2] * v[j][2] + v[j][3] * v[j][3];
    }
    ss = wave_sum(ss);
    const float rs = rsqrtf(ss * (1.f / 1024.f) + 1e-6f);
#pragma unroll
    for (int j = 0; j < 4; ++j) {
      const v4f g = *(const v4f*)(p.final_g + lane * 4 + 256 * j);
      v4f o;
#pragma unroll
      for (int e = 0; e < 4; ++e) o[e] = v[j][e] * rs * g[e];
      *(v4f*)(xr + lane * 4 + 256 * j) = o;
    }
  }
}

#define XB_TMO      128
#define XB_XCNT(j)  (256  + 64 * (j))
#define XB_XSUB(j)  (1280 + 64 * (j))
#define XB_XGEN(j)  (2304 + 64 * (j))
#define XB_TOP      3328
#define XB_TOPGEN   3392
#define XCD_BAR_WORDS 3456
#define XB_SPIN_CAP (1u << 18)
#define LAS __attribute__((address_space(3)))

__device__ __forceinline__ unsigned xb_ld(unsigned* p)              { return __hip_atomic_load(p, __ATOMIC_RELAXED, __HIP_MEMORY_SCOPE_AGENT); }
__device__ __forceinline__ unsigned xb_add(unsigned* p, unsigned v) { return __hip_atomic_fetch_add(p, v, __ATOMIC_RELAXED, __HIP_MEMORY_SCOPE_AGENT); }
__device__ __forceinline__ unsigned xb_xcc_id() { return (unsigned)__builtin_amdgcn_s_getreg((3 << 11) | 20) & 0xFu; }
#define XB_SPIN(cond, bar) do { unsigned _sp = 0; while (cond) { __builtin_amdgcn_s_sleep(1); \
    if ((++_sp & 255u) == 0u) { if (xb_ld(&(bar)[XB_TMO])) break; if (_sp > XB_SPIN_CAP) { atomicAdd(&(bar)[XB_TMO], 1u); break; } } } } while (0)

struct XcdBarrier {
    unsigned* bar; unsigned x;
    volatile LAS unsigned* st;
};

__device__ __forceinline__ XcdBarrier xcd_barrier_post(unsigned* bar, volatile LAS unsigned* st) {
    XcdBarrier b; b.bar = bar; b.x = xb_xcc_id(); b.st = st;
    if (threadIdx.x == 0) (void)xb_add(&bar[XB_XCNT(b.x)], 1u);
    return b;
}
__device__ __forceinline__ void xcd_barrier_complete(unsigned* bar, unsigned x, unsigned& nloc, unsigned& nx) {
    const unsigned G = gridDim.x * gridDim.y * gridDim.z;
    unsigned sum, cnt, mine, sp = 0u;
    for (;;) {
        sum = 0u; cnt = 0u; mine = 0u;
#pragma unroll
        for (unsigned j = 0; j < 16; ++j) { const unsigned c = xb_ld(&bar[XB_XCNT(j)]); sum += c; cnt += (c > 0u) ? 1u : 0u; mine = (j == x) ? c : mine; }
        if (sum == G) break;
        __builtin_amdgcn_s_sleep(1);
        if ((++sp & 255u) == 0u) { if (xb_ld(&bar[XB_TMO])) break; if (sp > XB_SPIN_CAP) { atomicAdd(&bar[XB_TMO], 1u); break; } }
    }
    nloc = mine > 0u ? mine : 1u; nx = cnt > 0u ? cnt : 1u;
}

__device__ __forceinline__ void xcd_barrier(const XcdBarrier& b) {
    asm volatile("s_waitcnt vmcnt(0)" ::: "memory");
    __syncthreads();
    if (threadIdx.x == 0) {
        unsigned* bar = b.bar;
        __builtin_amdgcn_s_waitcnt(0);
        unsigned nloc = b.st[0], nx = b.st[1];
        if (nloc == 0u) { xcd_barrier_complete(bar, b.x, nloc, nx); b.st[0] = nloc; b.st[1] = nx; }
        const unsigned old = xb_add(&bar[XB_XSUB(b.x)], 1u);
        const unsigned gen = old / nloc;
        if (old + 1u == (gen + 1u) * nloc) {
            __builtin_amdgcn_fence(__ATOMIC_RELEASE, "agent");
            asm volatile("s_waitcnt vmcnt(0)" ::: "memory");
            const unsigned og = xb_add(&bar[XB_TOP], 1u);
            const unsigned tg = og / nx;
            if (og + 1u == (tg + 1u) * nx) xb_add(&bar[XB_TOPGEN], 1u);
            else XB_SPIN(xb_ld(&bar[XB_TOPGEN]) == tg, bar);
            __builtin_amdgcn_fence(__ATOMIC_ACQUIRE, "agent");
            xb_add(&bar[XB_XGEN(b.x)], 1u);
            asm volatile("s_waitcnt vmcnt(0)" ::: "memory");
        } else {
            XB_SPIN(xb_ld(&bar[XB_XGEN(b.x)]) == gen, bar);
            __builtin_amdgcn_fence(__ATOMIC_ACQUIRE, "agent");
            asm volatile("s_waitcnt vmcnt(0)" ::: "memory");
        }
    }
    __syncthreads();
}


__global__ void __launch_bounds__(NTHR) fwd_megakernel(Params p) {
  extern __shared__ __attribute__((aligned(16))) unsigned char smem[];
  cg::grid_group grid = cg::this_grid();
  __shared__ uint4 xb_words;
  if (threadIdx.x == 0) xb_words = make_uint4(0u, 0u, 0u, 0u);
  __syncthreads();
  XcdBarrier xbar = xcd_barrier_post((unsigned*)(p.ws + WS_BAR), (volatile LAS unsigned*)&xb_words);
#define PH(k, call)                                  \
  if (p.ph_lo <= (k) && (k) < p.ph_hi) {             \
    call;                                            \
    if ((k) + 1 < p.ph_hi) { if ((k) == 0) grid.sync(); else xcd_barrier(xbar); }  \
  }
  PH(0, phase_s0(p))
  PH(1, phase_s1(p, 0, smem))
  PH(2, phase_s2(p, 0, smem))
  PH(3, phase_s3(p, 0, smem))
  PH(4, phase_b2(p))
  PH(5, phase_s5(p, 0, smem))
  PH(6, phase_s6a(p, 0, smem))
  PH(7, phase_s6b(p, 0, smem))
  PH(8, phase_s7(p, 0, smem))
  PH(9, phase_s1(p, 1, smem))
  PH(10, phase_s2(p, 1, smem))
  PH(11, phase_s3(p, 1, smem))
  PH(12, phase_b2(p))
  PH(13, phase_s5(p, 1, smem))
  PH(14, phase_s6a(p, 1, smem))
  PH(15, phase_s6b(p, 1, smem))
  PH(16, phase_s7(p, 1, smem))
  PH(17, phase_final(p))
#undef PH
}

extern "C" void kernel_launch(void* const* d_in, const int* in_sizes, int n_in, void* d_out, int out_size,
                              void* d_ws, size_t ws_size, hipStream_t stream) {
  static int grid_blocks = 0;
  if (grid_blocks == 0) {
    if (n_in != 19 || ws_size < WS_END) {
      fprintf(stderr, "kernel_launch: unexpected n_in %d or ws_size %zu (< %llu)\n", n_in, ws_size, (unsigned long long)WS_END);
      grid_blocks = -1;
      return;
    }
    int dev = 0, cus = 0, per_cu = 0;
    hipGetDevice(&dev);
    hipDeviceGetAttribute(&cus, hipDeviceAttributeMultiprocessorCount, dev);
    if (hipFuncSetAttribute((const void*)fwd_megakernel, hipFuncAttributeMaxDynamicSharedMemorySize, LDS_BYTES) != hipSuccess) {
      fprintf(stderr, "kernel_launch: hipFuncSetAttribute failed\n");
      grid_blocks = -1;
      return;
    }
    hipOccupancyMaxActiveBlocksPerMultiprocessor(&per_cu, (const void*)fwd_megakernel, NTHR, LDS_BYTES);
    if (per_cu < 1) { fprintf(stderr, "kernel_launch: occupancy query says %d blocks/CU\n", per_cu); per_cu = 1; }
    (void)hipGetLastError();
    grid_blocks = cus;
  }
  if (grid_blocks < 0) return;
  hipMemsetAsync((char*)d_ws + WS_BAR, 0, 13824 + 73728, stream);
  Params p{};
  p.x = (const float*)d_in[0]; p.c = (const float*)d_in[1]; p.ctx = (const float*)d_in[2]; p.c_ctx = (const float*)d_in[3];
  p.w_mod = (const float*)d_in[4]; p.b_mod = (const float*)d_in[5]; p.norm_g = (const float*)d_in[6]; p.w_in = (const float*)d_in[7];
  p.lam_q = (const float*)d_in[8]; p.lam_k = (const float*)d_in[9]; p.da_g = (const float*)d_in[10];
  p.conv_w = (const float*)d_in[11]; p.conv_b = (const float*)d_in[12]; p.gate_b = (const float*)d_in[13]; p.ml_g = (const float*)d_in[14];
  p.rpb = (const float*)d_in[15]; p.w_br = (const float*)d_in[16]; p.w_out = (const float*)d_in[17]; p.final_g = (const float*)d_in[18];
  p.out = (float*)d_out; p.ws = (unsigned char*)d_ws;
#if MULTI_LAUNCH
  for (int ph = 0; ph < NPHASE; ++ph) {
    p.ph_lo = ph; p.ph_hi = ph + 1;
    hipLaunchKernelGGL(fwd_megakernel, dim3(grid_blocks), dim3(NTHR), LDS_BYTES, stream, p);
  }
#else
  p.ph_lo = 0; p.ph_hi = NPHASE;
  void* args[] = {&p};
  hipError_t e = hipLaunchCooperativeKernel((void*)fwd_megakernel, dim3(grid_blocks), dim3(NTHR), args, LDS_BYTES, stream);
  if (e != hipSuccess) fprintf(stderr, "cooperative launch failed: %s (grid %d)\n", hipGetErrorString(e), grid_blocks);
#endif
}
```

```cpp
#include <hip/hip_runtime.h>
#include <hip/hip_cooperative_groups.h>
#include <cstdio>
namespace cg = cooperative_groups;

#ifndef MULTI_LAUNCH
#define MULTI_LAUNCH 0
#endif

typedef unsigned short u16;
typedef __attribute__((ext_vector_type(8))) short bf16x8;
typedef __attribute__((ext_vector_type(16))) float f32x16;
typedef __attribute__((ext_vector_type(4))) unsigned int v4u;
typedef __attribute__((ext_vector_type(2))) unsigned int v2u;
typedef __attribute__((ext_vector_type(4))) float v4f;

#define R_TOT 16896
#define NKEY 8448
#define NPAD 9856
#define NTHR 512
#define LDS_BYTES 147456
#define NPHASE 18

#define WS_WT_IN 0ull
#define WS_WT_BR 20185088ull
#define WS_WT_OUT 23330816ull
#define WS_H 25427968ull
#define WS_PIECE 60030976ull
#define PIECE_SZ 17301504ull
#define WS_XC 284950528ull
#define WS_G 287047680ull
#define WS_MOD 289410816ull
#define WS_ROPE 288202752ull
#define WS_RSTD 288219136ull
#define WS_DN 288286720ull
#define WS_NPREV 288827392ull
#define WS_BL 289368064ull
#define WS_GS 289372416ull
#define WS_SH 289384704ull
#define WS_BAR 289396992ull
#define WS_END 289484544ull

enum { P_QA = 0, P_KA, P_VTA, P_ZA, P_QB, P_KB, P_VTB, P_OB, P_ZB, P_QC, P_KC, P_VTC, P_ZC };

#define GAS __attribute__((address_space(1)))
typedef GAS u16 gu16;
typedef GAS float gfloat;
typedef GAS v2u gv2u;
typedef GAS v4f gv4f;
struct Params {
  const float *x, *c, *ctx, *c_ctx, *w_mod, *b_mod, *norm_g, *w_in, *lam_q, *lam_k, *da_g,
      *conv_w, *conv_b, *gate_b, *ml_g, *rpb, *w_br, *w_out, *final_g;
  float* out;
  unsigned char* ws;
  int ph_lo, ph_hi;
};

__device__ __forceinline__ int opaque_tid() { int t = threadIdx.x; asm volatile("" : "+v"(t)); return t; }
__device__ __forceinline__ u16 f2bf(float f) {
  unsigned u = __float_as_uint(f);
  u += 0x7fffu + ((u >> 16) & 1u);
  return (u16)(u >> 16);
}
__device__ __forceinline__ float bf2f(u16 h) { return __uint_as_float(((unsigned)h) << 16); }
typedef __attribute__((ext_vector_type(2))) __bf16 bf16x2_t;
typedef __attribute__((ext_vector_type(2))) float f32x2_t;
__device__ __forceinline__ unsigned pk2(float a, float b) { f32x2_t v = {a, b}; bf16x2_t r = __builtin_convertvector(v, bf16x2_t); return __builtin_bit_cast(unsigned, r); }
__device__ __forceinline__ float bflo(unsigned u) { return __uint_as_float(u << 16); }
__device__ __forceinline__ float bfhi(unsigned u) { return __uint_as_float(u & 0xffff0000u); }
__device__ __forceinline__ float silu_f(float x) { return x / (1.f + __expf(-x)); }
__device__ __forceinline__ float sigmoid_f(float x) { return 1.f / (1.f + __expf(-x)); }
__device__ __forceinline__ float ex2(float x) { return __builtin_amdgcn_exp2f(x); }
__device__ __forceinline__ float wave_sum(float v) {
#pragma unroll
  for (int o = 32; o > 0; o >>= 1) v += __shfl_xor(v, o, 64);
  return v;
}
__device__ __forceinline__ f32x16 mfma32(bf16x8 a, bf16x8 b, f32x16 c) {
  return __builtin_amdgcn_mfma_f32_32x32x16_bf16(a, b, c, 0, 0, 0);
}
__device__ __forceinline__ f32x16 zero16() {
  f32x16 z;
#pragma unroll
  for (int i = 0; i < 16; ++i) z[i] = 0.f;
  return z;
}
__device__ __forceinline__ int pslot(int i) { return (int)((0xCBA2918765430ull >> (4 * i)) & 15ull); }
__device__ __forceinline__ u16* piece(const Params& p, int i) { return (u16*)(p.ws + WS_PIECE + (size_t)pslot(i) * PIECE_SZ); }
__device__ __forceinline__ u16* slotp(const Params& p, int sl) { return (u16*)(p.ws + WS_PIECE + (size_t)sl * PIECE_SZ); }
__device__ __forceinline__ const float* xrow(const Params& p, int l, int grow) {
  if (grow < 16384) return (l == 0 ? p.x : (const float*)p.out) + (size_t)grow * 1024;
  return (l == 0 ? p.ctx : (const float*)(p.ws + WS_XC)) + (size_t)(grow - 16384) * 1024;
}
__device__ __forceinline__ int which_of(int grow) { return grow < 8192 ? 0 : (grow < 16384 ? 1 : 2); }
__device__ __forceinline__ int perm16(int s) { return (s & ~15) | (((s >> 2) & 1) << 3) | (((s >> 3) & 1) << 2) | (s & 3); }

__device__ __attribute__((always_inline)) void phase_s0(const Params& p) {
  const int tid = threadIdx.x;
  float* mod = (float*)(p.ws + WS_MOD);
  for (int it = blockIdx.x; it < 2 * 12 * 16; it += gridDim.x) {
    const int l = it / 192, rem = it % 192, nch = rem / 16, kch = rem % 16;
    const int kh = tid >> 8, n = nch * 256 + (tid & 255);
    const int k0 = kch * 64 + kh * 32;
    const float* W = p.w_mod + (size_t)l * 1024 * 3072;
    float a0 = 0.f, a1 = 0.f, a2 = 0.f;
#pragma unroll 8
    for (int k = k0; k < k0 + 32; ++k) {
      const float w = W[(size_t)k * 3072 + n];
      a0 += silu_f(p.c[k]) * w;
      a1 += silu_f(p.c[1024 + k]) * w;
      a2 += silu_f(p.c_ctx[k]) * w;
    }
    if (kch == 0 && kh == 0) {
      const float bb = p.b_mod[l * 3072 + n];
      a0 += bb; a1 += bb; a2 += bb;
    }
    atomicAdd(&mod[(l * 3 + 0) * 3072 + n], a0);
    atomicAdd(&mod[(l * 3 + 1) * 3072 + n], a1);
    atomicAdd(&mod[(l * 3 + 2) * 3072 + n], a2);
  }
  const int gi = blockIdx.x * NTHR + tid;
  if (gi < 2048) {
    const int v = gi >> 4, f = gi & 15;
    const float inv = (float)exp(-(double)f * (9.210340371976184 / 16.0));
    const float angf = (float)v * inv;
    double a = (double)angf;
    const double twopi = 6.283185307179586476925;
    a -= twopi * floor(a / twopi + 0.5);
    const double a2 = a * a;
    double ts = a, tc = 1.0, sn = a, cs = 1.0;
    for (int i = 1; i <= 14; ++i) {
      tc = -tc * a2 / (double)((2 * i - 1) * (2 * i));
      ts = -ts * a2 / (double)((2 * i) * (2 * i + 1));
      cs += tc; sn += ts;
    }
    float* rt = (float*)(p.ws + WS_ROPE);
    rt[gi * 2] = (float)cs;
    rt[gi * 2 + 1] = (float)sn;
  }
}

__device__ __attribute__((always_inline)) void conv_tile(const float* __restrict__ src, int ld, int k0, int col0, int nvalid, bool perm,
                          u16* __restrict__ dst, int ldd, int n0, unsigned char* smem) {
  u16* t = (u16*)smem;
  const int tid = opaque_tid();
#pragma unroll
  for (int i = 0; i < 2; ++i) {
    const int idx = tid + NTHR * i;
    const int kk = idx >> 4, c4 = idx & 15;
    v4f v = {0.f, 0.f, 0.f, 0.f};
    if (4 * c4 < nvalid) v = *(const v4f*)(src + (size_t)(k0 + kk) * ld + col0 + 4 * c4);
#pragma unroll
    for (int e = 0; e < 4; ++e) {
      const int j = 4 * c4 + e;
      const int jp = perm ? (32 * (j >> 5) + 8 * (((j >> 1) & 15) >> 2) + 4 * (j & 1) + ((j >> 1) & 3)) : j;
      t[jp * 72 + kk] = f2bf(v[e]);
    }
  }
  __syncthreads();
  {
    const int n = tid >> 3, ch = tid & 7;
    const v4u v = *(const v4u*)(t + n * 72 + ch * 8);
    *(v4u*)(dst + (size_t)(n0 + n) * ldd + k0 + ch * 8) = v;
  }
  __syncthreads();
}

__device__ __attribute__((always_inline)) void phase_s1(const Params& p, int l, unsigned char* smem) {
  const int tid = threadIdx.x, lane = tid & 63, wave = tid >> 6;
  const float* mod = (const float*)(p.ws + WS_MOD) + (size_t)l * 3 * 3072;
  const float* g = p.norm_g + l * 1024;
  u16* H = (u16*)(p.ws + WS_H);
  float* rstd = (float*)(p.ws + WS_RSTD);
  if (blockIdx.x == 0) {
    float* gs = (float*)(p.ws + WS_GS);
    float* sh = (float*)(p.ws + WS_SH);
    for (int i = tid; i < 3072; i += NTHR) {
      const int w = i >> 10, k = i & 1023;
      gs[i] = g[k] * (1.f + mod[w * 3072 + 1024 + k]);
      sh[i] = mod[w * 3072 + k];
    }
  }
#pragma unroll 2
  for (int row = blockIdx.x * 8 + wave; row < R_TOT; row += gridDim.x * 8) {
    const float* xr = xrow(p, l, row);
    const int w = which_of(row);
    v4f v[4];
    float ss = 0.f;
#pragma unroll
    for (int j = 0; j < 4; ++j) {
      v[j] = *(const v4f*)(xr + lane * 4 + 256 * j);
      ss += v[j][0] * v[j][0] + v[j][1] * v[j][1] + v[j][2] * v[j][2] + v[j][3] * v[j][3];
    }
    ss = wave_sum(ss);
    const float rs = rsqrtf(ss * (1.f / 1024.f) + 1e-6f);
    if (lane == 0) rstd[row] = rs;
#pragma unroll
    for (int j = 0; j < 4; ++j) {
      const int k = lane * 4 + 256 * j;
      const v4f gg = *(const v4f*)(g + k);
      const v4f sc = *(const v4f*)(mod + w * 3072 + 1024 + k);
      const v4f sf = *(const v4f*)(mod + w * 3072 + k);
      float o[4];
#pragma unroll
      for (int e = 0; e < 4; ++e) o[e] = v[j][e] * rs * gg[e] * (1.f + sc[e]) + sf[e];
      v2u pk;
      pk[0] = pk2(o[0], o[1]);
      pk[1] = pk2(o[2], o[3]);
      *(v2u*)(H + (size_t)row * 1024 + k) = pk;
    }
  }
  u16* WTI = (u16*)(p.ws + WS_WT_IN);
  u16* WTB = (u16*)(p.ws + WS_WT_BR);
  u16* WTO = (u16*)(p.ws + WS_WT_OUT);
  const float* win = p.w_in + (size_t)l * 1024 * 9744;
  for (int it = blockIdx.x; it < 2464 + 384 + 256; it += gridDim.x) {
    if (it < 2464) {
      const int nb = it % 154, kb = it / 154;
      const int n0 = nb * 64;
      int col0 = n0, nvalid = 64;
      bool perm = n0 < 1024;
      if (n0 >= 4608 && n0 < 9728) col0 = n0 + 16;
      else if (n0 == 9728) { col0 = 4608; nvalid = 16; }
      else if (n0 > 9728) { col0 = 0; nvalid = 0; }
      conv_tile(win, 9744, kb * 64, col0, nvalid, perm, WTI, 1024, n0, smem);
    } else if (it < 2464 + 384) {
      const int j = it - 2464;
      const int n = j / 128, r = j % 128, db = r / 8, wb = r % 8;
      conv_tile(p.w_br + ((size_t)l * 3 + n) * 512 * 1024, 1024, wb * 64, db * 64, 64, false,
                WTB + (size_t)n * 1024 * 512, 512, db * 64, smem);
    } else {
      const int j = it - 2464 - 384;
      const int db = j / 16, kb = j % 16;
      conv_tile(p.w_out + (size_t)l * 1024 * 1024, 1024, kb * 64, db * 64, 64, false, WTO, 1024, db * 64, smem);
    }
  }
}

template <int AMODE, int MI>
__device__ __forceinline__ void gemm_core(f32x16 (&acc)[MI][2], const u16* __restrict__ A, int lda,
                                          const float* __restrict__ Ax, const float* __restrict__ rstd,
                                          const float* __restrict__ gs, const float* __restrict__ sh,
                                          const u16* __restrict__ B, int K, unsigned char* smem) {
  constexpr int AROWS = 128 * MI;
  u16* As = (u16*)smem;
  u16* Bs = (u16*)(smem + 73728);
  const int tid = opaque_tid(), lane = tid & 63, wave = tid >> 6;
  const int wm = wave >> 1, wn = wave & 1, r = lane & 31, hh = lane >> 5;
  const int lrow = tid >> 3, c8 = tid & 7;
  v4u ra[2][2 * MI], rb[2][2];
  float rs4[2 * MI];
  if (AMODE == 1) {
#pragma unroll
    for (int i = 0; i < 2 * MI; ++i) rs4[i] = rstd[lrow + 64 * i];
  }
  const int KT = K >> 6;
#define GEMM_LOAD(set, k0)                                                                        \
  {                                                                                               \
    if (AMODE == 0) {                                                                             \
      _Pragma("unroll") for (int i = 0; i < 2 * MI; ++i)                                          \
        ra[set][i] = *(const v4u*)(A + (size_t)(lrow + 64 * i) * lda + (k0) + c8 * 8);            \
    } else {                                                                                      \
      const v4f g0 = *(const v4f*)(gs + (k0) + c8 * 8), g1 = *(const v4f*)(gs + (k0) + c8 * 8 + 4); \
      const v4f s0 = *(const v4f*)(sh + (k0) + c8 * 8), s1 = *(const v4f*)(sh + (k0) + c8 * 8 + 4); \
      _Pragma("unroll") for (int i = 0; i < 2 * MI; ++i) {                                        \
        const float* xp = Ax + (size_t)(lrow + 64 * i) * 1024 + (k0) + c8 * 8;                    \
        const v4f x0 = *(const v4f*)xp, x1 = *(const v4f*)(xp + 4);                               \
        const float rr = rs4[i];                                                                  \
        ra[set][i][0] = pk2(x0[0] * rr * g0[0] + s0[0], x0[1] * rr * g0[1] + s0[1]);              \
        ra[set][i][1] = pk2(x0[2] * rr * g0[2] + s0[2], x0[3] * rr * g0[3] + s0[3]);              \
        ra[set][i][2] = pk2(x1[0] * rr * g1[0] + s1[0], x1[1] * rr * g1[1] + s1[1]);              \
        ra[set][i][3] = pk2(x1[2] * rr * g1[2] + s1[2], x1[3] * rr * g1[3] + s1[3]);              \
      }                                                                                           \
    }                                                                                             \
    _Pragma("unroll") for (int i = 0; i < 2; ++i)                                                 \
        rb[set][i] = *(const v4u*)(B + (size_t)(lrow + 64 * i) * K + (k0) + c8 * 8);              \
  }
#define GEMM_STORE(set, buf)                                                                      \
  {                                                                                               \
    _Pragma("unroll") for (int i = 0; i < 2 * MI; ++i)                                            \
        *(v4u*)(As + (buf) * AROWS * 72 + (lrow + 64 * i) * 72 + c8 * 8) = ra[set][i];            \
    _Pragma("unroll") for (int i = 0; i < 2; ++i)                                                 \
        *(v4u*)(Bs + (buf) * 128 * 72 + (lrow + 64 * i) * 72 + c8 * 8) = rb[set][i];              \
  }
#define GEMM_COMPUTE(cur)                                                                         \
  {                                                                                               \
    const u16* Ab = As + (cur) * AROWS * 72 + (32 * MI * wm + r) * 72 + 8 * hh;                   \
    const u16* Bb = Bs + (cur) * 128 * 72 + (64 * wn + r) * 72 + 8 * hh;                          \
    _Pragma("unroll") for (int ks = 0; ks < 4; ++ks) {                                            \
      const bf16x8 b0 = *(const bf16x8*)(Bb + ks * 16);                                           \
      const bf16x8 b1 = *(const bf16x8*)(Bb + 32 * 72 + ks * 16);                                 \
      _Pragma("unroll") for (int i = 0; i < MI; ++i) {                                            \
        const bf16x8 a0 = *(const bf16x8*)(Ab + i * 32 * 72 + ks * 16);                           \
        acc[i][0] = mfma32(a0, b0, acc[i][0]);                                                    \
        acc[i][1] = mfma32(a0, b1, acc[i][1]);                                                    \
      }                                                                                           \
    }                                                                                             \
  }
  GEMM_LOAD(0, 0);
  GEMM_LOAD(1, 64);
  GEMM_STORE(0, 0);
  __syncthreads();
  for (int kt = 0; kt < KT; kt += 2) {
    if (kt + 2 < KT) GEMM_LOAD(0, (kt + 2) * 64);
    GEMM_COMPUTE(0);
    GEMM_STORE(1, 1);
    __syncthreads();
    if (kt + 3 < KT) GEMM_LOAD(1, (kt + 3) * 64);
    GEMM_COMPUTE(1);
    if (kt + 2 < KT) GEMM_STORE(0, 0);
    __syncthreads();
  }
#undef GEMM_COMPUTE
#undef GEMM_LOAD
#undef GEMM_STORE
}

__device__ __forceinline__ void gemm_core_lean2(f32x16 (&acc)[2][2], const u16* __restrict__ A, int lda,
                                                const u16* __restrict__ B, int K, unsigned char* smem) {
  u16* As = (u16*)smem;
  u16* Bs = (u16*)(smem + 73728);
  const int tid = opaque_tid(), lane = tid & 63, wave = tid >> 6;
  const int wm = wave >> 1, wn = wave & 1, r = lane & 31, hh = lane >> 5;
  const int lrow = tid >> 3, c8 = tid & 7;
  v4u ra[4], rb[2];
  const int KT = K >> 6;
#define GL_LOAD(k0)                                                                               \
  {                                                                                               \
    _Pragma("unroll") for (int i = 0; i < 4; ++i)                                                 \
      ra[i] = *(const v4u*)(A + (size_t)(lrow + 64 * i) * lda + (k0) + c8 * 8);                   \
    _Pragma("unroll") for (int i = 0; i < 2; ++i)                                                 \
      rb[i] = *(const v4u*)(B + (size_t)(lrow + 64 * i) * K + (k0) + c8 * 8);                     \
  }
#define GL_STORE(buf)                                                                             \
  {                                                                                               \
    _Pragma("unroll") for (int i = 0; i < 4; ++i)                                                 \
      *(v4u*)(As + (buf) * 256 * 72 + (lrow + 64 * i) * 72 + c8 * 8) = ra[i];                     \
    _Pragma("unroll") for (int i = 0; i < 2; ++i)                                                 \
      *(v4u*)(Bs + (buf) * 128 * 72 + (lrow + 64 * i) * 72 + c8 * 8) = rb[i];                     \
  }
  GL_LOAD(0);
  GL_STORE(0);
  __syncthreads();
  if (KT > 1) GL_LOAD(64);
  for (int kt = 0; kt < KT; ++kt) {
    const int cur = kt & 1;
    const u16* Ab = As + cur * 256 * 72 + (64 * wm + r) * 72 + 8 * hh;
    const u16* Bb = Bs + cur * 128 * 72 + (64 * wn + r) * 72 + 8 * hh;
#pragma unroll
    for (int ks = 0; ks < 4; ++ks) {
      __builtin_amdgcn_sched_barrier(0);
      const bf16x8 a0 = *(const bf16x8*)(Ab + ks * 16);
      const bf16x8 a1 = *(const bf16x8*)(Ab + 32 * 72 + ks * 16);
      const bf16x8 b0 = *(const bf16x8*)(Bb + ks * 16);
      const bf16x8 b1 = *(const bf16x8*)(Bb + 32 * 72 + ks * 16);
      acc[0][0] = mfma32(a0, b0, acc[0][0]);
      acc[0][1] = mfma32(a0, b1, acc[0][1]);
      acc[1][0] = mfma32(a1, b0, acc[1][0]);
      acc[1][1] = mfma32(a1, b1, acc[1][1]);
    }
    if (kt + 1 < KT) {
      GL_STORE(cur ^ 1);
      if (kt + 2 < KT) GL_LOAD((kt + 2) * 64);
    }
    __syncthreads();
  }
#undef GL_LOAD
#undef GL_STORE
}

template <int LEAN>
__device__ __forceinline__ void gemm_core256(f32x16 (&acc)[2][4], const u16* __restrict__ A, int lda,
                                             const u16* __restrict__ B, int K, unsigned char* smem) {
  u16* As = (u16*)smem;
  u16* Bs = (u16*)(smem + 73728);
  const int tid = opaque_tid(), lane = tid & 63, wave = tid >> 6;
  const int wm = wave >> 1, wn = wave & 1, r = lane & 31, hh = lane >> 5;
  const int lrow = tid >> 3, c8 = tid & 7;
  v4u ra[4], rb[4];
  const int KT = K >> 6;
#define G2_LOAD(k0)                                                                               \
  {                                                                                               \
    _Pragma("unroll") for (int i = 0; i < 4; ++i) {                                               \
      ra[i] = *(const v4u*)(A + (size_t)(lrow + 64 * i) * lda + (k0) + c8 * 8);                   \
      rb[i] = *(const v4u*)(B + (size_t)(lrow + 64 * i) * K + (k0) + c8 * 8);                     \
    }                                                                                             \
  }
#define G2_STORE(buf)                                                                             \
  {                                                                                               \
    _Pragma("unroll") for (int i = 0; i < 4; ++i) {                                               \
      *(v4u*)(As + (buf) * 256 * 72 + (lrow + 64 * i) * 72 + c8 * 8) = ra[i];                     \
      *(v4u*)(Bs + (buf) * 256 * 72 + (lrow + 64 * i) * 72 + c8 * 8) = rb[i];                     \
    }                                                                                             \
  }
  G2_LOAD(0);
  G2_STORE(0);
  __syncthreads();
  if (KT > 1) G2_LOAD(64);
  for (int kt = 0; kt < KT; ++kt) {
    const int cur = kt & 1;
    const u16* Ab = As + cur * 256 * 72 + (64 * wm + r) * 72 + 8 * hh;
    const u16* Bb = Bs + cur * 256 * 72 + (128 * wn + r) * 72 + 8 * hh;
#pragma unroll
    for (int ks = 0; ks < 4; ++ks) {
      if (LEAN) __builtin_amdgcn_sched_barrier(0);
      const bf16x8 a0 = *(const bf16x8*)(Ab + ks * 16);
      const bf16x8 a1 = *(const bf16x8*)(Ab + 32 * 72 + ks * 16);
#pragma unroll
      for (int j = 0; j < 4; ++j) {
        const bf16x8 b0 = *(const bf16x8*)(Bb + j * 32 * 72 + ks * 16);
        acc[0][j] = mfma32(a0, b0, acc[0][j]);
        acc[1][j] = mfma32(a1, b0, acc[1][j]);
      }
    }
    if (kt + 1 < KT) {
      G2_STORE(cur ^ 1);
      if (kt + 2 < KT) G2_LOAD((kt + 2) * 64);
    }
    __syncthreads();
  }
#undef G2_LOAD
#undef G2_STORE
}

namespace pg8 {
#define PG8_LAS __attribute__((address_space(3)))
typedef unsigned short bf16_t;
typedef short bf16x8 __attribute__((ext_vector_type(8)));
typedef float f32x4 __attribute__((ext_vector_type(4)));
typedef unsigned u32x4 __attribute__((ext_vector_type(4)));
constexpr int BM = 256, BK = 64, HALF = 128, HTB = HALF * BK * 2  , STAGE_BYTES = 8 * HTB, NXCD = 8, WGM = 8;

__host__ __device__ __forceinline__ int lds_byte(int r, int c) { const int st = (r >> 4) * 2 + (c >> 5), rr = r & 15, cc = c & 31, ob = rr * 64 + cc * 2; return st * 1024 + (ob ^ (((ob >> 9) & 1) << 5)); }
__host__ __device__ __forceinline__ void stage_rc(int b, int& R, int& C) { const int st = b / 1024, sb = b % 1024, swz = sb ^ (((sb >> 9) & 1) << 5); R = (st >> 1) * 16 + swz / 64; C = (st & 1) * 32 + (swz % 64) / 2; }
__host__ __device__ __forceinline__ int perm32(int rho) { const int n = rho >> 4, i = rho & 15; return 8 * (i >> 2) + 4 * n + (i & 3); }

struct Unit { int pm, pn; };
struct Gemm { const bf16_t* A; const bf16_t* Bt; int M, N, K; };

template <class Epi, class Sched, bool STAMP = false>
__device__ __forceinline__ void gemm_phase(PG8_LAS unsigned char* lds, const Gemm g, const Sched& S, const Epi& E, unsigned long long* stamps) {
    const int tid = threadIdx.x, wid = __builtin_amdgcn_readfirstlane(tid >> 6), lane = tid & 63, wr = wid >> 2, wc = wid & 3, fr = lane & 15, fq = lane >> 4;
    const int K = g.K, nt = K / BK;
    int ts_lo = 0, ts_hi = 0, nts = 0; const unsigned long long rt_entry = STAMP ? (unsigned long long)wall_clock64() : 0ull;
#define PG8_STAMP() do { if (STAMP && wid == 0 && nts < 64) { const unsigned long long _c = (unsigned long long)clock64(); \
        ts_lo = (lane == nts) ? (int)(unsigned)_c : ts_lo; ts_hi = (lane == nts) ? (int)(unsigned)(_c >> 32) : ts_hi; ++nts; } } while (0)
    PG8_STAMP();
    unsigned voffA[2], voffB[2];
#pragma unroll
    for (int i = 0; i < 2; ++i) { int R, C; stage_rc(tid * 16 + i * 8192, R, C); const int Rb = Epi::PERM ? ((R & ~31) + perm32(R & 31)) : R;
        voffA[i] = (unsigned)(R * K + C) * 2u; voffB[i] = (unsigned)(Rb * K + C) * 2u; }
    const size_t kstep = (size_t)(BK * 2);
    const size_t hstep = (size_t)HALF * K * 2;
    const size_t tstep = 2 * hstep;
    const unsigned ldsw = (unsigned)wid * 1024u;
    const int aoff = lds_byte(wr * 64 + fr, fq * 8), boff = lds_byte(wc * 32 + fr, fq * 8);
#define PG8_SA(b, h) (((b) * 2 + (h)) * HTB)
#define PG8_SB(b, h) ((4 + (b) * 2 + (h)) * HTB)
#define PG8_STAGE(bufoff, gbase, voff) do { _Pragma("unroll") for (int _i = 0; _i < 2; ++_i) \
        __builtin_amdgcn_global_load_lds((const unsigned*)((const char*)(gbase) + (voff)[_i]), (PG8_LAS unsigned*)(lds + (bufoff) + ldsw + _i * 8192), 16, 0, 0); } while (0)
#define PG8_LDA(dst, b, h) do { _Pragma("unroll") for (int m = 0; m < 4; ++m) _Pragma("unroll") for (int k = 0; k < 2; ++k) dst[m][k] = *(const PG8_LAS bf16x8*)(lds + PG8_SA(b, h) + aoff + m * 2048 + k * 1024); } while (0)
#define PG8_LDB(dst, b, h) do { _Pragma("unroll") for (int n = 0; n < 2; ++n) _Pragma("unroll") for (int k = 0; k < 2; ++k) dst[n][k] = *(const PG8_LAS bf16x8*)(lds + PG8_SB(b, h) + boff + n * 2048 + k * 1024); } while (0)
#define PG8_MMA(ai, bj, At, Bt) do { __builtin_amdgcn_s_setprio(1); _Pragma("unroll") for (int m = 0; m < 4; ++m) _Pragma("unroll") for (int n = 0; n < 2; ++n) _Pragma("unroll") for (int k = 0; k < 2; ++k) \
        acc[ai][bj][m][n] = __builtin_amdgcn_mfma_f32_16x16x32_bf16(Bt[n][k], At[m][k], acc[ai][bj][m][n], 0, 0, 0); __builtin_amdgcn_s_setprio(0); } while (0)
#define PG8_WAIT_V(n) asm volatile("s_waitcnt vmcnt(" #n ")" ::: "memory")
#define PG8_WAIT_L(n) asm volatile("s_waitcnt lgkmcnt(" #n ")" ::: "memory")
#define PG8_BAR __builtin_amdgcn_s_barrier()
#define PG8_SCHED __builtin_amdgcn_sched_barrier(0)
    Unit cur, nxt; int ui = 0;
    if (!S.next(0, cur)) return;
    f32x4 acc[2][2][4][2];
#pragma unroll
    for (int a = 0; a < 2; ++a)
#pragma unroll
        for (int b = 0; b < 2; ++b)
#pragma unroll
            for (int m = 0; m < 4; ++m)
#pragma unroll
                for (int n = 0; n < 2; ++n) acc[a][b][m][n] = (f32x4){0.f, 0.f, 0.f, 0.f};
    bf16x8 At[4][2], B0[2][2], B1[2][2];
    const char* cA = (const char*)g.A + (size_t)cur.pm * tstep; const char* cB = (const char*)g.Bt + (size_t)cur.pn * tstep;
    S.a_ready(cur);
    PG8_STAGE(PG8_SB(0, 0), cB, voffB); PG8_STAGE(PG8_SA(0, 0), cA, voffA); PG8_STAGE(PG8_SB(0, 1), cB + hstep, voffB); PG8_STAGE(PG8_SA(0, 1), cA + hstep, voffA);
    if (wr == 1) PG8_BAR;
    PG8_WAIT_V(4); PG8_BAR;
    PG8_STAGE(PG8_SB(1, 0), cB + kstep, voffB); PG8_STAGE(PG8_SA(1, 0), cA + kstep, voffA); PG8_STAGE(PG8_SB(1, 1), cB + hstep + kstep, voffB);
    PG8_WAIT_V(6); PG8_BAR;
    PG8_STAMP();
    for (;;) {
        const bool has_next = S.next(ui + 1, nxt);
        const char* nA = has_next ? (const char*)g.A + (size_t)nxt.pm * tstep : cA; const char* nB = has_next ? (const char*)g.Bt + (size_t)nxt.pn * tstep : cB;
        for (int t = 0; t < nt; t += 2) {
            const bool last = (t == nt - 2);
            const char* a1 = cA + (size_t)(t + 1) * kstep;
            const char* a2 = last ? nA : cA + (size_t)(t + 2) * kstep; const char* b2 = last ? nB : cB + (size_t)(t + 2) * kstep;
            const char* a3 = a2 + kstep; const char* b3 = b2 + kstep;
            if (last && has_next) S.a_ready(nxt);
            PG8_LDB(B0, 0, 0); PG8_SCHED; PG8_LDA(At, 0, 0); PG8_STAGE(PG8_SA(1, 1), a1 + hstep, voffA);
            PG8_WAIT_L(8); PG8_BAR; PG8_WAIT_L(0); PG8_MMA(0, 0, At, B0); PG8_BAR; PG8_SCHED;
            PG8_LDB(B1, 0, 1); PG8_STAGE(PG8_SB(0, 0), b2, voffB);
            PG8_BAR; PG8_WAIT_L(0); PG8_MMA(0, 1, At, B1); PG8_BAR;
            PG8_LDA(At, 0, 1); PG8_STAGE(PG8_SA(0, 0), a2, voffA);
            PG8_BAR; PG8_WAIT_L(0); PG8_MMA(1, 0, At, B0); PG8_BAR; PG8_SCHED;
            PG8_STAGE(PG8_SB(0, 1), b2 + hstep, voffB);
            PG8_WAIT_V(6); PG8_BAR; PG8_MMA(1, 1, At, B1); PG8_BAR;
            PG8_LDB(B0, 1, 0); PG8_SCHED; PG8_LDA(At, 1, 0); PG8_STAGE(PG8_SA(0, 1), a2 + hstep, voffA);
            PG8_WAIT_L(8); PG8_BAR; PG8_WAIT_L(0); PG8_MMA(0, 0, At, B0); PG8_BAR; PG8_SCHED;
            PG8_LDB(B1, 1, 1); PG8_STAGE(PG8_SB(1, 0), b3, voffB);
            PG8_BAR; PG8_WAIT_L(0); PG8_MMA(0, 1, At, B1); PG8_BAR;
            PG8_LDA(At, 1, 1); PG8_STAGE(PG8_SA(1, 0), a3, voffA);
            PG8_BAR; PG8_WAIT_L(0); PG8_MMA(1, 0, At, B0); PG8_BAR; PG8_SCHED;
            PG8_STAGE(PG8_SB(1, 1), b3 + hstep, voffB);
            PG8_WAIT_V(6); PG8_BAR; PG8_MMA(1, 1, At, B1); PG8_BAR;
        }
        PG8_STAMP();
        if constexpr (!Epi::AFTER_DRAIN) { E(acc, cur, wr, wc, fr, fq); S.done(cur); }
        PG8_STAMP();
        if (!has_next) break;
#pragma unroll
        for (int a = 0; a < 2; ++a)
#pragma unroll
            for (int b = 0; b < 2; ++b)
#pragma unroll
                for (int m = 0; m < 4; ++m)
#pragma unroll
                    for (int n = 0; n < 2; ++n) acc[a][b][m][n] = (f32x4){0.f, 0.f, 0.f, 0.f};
        cur = nxt; cA = nA; cB = nB; ++ui;
    }
    PG8_WAIT_V(0);
    if (wr == 0) PG8_BAR;
    PG8_BAR;
    if constexpr (Epi::AFTER_DRAIN) { E.fused(acc, cur, wr, wc, fr, fq, lds, wid, lane); S.done(cur); }
    PG8_STAMP();
    if (STAMP && wid == 0) { stamps[lane] = lane < nts ? (((unsigned long long)(unsigned)ts_hi << 32) | (unsigned)ts_lo) : 0ull;
        if (lane == 62) stamps[62] = rt_entry; if (lane == 63) stamps[63] = (unsigned long long)wall_clock64(); }
#undef PG8_STAMP
#undef PG8_SA
#undef PG8_SB
#undef PG8_STAGE
#undef PG8_LDA
#undef PG8_LDB
#undef PG8_MMA
#undef PG8_WAIT_V
#undef PG8_WAIT_L
#undef PG8_BAR
#undef PG8_SCHED
}
}

struct SegOrder {
  int seg0, seg1, slot, nb, mode;
  __device__ __forceinline__ bool next(int i, pg8::Unit& u) const {
    const int L = seg0 + slot + i * nb;
    if (L >= seg1) return false;
    if (mode == 0) {
      if (L < 1664) { const int g = L / 208, rem = L % 208; u.pn = rem >> 3; u.pm = 8 * g + (rem & 7); }
      else { const int rem = L - 1664; u.pn = rem >> 1; u.pm = 64 + (rem & 1); }
    } else if (mode == 3) {
      int j;
      if (L < 1280) { const int g = L / 160, rem = L % 160; j = rem >> 3; u.pm = 8 * g + (rem & 7); }
      else { const int rem = L - 1280; j = rem >> 1; u.pm = 64 + (rem & 1); }
      const int grp = (int)((0xCA98754310ull >> (4 * (j >> 1))) & 15ull);
      u.pn = 2 * grp + (j & 1);
    } else {
      const int per = (mode == 1) ? 96 : 32;
      const int g = L / per, rem = L % per;
      u.pn = rem >> 3; u.pm = 8 * g + (rem & 7);
    }
    return true;
  }
  __device__ __forceinline__ void a_ready(const pg8::Unit&) const {}
  __device__ __forceinline__ void done(const pg8::Unit&) const {}
};
__device__ __forceinline__ SegOrder make_order(int total, int mode) {
  SegOrder S;
  const bool xs = (gridDim.x & 7) == 0;
  const int nx = xs ? 8 : 1, xcd = xs ? (blockIdx.x & 7) : 0;
  S.nb = xs ? (gridDim.x >> 3) : gridDim.x;
  S.slot = xs ? (blockIdx.x >> 3) : blockIdx.x;
  S.seg0 = (total * xcd) / nx; S.seg1 = (total * (xcd + 1)) / nx; S.mode = mode;
  return S;
}

struct EpiS2 {
  static constexpr bool PERM = true, AFTER_DRAIN = false;
  const Params& p; const float* rope;
  __device__ __forceinline__ void operator()(const pg8::f32x4 (&acc)[2][2][4][2], const pg8::Unit& u, int wr, int wc, int fr, int fq) const {
    const int row0 = u.pm * 256;
    const bool latent = row0 < 16384;
    const int b = latent ? (row0 >> 13) : ((row0 - 16384) >> 8);
    const int keybase = latent ? (row0 & 8191) : 8192;
    const int grp = u.pn >> 1;
    const int fo0 = (u.pn & 1) * 256 + 32 * wc + 8 * fq;
    gu16* D = (gu16*)piece(p, grp);
    const gfloat* ropeg = (const gfloat*)rope;
    if (grp == P_VTA || grp == P_VTB || grp == P_VTC) {
      const int ps = perm16(fr);
#pragma unroll
      for (int ai = 0; ai < 2; ++ai)
#pragma unroll
        for (int m = 0; m < 4; ++m) {
          gu16* kp = D + (size_t)(b * 512 + fo0) * NKEY + keybase + 128 * ai + 64 * wr + 16 * m + ps;
          asm volatile("" : "+v"(kp));
#pragma unroll
          for (int bj = 0; bj < 2; ++bj)
#pragma unroll
            for (int n = 0; n < 2; ++n)
#pragma unroll
              for (int i = 0; i < 4; ++i) kp[(size_t)(128 * bj + 4 * n + i) * NKEY] = f2bf(acc[ai][bj][m][n][i]);
        }
    } else {
      const bool rot = latent && (grp == P_QA || grp == P_KA);
      const float qs = (grp == P_QA || grp == P_QC) ? 0.18033688011112042f : 1.f;
#pragma unroll
      for (int ai = 0; ai < 2; ++ai)
#pragma unroll
        for (int m = 0; m < 4; ++m) {
          const int row = row0 + 128 * ai + 64 * wr + 16 * m + fr;
          gu16* rp = D + (size_t)row * 512 + fo0;
          asm volatile("" : "+v"(rp));
          float cs[4] = {1.f, 1.f, 1.f, 1.f}, sn[4] = {0.f, 0.f, 0.f, 0.f};
          if (rot) {
            const int t = row & 8191;
            const int vv = (wc & 1) ? (t & 63) : (t >> 6);
            const v4f c01 = *(const gv4f*)(ropeg + (vv * 16 + 4 * fq) * 2);
            const v4f c23 = *(const gv4f*)(ropeg + (vv * 16 + 4 * fq) * 2 + 4);
            cs[0] = c01[0]; sn[0] = c01[1]; cs[1] = c01[2]; sn[1] = c01[3];
            cs[2] = c23[0]; sn[2] = c23[1]; cs[3] = c23[2]; sn[3] = c23[3];
          }
#pragma unroll
          for (int bj = 0; bj < 2; ++bj) {
            float o0[4], o1[4];
#pragma unroll
            for (int i = 0; i < 4; ++i) {
              const float x1 = acc[ai][bj][m][0][i], x2 = acc[ai][bj][m][1][i];
              o0[i] = (x1 * cs[i] - x2 * sn[i]) * qs;
              o1[i] = (x1 * sn[i] + x2 * cs[i]) * qs;
            }
            v4u a;
            a[0] = pk2(o0[0], o0[1]); a[1] = pk2(o0[2], o0[3]);
            a[2] = pk2(o1[0], o1[1]); a[3] = pk2(o1[2], o1[3]);
            *(GAS v4u*)(rp + 128 * bj) = a;
          }
        }
    }
  }
};

struct EpiVT {
  static constexpr bool PERM = false, AFTER_DRAIN = false;
  const Params& p;
  __device__ __forceinline__ void operator()(const pg8::f32x4 (&acc)[2][2][4][2], const pg8::Unit& u, int wr, int wc, int fr, int fq) const {
    const int grp = u.pm >> 1;
    const bool latent = u.pn < 64;
    const int b = latent ? (u.pn >> 5) : (u.pn - 64);
    const int keybase = latent ? ((u.pn & 31) * 256) : 8192;
    gu16* D = (gu16*)piece(p, grp);
    const int cq = ((fq & 1) << 1) | (fq >> 1);
#pragma unroll
    for (int ai = 0; ai < 2; ++ai)
#pragma unroll
      for (int m = 0; m < 4; ++m) {
        const int f = (u.pm & 1) * 256 + 128 * ai + 64 * wr + 16 * m + fr;
        gu16* rp = D + (size_t)(b * 512 + f) * NKEY + keybase + 32 * wc + 4 * cq;
        asm volatile("" : "+v"(rp));
#pragma unroll
        for (int bj = 0; bj < 2; ++bj)
#pragma unroll
          for (int n = 0; n < 2; ++n) {
            const pg8::f32x4 v = acc[ai][bj][m][n];
            v2u o;
            o[0] = pk2(v[0], v[1]); o[1] = pk2(v[2], v[3]);
            *(gv2u*)(rp + 128 * bj + 16 * n) = o;
          }
      }
  }
};

struct VtOrder {
  int seg0, seg1, slot, nb;
  __device__ __forceinline__ bool next(int i, pg8::Unit& u) const {
    const int L = seg0 + slot + i * nb;
    if (L >= seg1) return false;
    int j6, rt;
    if (L < 384) { const int g = L / 48, rem = L % 48; j6 = rem >> 3; rt = 8 * g + (rem & 7); }
    else { const int rem = L - 384; j6 = rem >> 1; rt = 64 + (rem & 1); }
    const int grp = (j6 >> 1) == 0 ? P_VTA : ((j6 >> 1) == 1 ? P_VTB : P_VTC);
    u.pm = 2 * grp + (j6 & 1); u.pn = rt;
    return true;
  }
  __device__ __forceinline__ void a_ready(const pg8::Unit&) const {}
  __device__ __forceinline__ void done(const pg8::Unit&) const {}
};

struct EpiS6a {
  static constexpr bool PERM = true, AFTER_DRAIN = false;
  u16* G;
  __device__ __forceinline__ void operator()(const pg8::f32x4 (&acc)[2][2][4][2], const pg8::Unit& u, int wr, int wc, int fr, int fq) const {
    gu16* Gn = (gu16*)G + (size_t)(u.pn >> 2) * R_TOT * 1024;
    const int d0 = (u.pn & 3) * 256 + 32 * wc + 8 * fq;
#pragma unroll
    for (int ai = 0; ai < 2; ++ai)
#pragma unroll
      for (int m = 0; m < 4; ++m) {
        gu16* rp = Gn + (size_t)(u.pm * 256 + 128 * ai + 64 * wr + 16 * m + fr) * 1024 + d0;
        asm volatile("" : "+v"(rp));
#pragma unroll
        for (int bj = 0; bj < 2; ++bj) {
          const pg8::f32x4 v0 = acc[ai][bj][m][0], v1 = acc[ai][bj][m][1];
          v4u o;
          o[0] = pk2(sigmoid_f(v0[0]), sigmoid_f(v0[1]));
          o[1] = pk2(sigmoid_f(v0[2]), sigmoid_f(v0[3]));
          o[2] = pk2(sigmoid_f(v1[0]), sigmoid_f(v1[1]));
          o[3] = pk2(sigmoid_f(v1[2]), sigmoid_f(v1[3]));
          *(GAS v4u*)(rp + 128 * bj) = o;
        }
      }
  }
};

struct EpiS7 {
  static constexpr bool PERM = false, AFTER_DRAIN = false;
  const float* xsrc; float* xdst; const float* gate;
  const float* mod;
  __device__ __forceinline__ void operator()(const pg8::f32x4 (&acc)[2][2][4][2], const pg8::Unit& u, int wr, int wc, int fr, int fq) const {
    const int row0 = u.pm * 256;
    const gfloat* gp = (const gfloat*)mod + which_of(row0) * 3072 + 2048 + u.pn * 256 + 32 * wc + 4 * fq;
    v4f gv[2][2];
#pragma unroll
    for (int bj = 0; bj < 2; ++bj)
#pragma unroll
      for (int n = 0; n < 2; ++n) gv[bj][n] = *(const gv4f*)(gp + 128 * bj + 16 * n);
#pragma unroll
    for (int ai = 0; ai < 2; ++ai)
#pragma unroll
      for (int m = 0; m < 4; ++m) {
        const size_t off = (size_t)(row0 + 128 * ai + 64 * wr + 16 * m + fr) * 1024 + u.pn * 256 + 32 * wc + 4 * fq;
        const gfloat* sp = (const gfloat*)xsrc + off;
        gfloat* dp = (gfloat*)xdst + off;
        asm volatile("" : "+v"(sp), "+v"(dp));
#pragma unroll
        for (int bj = 0; bj < 2; ++bj)
#pragma unroll
          for (int n = 0; n < 2; ++n) {
            const v4f xv = *(const gv4f*)(sp + 128 * bj + 16 * n);
            const pg8::f32x4 a = acc[ai][bj][m][n];
            v4f o;
#pragma unroll
            for (int i = 0; i < 4; ++i) o[i] = xv[i] + gv[bj][n][i] * a[i];
            *(gv4f*)(dp + 128 * bj + 16 * n) = o;
          }
      }
  }
};

__device__ __forceinline__ void s2_store64(const Params& p, int grp, const f32x16& a0, const f32x16& a1, int rowbase, int fb64,
                                           bool latent, int b, int keyb, int r, int hh, const float* __restrict__ rope) {
  if (grp == P_VTA || grp == P_VTB || grp == P_VTC) {
    gu16* VT = (gu16*)piece(p, grp);
#pragma unroll
    for (int j = 0; j < 2; ++j) {
      const int f = fb64 + 32 * j + r;
#pragma unroll
      for (int q = 0; q < 4; ++q) {
        const int key = keyb + 16 * (q >> 1) + 4 * (hh * 2 + (q & 1));
        v2u pk;
        if (j == 0) { pk[0] = pk2(a0[4 * q], a0[4 * q + 1]); pk[1] = pk2(a0[4 * q + 2], a0[4 * q + 3]); }
        else { pk[0] = pk2(a1[4 * q], a1[4 * q + 1]); pk[1] = pk2(a1[4 * q + 2], a1[4 * q + 3]); }
        *(gv2u*)(VT + ((size_t)(b * 512 + f)) * NKEY + key) = pk;
      }
    }
  } else {
    gu16* D = (gu16*)piece(p, grp);
    const bool rot = latent && (grp == P_QA || grp == P_KA);
    const float qs = (grp == P_QA || grp == P_QC) ? 0.18033688011112042f : 1.f;
#pragma unroll
    for (int e = 0; e < 16; ++e) {
      const int row = rowbase + (e & 3) + 8 * (e >> 2) + 4 * hh;
      float v0 = a0[e], v1 = a1[e];
      if (rot) {
        const int t = row & 8191;
        const int vv = (r < 16) ? (t >> 6) : (t & 63);
        const float cs = rope[(vv * 16 + (r & 15)) * 2], sn = rope[(vv * 16 + (r & 15)) * 2 + 1];
        const float o0 = v0 * cs - v1 * sn, o1 = v0 * sn + v1 * cs;
        v0 = o0; v1 = o1;
      }
      D[(size_t)row * 512 + fb64 + r] = f2bf(v0 * qs);
      D[(size_t)row * 512 + fb64 + 32 + r] = f2bf(v1 * qs);
    }
  }
}

__device__ __attribute__((always_inline)) void phase_s2(const Params& p, int l, unsigned char* smem) {
  const int tid = opaque_tid(), lane = tid & 63, wave = tid >> 6;
  const int wm = wave >> 1, wn = wave & 1, r = lane & 31, hh = lane >> 5;
  const u16* H = (const u16*)(p.ws + WS_H);
  const u16* WTI = (const u16*)(p.ws + WS_WT_IN);
  const float* rope = (const float*)(p.ws + WS_ROPE);
  float* G = (float*)(p.ws + WS_G);
  {
    const pg8::Gemm g{H, WTI, R_TOT, 6656, 1024};
    const SegOrder S = make_order(1320, 3);
    const EpiS2 E{p, rope};
    pg8::gemm_phase<EpiS2, SegOrder, false>((PG8_LAS unsigned char*)smem, g, S, E, nullptr);
  }
  {
    const pg8::Gemm g{WTI, H, 6656, R_TOT, 1024};
    const bool xs = (gridDim.x & 7) == 0;
    VtOrder S;
    const int nx = xs ? 8 : 1, xcd = xs ? (blockIdx.x & 7) : 0;
    S.nb = xs ? (gridDim.x >> 3) : gridDim.x;
    S.slot = xs ? (S.nb - 1 - (int)(blockIdx.x >> 3)) : blockIdx.x;
    S.seg0 = (396 * xcd) / nx; S.seg1 = (396 * (xcd + 1)) / nx;
    const EpiVT E{p};
    pg8::gemm_phase<EpiVT, VtOrder, false>((PG8_LAS unsigned char*)smem, g, S, E, nullptr);
  }
#pragma unroll 1
  for (int rt = (blockIdx.x + gridDim.x - 40) % gridDim.x; rt < 132; rt += gridDim.x) {
    const int row0 = rt * 128;
    f32x16 acc[1][2];
    acc[0][0] = zero16(); acc[0][1] = zero16();
    gemm_core<0, 1>(acc, H + (size_t)row0 * 1024, 1024, nullptr, nullptr, nullptr, nullptr, WTI + (size_t)9728 * 1024, 1024, smem);
    if (wn == 0) {
#pragma unroll
      for (int e = 0; e < 16; ++e) {
        const int row = row0 + 32 * wm + (e & 3) + 8 * (e >> 2) + 4 * hh;
        if (r < 16) G[(size_t)row * 16 + r] = acc[0][0][e];
      }
    }
  }
}

__device__ __attribute__((always_inline)) void attn_item(const Params& p, int l, int b, int h, int qgrow0, int kt0, int kt1, unsigned char* smem) {
  u16* Ks = (u16*)smem;
  u16* Vs = (u16*)(smem + 34816);
  const int tid = opaque_tid(), lane = tid & 63, wave = tid >> 6;
  const int c = wave & 1, qg = wave >> 1, r = lane & 31, hh = lane >> 5;
  u16* QA = piece(p, P_QA);
  const u16* KA = piece(p, P_KA);
  const u16* VT = piece(p, P_VTA);
  const u16* ZA = piece(p, P_ZA);
  const float lam_init = 0.8f - 0.6f * expf(-0.3f * (float)l);
  float lam;
  {
    const float* lq = p.lam_q + l * 128;
    const float* lk = p.lam_k + l * 128;
    const float s0 = wave_sum(lq[lane] * lk[lane]);
    const float s1 = wave_sum(lq[64 + lane] * lk[64 + lane]);
    lam = expf(s0) - expf(s1) + lam_init;
  }
  const int qrow = qgrow0 + qg * 32 + r;
  bf16x8 qf[4];
#pragma unroll
  for (int ks = 0; ks < 4; ++ks) qf[ks] = *(const bf16x8*)(QA + (size_t)qrow * 512 + h * 128 + c * 64 + ks * 16 + hh * 8);
  f32x16 O[4];
#pragma unroll
  for (int i = 0; i < 4; ++i) O[i] = zero16();
  float m = -1e30f, lsum = 0.f;
  const int krow_l = tid >> 4, kc16 = tid & 15;
  const int vrow_l = tid >> 3, vc8 = tid & 7;
  v4u rk[2], rv[2];
#define ATT_LOADK(kt)                                                                             \
  {                                                                                               \
    const int key0 = (kt) * 64;                                                                   \
    const int gbase = (key0 < 8192) ? (b * 8192 + key0) : (16384 + b * 256 + key0 - 8192);        \
    _Pragma("unroll") for (int i = 0; i < 2; ++i)                                                 \
      rk[i] = *(const v4u*)(KA + (size_t)(gbase + krow_l + 32 * i) * 512 + h * 128 + kc16 * 8);   \
  }
#define ATT_LOADV(kt)                                                                             \
  {                                                                                               \
    const int key0 = (kt) * 64;                                                                   \
    _Pragma("unroll") for (int i = 0; i < 2; ++i)                                                 \
      rv[i] = *(const v4u*)(VT + ((size_t)(b * 512 + h * 128 + vrow_l + 64 * i)) * NKEY + key0 + vc8 * 8); \
  }
#define ATT_STOREK(buf)                                                                           \
  {                                                                                               \
    _Pragma("unroll") for (int i = 0; i < 2; ++i)                                                 \
      *(v4u*)(Ks + (buf) * 64 * 136 + (krow_l + 32 * i) * 136 + kc16 * 8) = rk[i];                \
  }
#define ATT_STOREV(buf)                                                                           \
  {                                                                                               \
    _Pragma("unroll") for (int i = 0; i < 2; ++i)                                                 \
      *(v4u*)(Vs + (buf) * 128 * 72 + (vrow_l + 64 * i) * 72 + vc8 * 8) = rv[i];                  \
  }
#define ATT_QK(Sx, buf)                                                                           \
  {                                                                                               \
    _Pragma("unroll") for (int kk = 0; kk < 2; ++kk) {                                            \
      Sx[kk] = zero16();                                                                          \
      _Pragma("unroll") for (int ks = 0; ks < 4; ++ks) {                                          \
        const bf16x8 kf = *(const bf16x8*)(Ks + (buf) * 64 * 136 + (32 * kk + r) * 136 + c * 64 + ks * 16 + hh * 8); \
        Sx[kk] = mfma32(kf, qf[ks], Sx[kk]);                                                      \
      }                                                                                           \
    }                                                                                             \
  }
  ATT_LOADK(kt0);
  ATT_LOADV(kt0);
  ATT_STOREK(0);
  ATT_STOREV(0);
  if (kt0 + 1 < kt1) { ATT_LOADK(kt0 + 1); ATT_STOREK(1); }
  __syncthreads();
  f32x16 S[2], Sn[2];
  ATT_QK(S, 0);
  if (kt0 + 2 < kt1) ATT_LOADK(kt0 + 2);
  if (kt0 + 1 < kt1) ATT_LOADV(kt0 + 1);
  for (int kt = kt0; kt < kt1; ++kt) {
    const int cur = (kt - kt0) & 1;
    if (kt + 1 < kt1) ATT_QK(Sn, cur ^ 1);
    float mx = -1e30f;
#pragma unroll
    for (int kk = 0; kk < 2; ++kk)
#pragma unroll
      for (int e = 0; e < 16; ++e) mx = fmaxf(mx, S[kk][e]);
    mx = fmaxf(mx, __shfl_xor(mx, 32, 64));
    const float mnew = fmaxf(m, mx);
    if (__builtin_amdgcn_ballot_w64(mnew > m) != 0ull) {
      const float alpha = ex2(m - mnew);
      lsum *= alpha;
#pragma unroll
      for (int i = 0; i < 4; ++i)
#pragma unroll
        for (int e = 0; e < 16; ++e) O[i][e] *= alpha;
    }
    m = mnew;
    bf16x8 pf[4];
#pragma unroll
    for (int kk = 0; kk < 2; ++kk)
#pragma unroll
      for (int s2 = 0; s2 < 2; ++s2) {
        v4u pkd;
#pragma unroll
        for (int jj = 0; jj < 4; ++jj) {
          const float p0 = ex2(S[kk][8 * s2 + 2 * jj] - mnew);
          const float p1 = ex2(S[kk][8 * s2 + 2 * jj + 1] - mnew);
          lsum += p0 + p1;
          pkd[jj] = pk2(p0, p1);
        }
        pf[2 * kk + s2] = (bf16x8)pkd;
      }
#pragma unroll
    for (int dvt = 0; dvt < 4; ++dvt)
#pragma unroll
      for (int s = 0; s < 4; ++s) {
        const bf16x8 vf = *(const bf16x8*)(Vs + cur * 128 * 72 + (32 * dvt + r) * 72 + 16 * s + 8 * hh);
        O[dvt] = mfma32(vf, pf[s], O[dvt]);
      }
    if (kt + 2 < kt1) ATT_STOREK(cur);
    if (kt + 1 < kt1) ATT_STOREV(cur ^ 1);
    if (kt + 3 < kt1) ATT_LOADK(kt + 3);
    if (kt + 2 < kt1) ATT_LOADV(kt + 2);
    __syncthreads();
    S[0] = Sn[0];
    S[1] = Sn[1];
  }
#undef ATT_LOADK
#undef ATT_LOADV
#undef ATT_STOREK
#undef ATT_STOREV
#undef ATT_QK
  const float ltot = lsum + __shfl_xor(lsum, 32, 64);
  const float inv = 1.f / ltot;
  float* X = (float*)smem;
  if (c == 1) {
#pragma unroll
    for (int dvt = 0; dvt < 4; ++dvt)
#pragma unroll
      for (int e = 0; e < 16; ++e) X[(qg * 128 + 32 * dvt + (e & 3) + 8 * (e >> 2) + 4 * hh) * 32 + r] = O[dvt][e] * inv;
  }
  __syncthreads();
  if (c == 0) {
    float ss = 0.f;
#pragma unroll
    for (int dvt = 0; dvt < 4; ++dvt)
#pragma unroll
      for (int e = 0; e < 16; ++e) {
        const float o = O[dvt][e] * inv - lam * X[(qg * 128 + 32 * dvt + (e & 3) + 8 * (e >> 2) + 4 * hh) * 32 + r];
        O[dvt][e] = o;
        ss += o * o;
      }
    ss += __shfl_xor(ss, 32, 64);
    const float rinv = rsqrtf(ss * (1.f / 128.f) + 1e-6f) * (1.f - lam_init);
    const float* dg = p.da_g + l * 128;
#pragma unroll
    for (int dvt = 0; dvt < 4; ++dvt)
#pragma unroll
      for (int g = 0; g < 4; ++g) {
        const int dv0 = 32 * dvt + 8 * g + 4 * hh;
        const size_t off = (size_t)qrow * 512 + h * 128 + dv0;
        const v2u z = *(const v2u*)(ZA + off);
        const float y0 = O[dvt][4 * g] * rinv * dg[dv0] * silu_f(bflo(z[0]));
        const float y1 = O[dvt][4 * g + 1] * rinv * dg[dv0 + 1] * silu_f(bfhi(z[0]));
        const float y2 = O[dvt][4 * g + 2] * rinv * dg[dv0 + 2] * silu_f(bflo(z[1]));
        const float y3 = O[dvt][4 * g + 3] * rinv * dg[dv0 + 3] * silu_f(bfhi(z[1]));
        v2u o;
        o[0] = pk2(y0, y1);
        o[1] = pk2(y2, y3);
        *(v2u*)(QA + off) = o;
      }
  }
  __syncthreads();
}

__device__ __attribute__((always_inline)) void natten_item(const Params& p, int l, int b, int rr, int qgrow, int i0, unsigned char* smem) {
  float* rp = (float*)smem;
  const int tid = opaque_tid(), lane = tid & 63, head = tid >> 6;
  const int r = lane & 31, hh = lane >> 5;
  for (int i = tid; i < 3720; i += NTHR) rp[i] = p.rpb[(size_t)l * 3720 + i];
  __syncthreads();
  u16* QC = piece(p, P_QC);
  const u16* KC = piece(p, P_KC);
  const u16* VT = piece(p, P_VTC);
  const u16* ZC = piece(p, P_ZC);
  const int rs = min(max(rr - 4, 0), 120);
  bf16x8 qf[2][4];
#pragma unroll
  for (int qt = 0; qt < 2; ++qt)
#pragma unroll
    for (int ks = 0; ks < 4; ++ks)
      qf[qt][ks] = *(const bf16x8*)(QC + (size_t)(qgrow + 32 * qt + r) * 512 + head * 64 + ks * 16 + hh * 8);
  f32x16 O[2][2];
  O[0][0] = zero16(); O[0][1] = zero16(); O[1][0] = zero16(); O[1][1] = zero16();
  float m[2] = {-1e30f, -1e30f}, lsum[2] = {0.f, 0.f};
  const float L2E = 1.4426950408889634f;
  bf16x8 kfn[2][4];
  {
    const int kgp = (i0 < 8) ? (b * 8192 + (rs + i0) * 64) : (16384 + b * 256 + (i0 - 8) * 64);
#pragma unroll
    for (int kk = 0; kk < 2; ++kk)
#pragma unroll
      for (int ks = 0; ks < 4; ++ks)
        kfn[kk][ks] = *(const bf16x8*)(KC + (size_t)(kgp + 32 * kk + r) * 512 + head * 64 + ks * 16 + hh * 8);
  }
#pragma unroll 1
  for (int i = i0; i < 12; ++i) {
    const bool local = i < 8;
    const int krow = rs + i;
    const int key0 = local ? krow * 64 : 8192 + (i - 8) * 64;
    bf16x8 kfc[2][4];
#pragma unroll
    for (int kk = 0; kk < 2; ++kk)
#pragma unroll
      for (int ks = 0; ks < 4; ++ks) kfc[kk][ks] = kfn[kk][ks];
    if (i + 1 < 12) {
      const int kg1 = (i + 1 < 8) ? (b * 8192 + (krow + 1) * 64) : (16384 + b * 256 + (i - 7) * 64);
#pragma unroll
      for (int kk = 0; kk < 2; ++kk)
#pragma unroll
        for (int ks = 0; ks < 4; ++ks)
          kfn[kk][ks] = *(const bf16x8*)(KC + (size_t)(kg1 + 32 * kk + r) * 512 + head * 64 + ks * 16 + hh * 8);
    }
    f32x16 S[2][2];
    S[0][0] = zero16(); S[0][1] = zero16(); S[1][0] = zero16(); S[1][1] = zero16();
#pragma unroll
    for (int kk = 0; kk < 2; ++kk)
#pragma unroll
      for (int ks = 0; ks < 4; ++ks) {
        S[kk][0] = mfma32(kfc[kk][ks], qf[0][ks], S[kk][0]);
        S[kk][1] = mfma32(kfc[kk][ks], qf[1][ks], S[kk][1]);
      }
    bf16x8 pf[2][4];
#pragma unroll
    for (int qt = 0; qt < 2; ++qt) {
      const int qcol = 32 * qt + r;
      const int cs = min(max(qcol - 8, 0), 48);
      const float* rprow = rp + (head * 15 + (local ? (krow - rr + 7) : 0)) * 31 + 15 - qcol;
      float mx = -1e30f;
#pragma unroll
      for (int kk = 0; kk < 2; ++kk)
#pragma unroll
        for (int e = 0; e < 16; ++e) {
          const int kcol = 32 * kk + (e & 3) + 8 * (e >> 2) + 4 * hh;
          float s = S[kk][qt][e];
          if (local) {
            const bool valid = (kcol >= cs) && (kcol < cs + 16);
            const int ci = min(max(kcol, cs), cs + 15);
            s = valid ? (s + rprow[ci] * L2E) : -1e30f;
          }
          S[kk][qt][e] = s;
          mx = fmaxf(mx, s);
        }
      mx = fmaxf(mx, __shfl_xor(mx, 32, 64));
      const float mnew = fmaxf(m[qt], mx);
      if (__builtin_amdgcn_ballot_w64(mnew > m[qt]) != 0ull) {
        const float alpha = ex2(m[qt] - mnew);
        lsum[qt] *= alpha;
#pragma unroll
        for (int dvt = 0; dvt < 2; ++dvt)
#pragma unroll
          for (int e = 0; e < 16; ++e) O[dvt][qt][e] *= alpha;
      }
      m[qt] = mnew;
#pragma unroll
      for (int kk = 0; kk < 2; ++kk)
#pragma unroll
        for (int s2 = 0; s2 < 2; ++s2) {
          v4u pkd;
#pragma unroll
          for (int jj = 0; jj < 4; ++jj) {
            const float p0 = ex2(S[kk][qt][8 * s2 + 2 * jj] - mnew);
            const float p1 = ex2(S[kk][qt][8 * s2 + 2 * jj + 1] - mnew);
            lsum[qt] += p0 + p1;
            pkd[jj] = pk2(p0, p1);
          }
          pf[qt][2 * kk + s2] = (bf16x8)pkd;
        }
    }
#pragma unroll
    for (int dvt = 0; dvt < 2; ++dvt)
#pragma unroll
      for (int s = 0; s < 4; ++s) {
        const bf16x8 vf = *(const bf16x8*)(VT + ((size_t)(b * 512 + head * 64 + 32 * dvt + r)) * NKEY + key0 + 16 * s + 8 * hh);
        O[dvt][0] = mfma32(vf, pf[0][s], O[dvt][0]);
        O[dvt][1] = mfma32(vf, pf[1][s], O[dvt][1]);
      }
  }
#pragma unroll
  for (int qt = 0; qt < 2; ++qt) {
    const float inv = 1.f / (lsum[qt] + __shfl_xor(lsum[qt], 32, 64));
    const int qrow = qgrow + 32 * qt + r;
#pragma unroll
    for (int dvt = 0; dvt < 2; ++dvt)
#pragma unroll
      for (int g = 0; g < 4; ++g) {
        const int dv0 = 32 * dvt + 8 * g + 4 * hh;
        const size_t off = (size_t)qrow * 512 + head * 64 + dv0;
        const v2u z = *(const v2u*)(ZC + off);
        v2u o;
        o[0] = pk2(O[dvt][qt][4 * g] * inv * silu_f(bflo(z[0])), O[dvt][qt][4 * g + 1] * inv * silu_f(bfhi(z[0])));
        o[1] = pk2(O[dvt][qt][4 * g + 2] * inv * silu_f(bflo(z[1])), O[dvt][qt][4 * g + 3] * inv * silu_f(bfhi(z[1])));
        *(v2u*)(QC + off) = o;
      }
  }
  __syncthreads();
}

__device__ __forceinline__ float logsigmoid_f(float x) { return fminf(x, 0.f) - log1pf(__expf(-fabsf(x))); }
__device__ __forceinline__ int chunk_grow0(int b, int P) { return P < 2 ? 16384 + b * 256 + 128 * P : b * 8192 + 128 * (P - 2); }
__device__ __forceinline__ int chunk_key0(int P) { return P < 2 ? 8192 + 128 * P : 128 * (P - 2); }

__device__ __forceinline__ void mlstm_gates(const Params& p, int l, int head, int grow0, float* lf, float* li) {
  const int tid = opaque_tid();
  if (tid < 256) {
    const int d = tid >> 7, s = tid & 127;
    const float* G = (const float*)(p.ws + WS_G) + (size_t)(grow0 + s) * 16;
    const float gi = G[d * 8 + head] + p.gate_b[l * 16 + d * 8 + head];
    const float gf = G[d * 8 + 4 + head] + p.gate_b[l * 16 + d * 8 + 4 + head];
    li[d * 128 + s] = gi;
    lf[d * 128 + s] = logsigmoid_f(gf);
  }
}

__device__ __forceinline__ void conv8(const Params& p, int l, const u16* src, int grow, int fcol, int ch0, bool hasprev,
                                      bool hasnext, float scale, float (&o)[8]) {
  const v4u zero = {0u, 0u, 0u, 0u};
  const v4u xm = hasprev ? *(const v4u*)(src + (size_t)(grow - 1) * 512 + fcol) : zero;
  const v4u x0 = *(const v4u*)(src + (size_t)grow * 512 + fcol);
  const v4u xp = hasnext ? *(const v4u*)(src + (size_t)(grow + 1) * 512 + fcol) : zero;
  const float* cw = p.conv_w + (size_t)l * 3 * 1024 + ch0;
  const float* cb = p.conv_b + (size_t)l * 1024 + ch0;
#pragma unroll
  for (int e = 0; e < 8; ++e) {
    const float a = (e & 1) ? bfhi(xm[e >> 1]) : bflo(xm[e >> 1]);
    const float bq = (e & 1) ? bfhi(x0[e >> 1]) : bflo(x0[e >> 1]);
    const float cq = (e & 1) ? bfhi(xp[e >> 1]) : bflo(xp[e >> 1]);
    const float y = a * cw[e] + bq * cw[1024 + e] + cq * cw[2048 + e] + cb[e];
    o[e] = silu_f(y) * scale;
  }
}

__device__ __attribute__((always_inline)) void mlstm_b1_item(const Params& p, int l, int b, int head, int P, unsigned char* smem) {
  u16* kwT = (u16*)smem;
  float* lf = (float*)(smem + 69632);
  float* li = lf + 256;
  float* wS = li + 256;
  const int tid = opaque_tid(), lane = tid & 63, wave = tid >> 6;
  const int r = lane & 31, hh = lane >> 5;
  const int grow0 = chunk_grow0(b, P), key0 = chunk_key0(P);
  float* BL = (float*)(p.ws + WS_BL);
  float* DN = (float*)(p.ws + WS_DN);
  u16* CST = (u16*)(p.ws + WS_H);
  bf16x8 vf[8];
  {
    const int dvt0 = wave & 3;
    const u16* VT0 = piece(p, P_VTB);
#pragma unroll
    for (int s8 = 0; s8 < 8; ++s8)
      vf[s8] = *(const bf16x8*)(VT0 + ((size_t)(b * 512 + head * 128 + 32 * dvt0 + r)) * NKEY + key0 + 16 * s8 + 8 * hh);
  }
  mlstm_gates(p, l, head, grow0, lf, li);
  __syncthreads();
  if (tid < 256) {
    const int d = tid >> 7, s = tid & 127;
    float tot = 0.f, bs = 0.f;
    for (int j = 0; j < 128; ++j) {
      const float v = lf[d * 128 + j];
      tot += v;
      if (d == 0 ? (j <= s) : (j >= s)) bs += v;
    }
    wS[d * 128 + s] = __expf(tot - bs + li[d * 128 + s]);
    if (s == 0) BL[((b * 4 + head) * 2 + d) * 66 + P] = tot;
  }
  __syncthreads();
  const u16* KB = piece(p, P_KB);
#pragma unroll 1
  for (int i = 0; i < 4; ++i) {
    const int u = tid + NTHR * i;
    const int s = u >> 4, dg = u & 15;
    const bool hasprev = !((P == 0 || P == 2) && s == 0);
    const bool hasnext = !((P == 1 || P == 65) && s == 127);
    float kc[8];
    conv8(p, l, KB, grow0 + s, head * 128 + dg * 8, 512 + head * 128 + dg * 8, hasprev, hasnext, 0.08838834764831845f, kc);
    const int ps = perm16(s);
    const float w0 = wS[s], w1 = wS[128 + s];
#pragma unroll
    for (int e = 0; e < 8; ++e) {
      kwT[(dg * 8 + e) * 136 + ps] = f2bf(kc[e] * w0);
      kwT[(128 + dg * 8 + e) * 136 + ps] = f2bf(kc[e] * w1);
    }
  }
  __syncthreads();
  {
    const int d = wave >> 2, dvt = wave & 3;
    const int chain = (b * 4 + head) * 2 + d;
    u16* dst = CST + ((size_t)(chain * 66 + P)) * 16384;
#pragma unroll
    for (int dkt = 0; dkt < 4; ++dkt) {
      f32x16 acc = zero16();
#pragma unroll
      for (int s8 = 0; s8 < 8; ++s8) {
        const bf16x8 kf = *(const bf16x8*)(kwT + (d * 128 + 32 * dkt + r) * 136 + 16 * s8 + 8 * hh);
        acc = mfma32(vf[s8], kf, acc);
      }
#pragma unroll
      for (int e = 0; e < 16; ++e) {
        const int dv = 32 * dvt + (e & 3) + 8 * (e >> 2) + 4 * hh;
        dst[dv * 128 + 32 * dkt + r] = f2bf(acc[e]);
      }
    }
  }
  if (tid < 256) {
    const int d = tid >> 7, dk = tid & 127;
    float s = 0.f;
    for (int j = 0; j < 128; ++j) s += bf2f(kwT[(d * 128 + dk) * 136 + j]);
    DN[(((b * 4 + head) * 2 + d) * 66 + P) * 128 + dk] = s;
  }
  __syncthreads();
}

__device__ __attribute__((always_inline)) void phase_b2(const Params& p) {
  const int gid = blockIdx.x * NTHR + threadIdx.x;
  const float* BL = (const float*)(p.ws + WS_BL);
  if (gid < 131072) {
    const int chain = gid >> 13, e2 = gid & 8191;
    const int d = chain & 1;
    unsigned* base = (unsigned*)(p.ws + WS_H) + (size_t)chain * 66 * 8192 + e2;
    float c0 = 0.f, c1 = 0.f;
    for (int i0 = 0; i0 < 66; i0 += 11) {
      unsigned v[11];
      float a[11];
#pragma unroll
      for (int j = 0; j < 11; ++j) {
        const int i = i0 + j;
        const int P = d == 0 ? i : (i < 2 ? 1 - i : 67 - i);
        v[j] = base[(size_t)P * 8192];
        a[j] = __expf(BL[chain * 66 + P]);
      }
#pragma unroll
      for (int j = 0; j < 11; ++j) {
        const int i = i0 + j;
        const int P = d == 0 ? i : (i < 2 ? 1 - i : 67 - i);
        base[(size_t)P * 8192] = pk2(c0, c1);
        c0 = a[j] * c0 + bflo(v[j]);
        c1 = a[j] * c1 + bfhi(v[j]);
      }
    }
  }
  if (gid < 2048) {
    const int chain = gid >> 7, dk = gid & 127;
    const int d = chain & 1;
    const float* DN = (const float*)(p.ws + WS_DN);
    float* NP = (float*)(p.ws + WS_NPREV);
    float run = 0.f;
    for (int i = 0; i < 66; ++i) {
      const int P = d == 0 ? i : (i < 2 ? 1 - i : 67 - i);
      NP[(chain * 66 + P) * 128 + dk] = run;
      run = __expf(BL[chain * 66 + P]) * run + DN[(chain * 66 + P) * 128 + dk];
    }
  }
}

__device__ __attribute__((always_inline)) void mlstm_b3_item(const Params& p, int l, int b, int head, int P, unsigned char* smem) {
  u16* qS = (u16*)smem;
  u16* kS = (u16*)(smem + 34816);
  u16* pS = (u16*)(smem + 69632);
  float* fb = (float*)(smem + 104448);
  float* lf = fb;
  float* li = fb + 256;
  float* bc = fb + 512;
  float* colsum = fb + 768;
  float* nS = fb + 1280;
  float* nq = fb + 1536;
  float* cfs = fb + 1792;
  float* hsq = fb + 2048;
  const int tid = opaque_tid(), lane = tid & 63, wave = tid >> 6;
  const int r = lane & 31, hh = lane >> 5;
  const int grow0 = chunk_grow0(b, P), key0 = chunk_key0(P);
  const int chainF = (b * 4 + head) * 2, chainB = chainF + 1;
  mlstm_gates(p, l, head, grow0, lf, li);
  __syncthreads();
  if (tid < 256) {
    const int d = tid >> 7, s = tid & 127;
    float bs = 0.f;
    for (int j = 0; j < 128; ++j) {
      const float v = lf[d * 128 + j];
      if (d == 0 ? (j <= s) : (j >= s)) bs += v;
    }
    bc[d * 128 + s] = bs;
    nS[d * 128 + s] = ((const float*)(p.ws + WS_NPREV))[((chainF + d) * 66 + P) * 128 + s];
  }
  {
    const u16* QB = piece(p, P_QB);
    const u16* KB = piece(p, P_KB);
#pragma unroll 1
    for (int i = 0; i < 4; ++i) {
      const int u = tid + NTHR * i;
      const int s = u >> 4, dg = u & 15;
      const bool hasprev = !((P == 0 || P == 2) && s == 0);
      const bool hasnext = !((P == 1 || P == 65) && s == 127);
      float o[8];
      conv8(p, l, QB, grow0 + s, head * 128 + dg * 8, head * 128 + dg * 8, hasprev, hasnext, 1.f, o);
      v4u pk;
      pk[0] = pk2(o[0], o[1]); pk[1] = pk2(o[2], o[3]); pk[2] = pk2(o[4], o[5]); pk[3] = pk2(o[6], o[7]);
      *(v4u*)(qS + s * 136 + dg * 8) = pk;
      conv8(p, l, KB, grow0 + s, head * 128 + dg * 8, 512 + head * 128 + dg * 8, hasprev, hasnext, 0.08838834764831845f, o);
      pk[0] = pk2(o[0], o[1]); pk[1] = pk2(o[2], o[3]); pk[2] = pk2(o[4], o[5]); pk[3] = pk2(o[6], o[7]);
      *(v4u*)(kS + s * 136 + dg * 8) = pk;
    }
  }
  __syncthreads();
  if (tid < 256) {
    const int d = tid >> 7, t = tid & 127;
    float s = 0.f;
    for (int k = 0; k < 128; ++k) s += nS[d * 128 + k] * bf2f(qS[t * 136 + k]);
    nq[d * 128 + t] = s;
  }
  bf16x8 vfh[8];
  {
    const u16* VT0 = piece(p, P_VTB);
#pragma unroll
    for (int s8 = 0; s8 < 8; ++s8)
      vfh[s8] = *(const bf16x8*)(VT0 + ((size_t)(b * 512 + head * 128 + 32 * (wave & 3) + r)) * NKEY + key0 + 16 * s8 + 8 * hh);
  }
  f32x16 Pf[2], Pb[2];
  {
    const int tt = wave & 3, sh = wave >> 2;
    const int t = 32 * tt + r;
    bf16x8 qf[8];
#pragma unroll
    for (int ks = 0; ks < 8; ++ks) qf[ks] = *(const bf16x8*)(qS + t * 136 + 16 * ks + 8 * hh);
    const float bFt = bc[t], bBt = bc[128 + t];
    float csf = 0.f, csb = 0.f;
#pragma unroll
    for (int st2 = 0; st2 < 2; ++st2) {
      const int stile = 2 * sh + st2;
      f32x16 S = zero16();
#pragma unroll
      for (int ks = 0; ks < 8; ++ks) {
        const bf16x8 kf = *(const bf16x8*)(kS + (32 * stile + r) * 136 + 16 * ks + 8 * hh);
        S = mfma32(kf, qf[ks], S);
      }
#pragma unroll
      for (int e = 0; e < 16; ++e) {
        const int s = 32 * stile + (e & 3) + 8 * (e >> 2) + 4 * hh;
        const float raw = S[e];
        const float pf_ = (s <= t) ? raw * __expf(bFt - bc[s] + li[s]) : 0.f;
        const float pb_ = (s >= t) ? raw * __expf(bBt - bc[128 + s] + li[128 + s]) : 0.f;
        Pf[st2][e] = pf_;
        Pb[st2][e] = pb_;
        csf += pf_;
        csb += pb_;
      }
    }
    csf += __shfl_xor(csf, 32, 64);
    csb += __shfl_xor(csb, 32, 64);
    if (hh == 0) {
      colsum[(0 * 2 + sh) * 128 + t] = csf;
      colsum[(1 * 2 + sh) * 128 + t] = csb;
    }
  }
  bf16x8 cFh[8], cBh[8];
  {
    const u16* CST0 = (const u16*)(p.ws + WS_H);
    const u16* cF0 = CST0 + ((size_t)(chainF * 66 + P)) * 16384 + (32 * (wave & 3) + r) * 128 + 8 * hh;
    const u16* cB0 = CST0 + ((size_t)(chainB * 66 + P)) * 16384 + (32 * (wave & 3) + r) * 128 + 8 * hh;
#pragma unroll
    for (int ks = 0; ks < 8; ++ks) { cFh[ks] = *(const bf16x8*)(cF0 + 16 * ks); cBh[ks] = *(const bf16x8*)(cB0 + 16 * ks); }
  }
  __syncthreads();
  {
    const int tt = wave & 3, sh = wave >> 2;
    const int t = 32 * tt + r;
    const float eF = __expf(bc[t]), eB = __expf(bc[128 + t]);
    const float denF = eF * nq[t] + colsum[0 * 128 + t] + colsum[1 * 128 + t];
    const float denB = eB * nq[128 + t] + colsum[2 * 128 + t] + colsum[3 * 128 + t];
    const float invF = 1.f / fmaxf(fabsf(denF), 1.f);
    const float invB = 1.f / fmaxf(fabsf(denB), 1.f);
    if (sh == 0 && hh == 0) {
      cfs[t] = eF * invF;
      cfs[128 + t] = eB * invB;
    }
#pragma unroll
    for (int st2 = 0; st2 < 2; ++st2) {
      const int stile = 2 * sh + st2;
#pragma unroll
      for (int g = 0; g < 4; ++g) {
        v2u pk;
        pk[0] = pk2(Pf[st2][4 * g] * invF + Pb[st2][4 * g] * invB, Pf[st2][4 * g + 1] * invF + Pb[st2][4 * g + 1] * invB);
        pk[1] = pk2(Pf[st2][4 * g + 2] * invF + Pb[st2][4 * g + 2] * invB, Pf[st2][4 * g + 3] * invF + Pb[st2][4 * g + 3] * invB);
        const int pos = 32 * stile + 16 * (g >> 1) + 4 * (hh * 2 + (g & 1));
        *(v2u*)(pS + t * 136 + pos) = pk;
      }
    }
  }
  __syncthreads();
  const int dvt = wave & 3, tp = wave >> 2;
  f32x16 hacc[2];
  {
    const u16* VT = piece(p, P_VTB);
    const u16* CST = (const u16*)(p.ws + WS_H);
    f32x16 aP[2], aF[2], aB[2];
#pragma unroll
    for (int t2 = 0; t2 < 2; ++t2) { aP[t2] = zero16(); aF[t2] = zero16(); aB[t2] = zero16(); }
#pragma unroll
    for (int s8 = 0; s8 < 8; ++s8) {
      const bf16x8 vf = vfh[s8];
#pragma unroll
      for (int t2 = 0; t2 < 2; ++t2) {
        const bf16x8 pf_ = *(const bf16x8*)(pS + (32 * (2 * tp + t2) + r) * 136 + 16 * s8 + 8 * hh);
        aP[t2] = mfma32(vf, pf_, aP[t2]);
      }
    }
    const u16* cF = CST + ((size_t)(chainF * 66 + P)) * 16384 + (32 * dvt + r) * 128 + 8 * hh;
    const u16* cB = CST + ((size_t)(chainB * 66 + P)) * 16384 + (32 * dvt + r) * 128 + 8 * hh;
#pragma unroll
    for (int ks = 0; ks < 8; ++ks) {
      const bf16x8 f1 = cFh[ks];
      const bf16x8 f2 = cBh[ks];
#pragma unroll
      for (int t2 = 0; t2 < 2; ++t2) {
        const bf16x8 qf = *(const bf16x8*)(qS + (32 * (2 * tp + t2) + r) * 136 + 16 * ks + 8 * hh);
        aF[t2] = mfma32(f1, qf, aF[t2]);
        aB[t2] = mfma32(f2, qf, aB[t2]);
      }
    }
#pragma unroll
    for (int t2 = 0; t2 < 2; ++t2) {
      const int t = 32 * (2 * tp + t2) + r;
      const float cf = cfs[t], cb = cfs[128 + t];
      float ss = 0.f;
#pragma unroll
      for (int e = 0; e < 16; ++e) {
        const float hv = aP[t2][e] + cf * aF[t2][e] + cb * aB[t2][e];
        hacc[t2][e] = hv;
        ss += hv * hv;
      }
      ss += __shfl_xor(ss, 32, 64);
      if (hh == 0) hsq[dvt * 128 + t] = ss;
    }
  }
  __syncthreads();
  {
    u16* OB = piece(p, P_OB);
    const u16* ZB = piece(p, P_ZB);
    const float* mg = p.ml_g + l * 128;
#pragma unroll
    for (int t2 = 0; t2 < 2; ++t2) {
      const int t = 32 * (2 * tp + t2) + r;
      const float rinv = rsqrtf((hsq[t] + hsq[128 + t] + hsq[256 + t] + hsq[384 + t]) * (1.f / 128.f) + 1e-6f);
#pragma unroll
      for (int g = 0; g < 4; ++g) {
        const int dv0 = 32 * dvt + 8 * g + 4 * hh;
        const size_t off = (size_t)(grow0 + t) * 512 + head * 128 + dv0;
        const v2u ov = *(const v2u*)(OB + off);
        const v2u zv = *(const v2u*)(ZB + off);
        const float y0 = sigmoid_f(bflo(ov[0])) * hacc[t2][4 * g] * rinv * mg[dv0] * silu_f(bflo(zv[0]));
        const float y1 = sigmoid_f(bfhi(ov[0])) * hacc[t2][4 * g + 1] * rinv * mg[dv0 + 1] * silu_f(bfhi(zv[0]));
        const float y2 = sigmoid_f(bflo(ov[1])) * hacc[t2][4 * g + 2] * rinv * mg[dv0 + 2] * silu_f(bflo(zv[1]));
        const float y3 = sigmoid_f(bfhi(ov[1])) * hacc[t2][4 * g + 3] * rinv * mg[dv0 + 3] * silu_f(bfhi(zv[1]));
        v2u o;
        o[0] = pk2(y0, y1);
        o[1] = pk2(y2, y3);
        *(v2u*)(OB + off) = o;
      }
    }
  }
  __syncthreads();
}

__device__ __attribute__((always_inline)) void phase_s3(const Params& p, int l, unsigned char* smem) {
  const int nActx = (l == 0) ? 16 : 0, nCctx = (l == 0) ? 8 : 0;
  if ((gridDim.x & 7) == 0) {
    const int xcd = blockIdx.x & 7, slot = blockIdx.x >> 3, nb = gridDim.x >> 3;
#pragma unroll 1
    for (int q = slot; q < 64 + (nActx >> 3); q += nb) {
      const int b = xcd >> 2, h = xcd & 3;
      if (q < 64) attn_item(p, l, b, h, b * 8192 + q * 128, 0, 132, smem);
      else attn_item(p, l, b, h, 16384 + b * 256 + (q - 64) * 128, 128, 132, smem);
    }
  } else {
#pragma unroll 1
    for (int j = blockIdx.x; j < 512 + nActx; j += gridDim.x) {
      if (j < 512) {
        const int b = j >> 8, h = (j >> 6) & 3, qb = j & 63;
        attn_item(p, l, b, h, b * 8192 + qb * 128, 0, 132, smem);
      } else {
        const int jj = j - 512;
        const int b = jj >> 3, h = (jj >> 1) & 3, qh = jj & 1;
        attn_item(p, l, b, h, 16384 + b * 256 + qh * 128, 128, 132, smem);
      }
    }
  }
#pragma unroll 1
  for (int j = (blockIdx.x + gridDim.x - 32) % gridDim.x; j < 528; j += gridDim.x) {
    const int b = j / 264, rem = j % 264, head = rem / 66, P = rem % 66;
    mlstm_b1_item(p, l, b, head, P, smem);
  }
#pragma unroll 1
  for (int j = (blockIdx.x + gridDim.x - 64) % gridDim.x; j < 256 + nCctx; j += gridDim.x) {
    if (j < 256) natten_item(p, l, j >> 7, j & 127, (j >> 7) * 8192 + (j & 127) * 64, 0, smem);
    else natten_item(p, l, (j - 256) >> 2, 0, 16384 + ((j - 256) >> 2) * 256 + ((j - 256) & 3) * 64, 8, smem);
  }
}

__device__ __attribute__((always_inline)) void h2_rows(const Params& p, int l) {
  const int tid = opaque_tid(), lane = tid & 63, wave = tid >> 6;
  u16* H2 = slotp(p, 3);
  const float* rstd = (const float*)(p.ws + WS_RSTD);
#pragma unroll 2
  for (int row = blockIdx.x * 8 + wave; row < R_TOT; row += gridDim.x * 8) {
    const float* xr = xrow(p, l, row);
    const int w = which_of(row);
    const float* gs = (const float*)(p.ws + WS_GS) + w * 1024;
    const float* sh = (const float*)(p.ws + WS_SH) + w * 1024;
    const float rs = rstd[row];
#pragma unroll
    for (int j = 0; j < 4; ++j) {
      const int k = lane * 4 + 256 * j;
      const v4f v = *(const v4f*)(xr + k);
      const v4f g = *(const v4f*)(gs + k);
      const v4f sf = *(const v4f*)(sh + k);
      v2u pk;
      pk[0] = pk2(v[0] * rs * g[0] + sf[0], v[1] * rs * g[1] + sf[1]);
      pk[1] = pk2(v[2] * rs * g[2] + sf[2], v[3] * rs * g[3] + sf[3]);
      *(v2u*)(H2 + (size_t)row * 1024 + k) = pk;
    }
  }
}

__device__ __attribute__((always_inline)) void phase_s5(const Params& p, int l, unsigned char* smem) {
  h2_rows(p, l);
  const int P0 = (l == 0) ? 0 : 2;
  const int nP = 66 - P0;
  for (int it = (blockIdx.x + gridDim.x - 96) % gridDim.x; it < 8 * nP; it += gridDim.x) {
    const int bh = it / nP, P = P0 + it % nP;
    mlstm_b3_item(p, l, bh >> 2, bh & 3, P, smem);
  }
}

__device__ __forceinline__ void s6a_tile(const Params& p, int rt, int ct, unsigned char* smem) {
  const int tid = opaque_tid(), lane = tid & 63, wave = tid >> 6;
  const int wm = wave >> 1, wn = wave & 1, r = lane & 31, hh = lane >> 5;
  const u16* H2 = slotp(p, 3);
  const u16* WTI = (const u16*)(p.ws + WS_WT_IN);
  u16* G = slotp(p, 5);
  const int row0 = rt * 256;
  f32x16 acc[2][2];
  acc[0][0] = zero16(); acc[0][1] = zero16(); acc[1][0] = zero16(); acc[1][1] = zero16();
  gemm_core<0, 2>(acc, H2 + (size_t)row0 * 1024, 1024, nullptr, nullptr, nullptr, nullptr,
                  WTI + (size_t)(6656 + ct * 128) * 1024, 1024, smem);
  u16* Gn = G + (size_t)(ct >> 3) * R_TOT * 1024;
  const int d0 = (ct & 7) * 128 + 64 * wn + r;
#pragma unroll
  for (int i = 0; i < 2; ++i)
#pragma unroll
    for (int e = 0; e < 16; ++e) {
      const int row = row0 + 64 * wm + 32 * i + (e & 3) + 8 * (e >> 2) + 4 * hh;
      gu16* rp = (gu16*)Gn + (size_t)row * 1024 + d0;
      asm volatile("" : "+v"(rp));
      rp[0] = f2bf(sigmoid_f(acc[i][0][e]));
      rp[32] = f2bf(sigmoid_f(acc[i][1][e]));
    }
}

__device__ __forceinline__ void s6a_tile256(const Params& p, int rt, int ct, unsigned char* smem) {
  const int tid = opaque_tid(), lane = tid & 63, wave = tid >> 6;
  const int wm = wave >> 1, wn = wave & 1, r = lane & 31, hh = lane >> 5;
  const u16* H2 = slotp(p, 3);
  const u16* WTI = (const u16*)(p.ws + WS_WT_IN);
  u16* G = slotp(p, 5);
  const int row0 = rt * 256;
  f32x16 acc[2][4];
#pragma unroll
  for (int i = 0; i < 2; ++i)
#pragma unroll
    for (int j = 0; j < 4; ++j) acc[i][j] = zero16();
  gemm_core256<1>(acc, H2 + (size_t)row0 * 1024, 1024, WTI + (size_t)(6656 + ct * 256) * 1024, 1024, smem);
  u16* Gn = G + (size_t)(ct >> 2) * R_TOT * 1024;
  const int d0 = (ct & 3) * 256 + 128 * wn + r;
#pragma unroll
  for (int i = 0; i < 2; ++i)
#pragma unroll
    for (int e = 0; e < 16; ++e) {
      const int row = row0 + 64 * wm + 32 * i + (e & 3) + 8 * (e >> 2) + 4 * hh;
      gu16* rp = (gu16*)Gn + (size_t)row * 1024 + d0;
      asm volatile("" : "+v"(rp));
#pragma unroll
      for (int j = 0; j < 4; ++j) {
        float v = acc[i][j][e];
        asm volatile("" : "+v"(v));
        rp[32 * j] = f2bf(sigmoid_f(v));
      }
    }
}

__device__ __attribute__((always_inline)) void phase_s6a(const Params& p, int l, unsigned char* smem) {
  {
    const pg8::Gemm g{slotp(p, 3), (const u16*)(p.ws + WS_WT_IN) + (size_t)6656 * 1024, 16384, 3072, 1024};
    const SegOrder S = make_order(768, 1);
    const EpiS6a E{slotp(p, 5)};
    pg8::gemm_phase<EpiS6a, SegOrder, false>((PG8_LAS unsigned char*)smem, g, S, E, nullptr);
  }
  if (l == 0) {
#pragma unroll 1
    for (int it = blockIdx.x; it < 48; it += gridDim.x) s6a_tile(p, 64 + (it & 1), it >> 1, smem);
  }
}

template <int MI>
__device__ __forceinline__ void s6b_tile(const Params& p, int row0, int ct, unsigned char* smem) {
  const int tid = opaque_tid(), lane = tid & 63, wave = tid >> 6;
  const int wm = wave >> 1, wn = wave & 1, r = lane & 31, hh = lane >> 5;
  const u16* WTB = (const u16*)(p.ws + WS_WT_BR);
  const u16* G = slotp(p, 5);
  u16* M = (u16*)(p.ws + WS_H);
  f32x16 tot[MI][2];
#pragma unroll
  for (int i = 0; i < MI; ++i) { tot[i][0] = zero16(); tot[i][1] = zero16(); }
#pragma unroll 1
  for (int n = 0; n < 3; ++n) {
    f32x16 ap[MI][2];
#pragma unroll
    for (int i = 0; i < MI; ++i) { ap[i][0] = zero16(); ap[i][1] = zero16(); }
    if constexpr (MI == 2)
      gemm_core_lean2(ap, slotp(p, n) + (size_t)row0 * 512, 512, WTB + (size_t)(n * 1024 + ct * 128) * 512, 512, smem);
    else
      gemm_core<0, MI>(ap, slotp(p, n) + (size_t)row0 * 512, 512, nullptr, nullptr, nullptr, nullptr,
                       WTB + (size_t)(n * 1024 + ct * 128) * 512, 512, smem);
    const u16* Gn = G + (size_t)n * R_TOT * 1024;
#pragma unroll
    for (int i = 0; i < MI; ++i)
#pragma unroll
      for (int e = 0; e < 16; ++e) {
        const int row = row0 + 32 * MI * wm + 32 * i + (e & 3) + 8 * (e >> 2) + 4 * hh;
        const gu16* rp = (const gu16*)Gn + (size_t)row * 1024 + ct * 128 + 64 * wn + r;
        asm volatile("" : "+v"(rp));
        tot[i][0][e] += bf2f(rp[0]) * ap[i][0][e];
        tot[i][1][e] += bf2f(rp[32]) * ap[i][1][e];
      }
  }
#pragma unroll
  for (int i = 0; i < MI; ++i)
#pragma unroll
    for (int e = 0; e < 16; ++e) {
      const int row = row0 + 32 * MI * wm + 32 * i + (e & 3) + 8 * (e >> 2) + 4 * hh;
      gu16* rp = (gu16*)M + (size_t)row * 1024 + ct * 128 + 64 * wn + r;
      asm volatile("" : "+v"(rp));
      rp[0] = f2bf(tot[i][0][e]);
      rp[32] = f2bf(tot[i][1][e]);
    }
}

__device__ __attribute__((always_inline)) void phase_s6b(const Params& p, int l, unsigned char* smem) {
  {
    const bool xs = (gridDim.x & 7) == 0;
    const int nb = xs ? (gridDim.x >> 3) : gridDim.x;
    const int xcd = xs ? (blockIdx.x & 7) : 0, slot = xs ? (blockIdx.x >> 3) : blockIdx.x;
    const int seg0 = xs ? 64 * xcd : 0, seg1 = xs ? 64 * (xcd + 1) : 512;
#pragma unroll 1
    for (int L = seg0 + slot; L < seg1; L += nb) {
      const int g = L >> 6, rem = L & 63, ct = rem >> 3, rt = 8 * g + (rem & 7);
      s6b_tile<2>(p, rt * 256, ct, smem);
    }
  }
  if (l == 0) {
#pragma unroll 1
    for (int it = blockIdx.x; it < 32; it += gridDim.x) s6b_tile<1>(p, 16384 + (it & 3) * 128, it >> 2, smem);
  }
}

template <int MI>
__device__ __forceinline__ void s7_tile(const Params& p, int l, int row0, int ct, unsigned char* smem) {
  const int tid = opaque_tid(), lane = tid & 63, wave = tid >> 6;
  const int wm = wave >> 1, wn = wave & 1, r = lane & 31, hh = lane >> 5;
  const u16* WTO = (const u16*)(p.ws + WS_WT_OUT);
  const u16* M = (const u16*)(p.ws + WS_H);
  const float* mod = (const float*)(p.ws + WS_MOD) + (size_t)l * 3 * 3072;
  const int w = which_of(row0);
  f32x16 acc[MI][2];
#pragma unroll
  for (int i = 0; i < MI; ++i) { acc[i][0] = zero16(); acc[i][1] = zero16(); }
  gemm_core<0, MI>(acc, M + (size_t)row0 * 1024, 1024, nullptr, nullptr, nullptr, nullptr, WTO + (size_t)(ct * 128) * 1024, 1024, smem);
  const float* xs_ = xrow(p, l, row0);
  float* xd = (row0 < 16384) ? (p.out + (size_t)row0 * 1024) : ((float*)(p.ws + WS_XC) + (size_t)(row0 - 16384) * 1024);
  const int col0 = ct * 128 + 64 * wn + r;
  const float g0 = mod[w * 3072 + 2048 + col0], g1 = mod[w * 3072 + 2048 + col0 + 32];
#pragma unroll
  for (int i = 0; i < MI; ++i)
#pragma unroll
    for (int e = 0; e < 16; ++e) {
      const size_t off = (size_t)(32 * MI * wm + 32 * i + (e & 3) + 8 * (e >> 2) + 4 * hh) * 1024 + col0;
      const gfloat* sp = (const gfloat*)xs_ + off;
      gfloat* dp = (gfloat*)xd + off;
      asm volatile("" : "+v"(sp), "+v"(dp));
      dp[0] = sp[0] + g0 * acc[i][0][e];
      dp[32] = sp[32] + g1 * acc[i][1][e];
    }
}

__device__ __attribute__((always_inline)) void phase_s7(const Params& p, int l, unsigned char* smem) {
  {
    const pg8::Gemm g{(const u16*)(p.ws + WS_H), (const u16*)(p.ws + WS_WT_OUT), 16384, 1024, 1024};
    const SegOrder S = make_order(256, 2);
    const EpiS7 E{(l == 0) ? p.x : (const float*)p.out, p.out, nullptr, (const float*)(p.ws + WS_MOD) + (size_t)l * 3 * 3072};
    pg8::gemm_phase<EpiS7, SegOrder, false>((PG8_LAS unsigned char*)smem, g, S, E, nullptr);
  }
  if (l == 0) {
#pragma unroll 1
    for (int it = blockIdx.x; it < 32; it += gridDim.x) s7_tile<1>(p, l, 16384 + (it & 3) * 128, it >> 2, smem);
  }
}

__device__ __attribute__((always_inline)) void phase_final(const Params& p) {
  const int tid = threadIdx.x, lane = tid & 63, wave = tid >> 6;
#pragma unroll 2
  for (int row = blockIdx.x * 8 + wave; row < 16384; row += gridDim.x * 8) {
    float* xr = p.out + (size_t)row * 1024;
    v4f v[4];
    float ss = 0.f;
#pragma unroll
    for (int j = 0; j < 4; ++j) {
      v[j] = *(const v4f*)(xr + lane * 4 + 256 * j);
      ss += v[j][0] * v[j][0] + v[j][1] * v[j][1] + v[j][2] * v[j][2] + v[j][3] * v[j][3];
    }
    ss = wave_sum(ss);
    const float rs = rsqrtf(ss * (1.f / 1024.f) + 1e-6f);
#pragma unroll
    for (int j = 0; j < 4; ++j) {
      const v4f g = *(const v4f*)(p.final_g + lane * 4 + 256 * j);
      v4f o;
#pragma unroll
      for (int e = 0; e < 4; ++e) o[e] = v[j][e] * rs * g[e];
      *(v4f*)(xr + lane * 4 + 256 * j) = o;
    }
  }
}

#define XB_TMO      128
#define XB_XCNT(j)  (256  + 64 * (j))
#define XB_XSUB(j)  (1280 + 64 * (j))
#define XB_XGEN(j)  (2304 + 64 * (j))
#define XB_TOP      3328
#define XB_TOPGEN   3392
#define XCD_BAR_WORDS 3456
#define XB_SPIN_CAP (1u << 18)
#define LAS __attribute__((address_space(3)))

__device__ __forceinline__ unsigned xb_ld(unsigned* p)              { return __hip_atomic_load(p, __ATOMIC_RELAXED, __HIP_MEMORY_SCOPE_AGENT); }
__device__ __forceinline__ unsigned xb_add(unsigned* p, unsigned v) { return __hip_atomic_fetch_add(p, v, __ATOMIC_RELAXED, __HIP_MEMORY_SCOPE_AGENT); }
__device__ __forceinline__ unsigned xb_xcc_id() { return (unsigned)__builtin_amdgcn_s_getreg((3 << 11) | 20) & 0xFu; }
#define XB_SPIN(cond, bar) do { unsigned _sp = 0; while (cond) { __builtin_amdgcn_s_sleep(1); \
    if ((++_sp & 255u) == 0u) { if (xb_ld(&(bar)[XB_TMO])) break; if (_sp > XB_SPIN_CAP) { atomicAdd(&(bar)[XB_TMO], 1u); break; } } } } while (0)

struct XcdBarrier {
    unsigned* bar; unsigned x;
    volatile LAS unsigned* st;
};

__device__ __forceinline__ XcdBarrier xcd_barrier_post(unsigned* bar, volatile LAS unsigned* st) {
    XcdBarrier b; b.bar = bar; b.x = xb_xcc_id(); b.st = st;
    if (threadIdx.x == 0) (void)xb_add(&bar[XB_XCNT(b.x)], 1u);
    return b;
}
__device__ __forceinline__ void xcd_barrier_complete(unsigned* bar, unsigned x, unsigned& nloc, unsigned& nx) {
    const unsigned G = gridDim.x * gridDim.y * gridDim.z;
    unsigned sum, cnt, mine, sp = 0u;
    for (;;) {
        sum = 0u; cnt = 0u; mine = 0u;
#pragma unroll
        for (unsigned j = 0; j < 16; ++j) { const unsigned c = xb_ld(&bar[XB_XCNT(j)]); sum += c; cnt += (c > 0u) ? 1u : 0u; mine = (j == x) ? c : mine; }
        if (sum == G) break;
        __builtin_amdgcn_s_sleep(1);
        if ((++sp & 255u) == 0u) { if (xb_ld(&bar[XB_TMO])) break; if (sp > XB_SPIN_CAP) { atomicAdd(&bar[XB_TMO], 1u); break; } }
    }
    nloc = mine > 0u ? mine : 1u; nx = cnt > 0u ? cnt : 1u;
}

__device__ __forceinline__ void xcd_barrier(const XcdBarrier& b) {
    asm volatile("s_waitcnt vmcnt(0)" ::: "memory");
    __syncthreads();
    if (threadIdx.x == 0) {
        unsigned* bar = b.bar;
        __builtin_amdgcn_s_waitcnt(0);
        unsigned nloc = b.st[0], nx = b.st[1];
        if (nloc == 0u) { xcd_barrier_complete(bar, b.x, nloc, nx); b.st[0] = nloc; b.st[1] = nx; }
        const unsigned old = xb_add(&bar[XB_XSUB(b.x)], 1u);
        const unsigned gen = old / nloc;
        if (old + 1u == (gen + 1u) * nloc) {
            __builtin_amdgcn_fence(__ATOMIC_RELEASE, "agent");
            asm volatile("s_waitcnt vmcnt(0)" ::: "memory");
            const unsigned og = xb_add(&bar[XB_TOP], 1u);
            const unsigned tg = og / nx;
            if (og + 1u == (tg + 1u) * nx) xb_add(&bar[XB_TOPGEN], 1u);
            else XB_SPIN(xb_ld(&bar[XB_TOPGEN]) == tg, bar);
            __builtin_amdgcn_fence(__ATOMIC_ACQUIRE, "agent");
            xb_add(&bar[XB_XGEN(b.x)], 1u);
            asm volatile("s_waitcnt vmcnt(0)" ::: "memory");
        } else {
            XB_SPIN(xb_ld(&bar[XB_XGEN(b.x)]) == gen, bar);
            __builtin_amdgcn_fence(__ATOMIC_ACQUIRE, "agent");
            asm volatile("s_waitcnt vmcnt(0)" ::: "memory");
        }
    }
    __syncthreads();
}


__global__ void __launch_bounds__(NTHR) fwd_megakernel(Params p) {
  extern __shared__ __attribute__((aligned(16))) unsigned char smem[];
  cg::grid_group grid = cg::this_grid();
  __shared__ uint4 xb_words;
  if (threadIdx.x == 0) xb_words = make_uint4(0u, 0u, 0u, 0u);
  __syncthreads();
  XcdBarrier xbar = xcd_barrier_post((unsigned*)(p.ws + WS_BAR), (volatile LAS unsigned*)&xb_words);
#define PH(k, call)                                  \
  if (p.ph_lo <= (k) && (k) < p.ph_hi) {             \
    call;                                            \
    if ((k) + 1 < p.ph_hi) { if ((k) == 0) grid.sync(); else xcd_barrier(xbar); }  \
  }
  PH(0, phase_s0(p))
  PH(1, phase_s1(p, 0, smem))
  PH(2, phase_s2(p, 0, smem))
  PH(3, phase_s3(p, 0, smem))
  PH(4, phase_b2(p))
  PH(5, phase_s5(p, 0, smem))
  PH(6, phase_s6a(p, 0, smem))
  PH(7, phase_s6b(p, 0, smem))
  PH(8, phase_s7(p, 0, smem))
  PH(9, phase_s1(p, 1, smem))
  PH(10, phase_s2(p, 1, smem))
  PH(11, phase_s3(p, 1, smem))
  PH(12, phase_b2(p))
  PH(13, phase_s5(p, 1, smem))
  PH(14, phase_s6a(p, 1, smem))
  PH(15, phase_s6b(p, 1, smem))
  PH(16, phase_s7(p, 1, smem))
  PH(17, phase_final(p))
#undef PH
}

extern "C" void kernel_launch(void* const* d_in, const int* in_sizes, int n_in, void* d_out, int out_size,
                              void* d_ws, size_t ws_size, hipStream_t stream) {
  static int grid_blocks = 0;
  if (grid_blocks == 0) {
    if (n_in != 19 || ws_size < WS_END) {
      fprintf(stderr, "kernel_launch: unexpected n_in %d or ws_size %zu (< %llu)\n", n_in, ws_size, (unsigned long long)WS_END);
      grid_blocks = -1;
      return;
    }
    int dev = 0, cus = 0, per_cu = 0;
    hipGetDevice(&dev);
    hipDeviceGetAttribute(&cus, hipDeviceAttributeMultiprocessorCount, dev);
    if (hipFuncSetAttribute((const void*)fwd_megakernel, hipFuncAttributeMaxDynamicSharedMemorySize, LDS_BYTES) != hipSuccess) {
      fprintf(stderr, "kernel_launch: hipFuncSetAttribute failed\n");
      grid_blocks = -1;
      return;
    }
    hipOccupancyMaxActiveBlocksPerMultiprocessor(&per_cu, (const void*)fwd_megakernel, NTHR, LDS_BYTES);
    if (per_cu < 1) { fprintf(stderr, "kernel_launch: occupancy query says %d blocks/CU\n", per_cu); per_cu = 1; }
    (void)hipGetLastError();
    grid_blocks = cus;
  }
  if (grid_blocks < 0) return;
  hipMemsetAsync((char*)d_ws + WS_BAR, 0, 13824 + 73728, stream);
  Params p{};
  p.x = (const float*)d_in[0]; p.c = (const float*)d_in[1]; p.ctx = (const float*)d_in[2]; p.c_ctx = (const float*)d_in[3];
  p.w_mod = (const float*)d_in[4]; p.b_mod = (const float*)d_in[5]; p.norm_g = (const float*)d_in[6]; p.w_in = (const float*)d_in[7];
  p.lam_q = (const float*)d_in[8]; p.lam_k = (const float*)d_in[9]; p.da_g = (const float*)d_in[10];
  p.conv_w = (const float*)d_in[11]; p.conv_b = (const float*)d_in[12]; p.gate_b = (const float*)d_in[13]; p.ml_g = (const float*)d_in[14];
  p.rpb = (const float*)d_in[15]; p.w_br = (const float*)d_in[16]; p.w_out = (const float*)d_in[17]; p.final_g = (const float*)d_in[18];
  p.out = (float*)d_out; p.ws = (unsigned char*)d_ws;
#if MULTI_LAUNCH
  for (int ph = 0; ph < NPHASE; ++ph) {
    p.ph_lo = ph; p.ph_hi = ph + 1;
    hipLaunchKernelGGL(fwd_megakernel, dim3(grid_blocks), dim3(NTHR), LDS_BYTES, stream, p);
  }
#else
  p.ph_lo = 0; p.ph_hi = NPHASE;
  void* args[] = {&p};
  hipError_t e = hipLaunchCooperativeKernel((void*)fwd_megakernel, dim3(grid_blocks), dim3(NTHR), args, LDS_BYTES, stream);
  if (e != hipSuccess) fprintf(stderr, "cooperative launch failed: %s (grid %d)\n", hipGetErrorString(e), grid_blocks);
#endif
}
```

```cpp
#include <hip/hip_runtime.h>
#include <hip/hip_cooperative_groups.h>
#include <cstdio>
namespace cg = cooperative_groups;

#ifndef MULTI_LAUNCH
#define MULTI_LAUNCH 0
#endif

typedef unsigned short u16;
typedef __attribute__((ext_vector_type(8))) short bf16x8;
typedef __attribute__((ext_vector_type(16))) float f32x16;
typedef __attribute__((ext_vector_type(4))) unsigned int v4u;
typedef __attribute__((ext_vector_type(2))) unsigned int v2u;
typedef __attribute__((ext_vector_type(4))) float v4f;

#define R_TOT 16896
#define NKEY 8448
#define NPAD 9856
#define NTHR 512
#define LDS_BYTES 147456
#define NPHASE 18

#define WS_WT_IN 0ull
#define WS_WT_BR 20185088ull
#define WS_WT_OUT 23330816ull
#define WS_H 25427968ull
#define WS_PIECE 60030976ull
#define PIECE_SZ 17301504ull
#define WS_XC 284950528ull
#define WS_G 287047680ull
#define WS_MOD 289410816ull
#define WS_ROPE 288202752ull
#define WS_RSTD 288219136ull
#define WS_DN 288286720ull
#define WS_NPREV 288827392ull
#define WS_BL 289368064ull
#define WS_GS 289372416ull
#define WS_SH 289384704ull
#define WS_BAR 289396992ull
#define WS_END 289484544ull

enum { P_QA = 0, P_KA, P_VTA, P_ZA, P_QB, P_KB, P_VTB, P_OB, P_ZB, P_QC, P_KC, P_VTC, P_ZC };

#define GAS __attribute__((address_space(1)))
typedef GAS u16 gu16;
typedef GAS float gfloat;
typedef GAS v2u gv2u;
typedef GAS v4f gv4f;
struct Params {
  const float *x, *c, *ctx, *c_ctx, *w_mod, *b_mod, *norm_g, *w_in, *lam_q, *lam_k, *da_g,
      *conv_w, *conv_b, *gate_b, *ml_g, *rpb, *w_br, *w_out, *final_g;
  float* out;
  unsigned char* ws;
  int ph_lo, ph_hi;
};

__device__ __forceinline__ int opaque_tid() { int t = threadIdx.x; asm volatile("" : "+v"(t)); return t; }
__device__ __forceinline__ u16 f2bf(float f) {
  unsigned u = __float_as_uint(f);
  u += 0x7fffu + ((u >> 16) & 1u);
  return (u16)(u >> 16);
}
__device__ __forceinline__ float bf2f(u16 h) { return __uint_as_float(((unsigned)h) << 16); }
typedef __attribute__((ext_vector_type(2))) __bf16 bf16x2_t;
typedef __attribute__((ext_vector_type(2))) float f32x2_t;
__device__ __forceinline__ unsigned pk2(float a, float b) { f32x2_t v = {a, b}; bf16x2_t r = __builtin_convertvector(v, bf16x2_t); return __builtin_bit_cast(unsigned, r); }
__device__ __forceinline__ float bflo(unsigned u) { return __uint_as_float(u << 16); }
__device__ __forceinline__ float bfhi(unsigned u) { return __uint_as_float(u & 0xffff0000u); }
__device__ __forceinline__ float silu_f(float x) { return x / (1.f + __expf(-x)); }
__device__ __forceinline__ float sigmoid_f(float x) { return 1.f / (1.f + __expf(-x)); }
__device__ __forceinline__ float ex2(float x) { return __builtin_amdgcn_exp2f(x); }
__device__ __forceinline__ float wave_sum(float v) {
#pragma unroll
  for (int o = 32; o > 0; o >>= 1) v += __shfl_xor(v, o, 64);
  return v;
}
__device__ __forceinline__ f32x16 mfma32(bf16x8 a, bf16x8 b, f32x16 c) {
  return __builtin_amdgcn_mfma_f32_32x32x16_bf16(a, b, c, 0, 0, 0);
}
__device__ __forceinline__ f32x16 zero16() {
  f32x16 z;
#pragma unroll
  for (int i = 0; i < 16; ++i) z[i] = 0.f;
  return z;
}
__device__ __forceinline__ int pslot(int i) { return (int)((0xCBA2918765430ull >> (4 * i)) & 15ull); }
__device__ __forceinline__ u16* piece(const Params& p, int i) { return (u16*)(p.ws + WS_PIECE + (size_t)pslot(i) * PIECE_SZ); }
__device__ __forceinline__ u16* slotp(const Params& p, int sl) { return (u16*)(p.ws + WS_PIECE + (size_t)sl * PIECE_SZ); }
__device__ __forceinline__ const float* xrow(const Params& p, int l, int grow) {
  if (grow < 16384) return (l == 0 ? p.x : (const float*)p.out) + (size_t)grow * 1024;
  return (l == 0 ? p.ctx : (const float*)(p.ws + WS_XC)) + (size_t)(grow - 16384) * 1024;
}
__device__ __forceinline__ int which_of(int grow) { return grow < 8192 ? 0 : (grow < 16384 ? 1 : 2); }
__device__ __forceinline__ int perm16(int s) { return (s & ~15) | (((s >> 2) & 1) << 3) | (((s >> 3) & 1) << 2) | (s & 3); }

__device__ __attribute__((always_inline)) void phase_s0(const Params& p) {
  const int tid = threadIdx.x;
  float* mod = (float*)(p.ws + WS_MOD);
  for (int it = blockIdx.x; it < 2 * 12 * 16; it += gridDim.x) {
    const int l = it / 192, rem = it % 192, nch = rem / 16, kch = rem % 16;
    const int kh = tid >> 8, n = nch * 256 + (tid & 255);
    const int k0 = kch * 64 + kh * 32;
    const float* W = p.w_mod + (size_t)l * 1024 * 3072;
    float a0 = 0.f, a1 = 0.f, a2 = 0.f;
#pragma unroll 8
    for (int k = k0; k < k0 + 32; ++k) {
      const float w = W[(size_t)k * 3072 + n];
      a0 += silu_f(p.c[k]) * w;
      a1 += silu_f(p.c[1024 + k]) * w;
      a2 += silu_f(p.c_ctx[k]) * w;
    }
    if (kch == 0 && kh == 0) {
      const float bb = p.b_mod[l * 3072 + n];
      a0 += bb; a1 += bb; a2 += bb;
    }
    atomicAdd(&mod[(l * 3 + 0) * 3072 + n], a0);
    atomicAdd(&mod[(l * 3 + 1) * 3072 + n], a1);
    atomicAdd(&mod[(l * 3 + 2) * 3072 + n], a2);
  }
  const int gi = blockIdx.x * NTHR + tid;
  if (gi < 2048) {
    const int v = gi >> 4, f = gi & 15;
    const float inv = (float)exp(-(double)f * (9.210340371976184 / 16.0));
    const float angf = (float)v * inv;
    double a = (double)angf;
    const double twopi = 6.283185307179586476925;
    a -= twopi * floor(a / twopi + 0.5);
    const double a2 = a * a;
    double ts = a, tc = 1.0, sn = a, cs = 1.0;
    for (int i = 1; i <= 14; ++i) {
      tc = -tc * a2 / (double)((2 * i - 1) * (2 * i));
      ts = -ts * a2 / (double)((2 * i) * (2 * i + 1));
      cs += tc; sn += ts;
    }
    float* rt = (float*)(p.ws + WS_ROPE);
    rt[gi * 2] = (float)cs;
    rt[gi * 2 + 1] = (float)sn;
  }
}

__device__ __attribute__((always_inline)) void conv_tile(const float* __restrict__ src, int ld, int k0, int col0, int nvalid, bool perm,
                          u16* __restrict__ dst, int ldd, int n0, unsigned char* smem) {
  u16* t = (u16*)smem;
  const int tid = opaque_tid();
#pragma unroll
  for (int i = 0; i < 2; ++i) {
    const int idx = tid + NTHR * i;
    const int kk = idx >> 4, c4 = idx & 15;
    v4f v = {0.f, 0.f, 0.f, 0.f};
    if (4 * c4 < nvalid) v = *(const v4f*)(src + (size_t)(k0 + kk) * ld + col0 + 4 * c4);
#pragma unroll
    for (int e = 0; e < 4; ++e) {
      const int j = 4 * c4 + e;
      const int jp = perm ? (32 * (j >> 5) + 8 * (((j >> 1) & 15) >> 2) + 4 * (j & 1) + ((j >> 1) & 3)) : j;
      t[jp * 72 + kk] = f2bf(v[e]);
    }
  }
  __syncthreads();
  {
    const int n = tid >> 3, ch = tid & 7;
    const v4u v = *(const v4u*)(t + n * 72 + ch * 8);
    *(v4u*)(dst + (size_t)(n0 + n) * ldd + k0 + ch * 8) = v;
  }
  __syncthreads();
}

__device__ __attribute__((always_inline)) void phase_s1(const Params& p, int l, unsigned char* smem) {
  const int tid = threadIdx.x, lane = tid & 63, wave = tid >> 6;
  const float* mod = (const float*)(p.ws + WS_MOD) + (size_t)l * 3 * 3072;
  const float* g = p.norm_g + l * 1024;
  u16* H = (u16*)(p.ws + WS_H);
  float* rstd = (float*)(p.ws + WS_RSTD);
  if (blockIdx.x == 0) {
    float* gs = (float*)(p.ws + WS_GS);
    float* sh = (float*)(p.ws + WS_SH);
    for (int i = tid; i < 3072; i += NTHR) {
      const int w = i >> 10, k = i & 1023;
      gs[i] = g[k] * (1.f + mod[w * 3072 + 1024 + k]);
      sh[i] = mod[w * 3072 + k];
    }
  }
#pragma unroll 2
  for (int row = blockIdx.x * 8 + wave; row < R_TOT; row += gridDim.x * 8) {
    const float* xr = xrow(p, l, row);
    const int w = which_of(row);
    v4f v[4];
    float ss = 0.f;
#pragma unroll
    for (int j = 0; j < 4; ++j) {
      v[j] = *(const v4f*)(xr + lane * 4 + 256 * j);
      ss += v[j][0] * v[j][0] + v[j][1] * v[j][1] + v[j][2] * v[j][2] + v[j][3] * v[j][3];
    }
    ss = wave_sum(ss);
    const float rs = rsqrtf(ss * (1.f / 1024.f) + 1e-6f);
    if (lane == 0) rstd[row] = rs;
#pragma unroll
    for (int j = 0; j < 4; ++j) {
      const int k = lane * 4 + 256 * j;
      const v4f gg = *(const v4f*)(g + k);
      const v4f sc = *(const v4f*)(mod + w * 3072 + 1024 + k);
      const v4f sf = *(const v4f*)(mod + w * 3072 + k);
      float o[4];
#pragma unroll
      for (int e = 0; e < 4; ++e) o[e] = v[j][e] * rs * gg[e] * (1.f + sc[e]) + sf[e];
      v2u pk;
      pk[0] = pk2(o[0], o[1]);
      pk[1] = pk2(o[2], o[3]);
      *(v2u*)(H + (size_t)row * 1024 + k) = pk;
    }
  }
  u16* WTI = (u16*)(p.ws + WS_WT_IN);
  u16* WTB = (u16*)(p.ws + WS_WT_BR);
  u16* WTO = (u16*)(p.ws + WS_WT_OUT);
  const float* win = p.w_in + (size_t)l * 1024 * 9744;
  for (int it = blockIdx.x; it < 2464 + 384 + 256; it += gridDim.x) {
    if (it < 2464) {
      const int nb = it % 154, kb = it / 154;
      const int n0 = nb * 64;
      int col0 = n0, nvalid = 64;
      bool perm = n0 < 1024;
      if (n0 >= 4608 && n0 < 9728) col0 = n0 + 16;
      else if (n0 == 9728) { col0 = 4608; nvalid = 16; }
      else if (n0 > 9728) { col0 = 0; nvalid = 0; }
      conv_tile(win, 9744, kb * 64, col0, nvalid, perm, WTI, 1024, n0, smem);
    } else if (it < 2464 + 384) {
      const int j = it - 2464;
      const int n = j / 128, r = j % 128, db = r / 8, wb = r % 8;
      conv_tile(p.w_br + ((size_t)l * 3 + n) * 512 * 1024, 1024, wb * 64, db * 64, 64, false,
                WTB + (size_t)n * 1024 * 512, 512, db * 64, smem);
    } else {
      const int j = it - 2464 - 384;
      const int db = j / 16, kb = j % 16;
      conv_tile(p.w_out + (size_t)l * 1024 * 1024, 1024, kb * 64, db * 64, 64, false, WTO, 1024, db * 64, smem);
    }
  }
}

template <int AMODE, int MI>
__device__ __forceinline__ void gemm_core(f32x16 (&acc)[MI][2], const u16* __restrict__ A, int lda,
                                          const float* __restrict__ Ax, const float* __restrict__ rstd,
                                          const float* __restrict__ gs, const float* __restrict__ sh,
                                          const u16* __restrict__ B, int K, unsigned char* smem) {
  constexpr int AROWS = 128 * MI;
  u16* As = (u16*)smem;
  u16* Bs = (u16*)(smem + 73728);
  const int tid = opaque_tid(), lane = tid & 63, wave = tid >> 6;
  const int wm = wave >> 1, wn = wave & 1, r = lane & 31, hh = lane >> 5;
  const int lrow = tid >> 3, c8 = tid & 7;
  v4u ra[2][2 * MI], rb[2][2];
  float rs4[2 * MI];
  if (AMODE == 1) {
#pragma unroll
    for (int i = 0; i < 2 * MI; ++i) rs4[i] = rstd[lrow + 64 * i];
  }
  const int KT = K >> 6;
#define GEMM_LOAD(set, k0)                                                                        \
  {                                                                                               \
    if (AMODE == 0) {                                                                             \
      _Pragma("unroll") for (int i = 0; i < 2 * MI; ++i)                                          \
        ra[set][i] = *(const v4u*)(A + (size_t)(lrow + 64 * i) * lda + (k0) + c8 * 8);            \
    } else {                                                                                      \
      const v4f g0 = *(const v4f*)(gs + (k0) + c8 * 8), g1 = *(const v4f*)(gs + (k0) + c8 * 8 + 4); \
      const v4f s0 = *(const v4f*)(sh + (k0) + c8 * 8), s1 = *(const v4f*)(sh + (k0) + c8 * 8 + 4); \
      _Pragma("unroll") for (int i = 0; i < 2 * MI; ++i) {                                        \
        const float* xp = Ax + (size_t)(lrow + 64 * i) * 1024 + (k0) + c8 * 8;                    \
        const v4f x0 = *(const v4f*)xp, x1 = *(const v4f*)(xp + 4);                               \
        const float rr = rs4[i];                                                                  \
        ra[set][i][0] = pk2(x0[0] * rr * g0[0] + s0[0], x0[1] * rr * g0[1] + s0[1]);              \
        ra[set][i][1] = pk2(x0[2] * rr * g0[2] + s0[2], x0[3] * rr * g0[3] + s0[3]);              \
        ra[set][i][2] = pk2(x1[0] * rr * g1[0] + s1[0], x1[1] * rr * g1[1] + s1[1]);              \
        ra[set][i][3] = pk2(x1[2] * rr * g1[2] + s1[2], x1[3] * rr * g1[3] + s1[3]);              \
      }                                                                                           \
    }                                                                                             \
    _Pragma("unroll") for (int i = 0; i < 2; ++i)                                                 \
        rb[set][i] = *(const v4u*)(B + (size_t)(lrow + 64 * i) * K + (k0) + c8 * 8);              \
  }
#define GEMM_STORE(set, buf)                                                                      \
  {                                                                                               \
    _Pragma("unroll") for (int i = 0; i < 2 * MI; ++i)                                            \
        *(v4u*)(As + (buf) * AROWS * 72 + (lrow + 64 * i) * 72 + c8 * 8) = ra[set][i];            \
    _Pragma("unroll") for (int i = 0; i < 2; ++i)                                                 \
        *(v4u*)(Bs + (buf) * 128 * 72 + (lrow + 64 * i) * 72 + c8 * 8) = rb[set][i];              \
  }
#define GEMM_COMPUTE(cur)                                                                         \
  {                                                                                               \
    const u16* Ab = As + (cur) * AROWS * 72 + (32 * MI * wm + r) * 72 + 8 * hh;                   \
    const u16* Bb = Bs + (cur) * 128 * 72 + (64 * wn + r) * 72 + 8 * hh;                          \
    _Pragma("unroll") for (int ks = 0; ks < 4; ++ks) {                                            \
      const bf16x8 b0 = *(const bf16x8*)(Bb + ks * 16);                                           \
      const bf16x8 b1 = *(const bf16x8*)(Bb + 32 * 72 + ks * 16);                                 \
      _Pragma("unroll") for (int i = 0; i < MI; ++i) {                                            \
        const bf16x8 a0 = *(const bf16x8*)(Ab + i * 32 * 72 + ks * 16);                           \
        acc[i][0] = mfma32(a0, b0, acc[i][0]);                                                    \
        acc[i][1] = mfma32(a0, b1, acc[i][1]);                                                    \
      }                                                                                           \
    }                                                                                             \
  }
  GEMM_LOAD(0, 0);
  GEMM_LOAD(1, 64);
  GEMM_STORE(0, 0);
  __syncthreads();
  for (int kt = 0; kt < KT; kt += 2) {
    if (kt + 2 < KT) GEMM_LOAD(0, (kt + 2) * 64);
    GEMM_COMPUTE(0);
    GEMM_STORE(1, 1);
    __syncthreads();
    if (kt + 3 < KT) GEMM_LOAD(1, (kt + 3) * 64);
    GEMM_COMPUTE(1);
    if (kt + 2 < KT) GEMM_STORE(0, 0);
    __syncthreads();
  }
#undef GEMM_COMPUTE
#undef GEMM_LOAD
#undef GEMM_STORE
}

__device__ __forceinline__ void gemm_core_lean2(f32x16 (&acc)[2][2], const u16* __restrict__ A, int lda,
                                                const u16* __restrict__ B, int K, unsigned char* smem) {
  u16* As = (u16*)smem;
  u16* Bs = (u16*)(smem + 73728);
  const int tid = opaque_tid(), lane = tid & 63, wave = tid >> 6;
  const int wm = wave >> 1, wn = wave & 1, r = lane & 31, hh = lane >> 5;
  const int lrow = tid >> 3, c8 = tid & 7;
  v4u ra[4], rb[2];
  const int KT = K >> 6;
#define GL_LOAD(k0)                                                                               \
  {                                                                                               \
    _Pragma("unroll") for (int i = 0; i < 4; ++i)                                                 \
      ra[i] = *(const v4u*)(A + (size_t)(lrow + 64 * i) * lda + (k0) + c8 * 8);                   \
    _Pragma("unroll") for (int i = 0; i < 2; ++i)                                                 \
      rb[i] = *(const v4u*)(B + (size_t)(lrow + 64 * i) * K + (k0) + c8 * 8);                     \
  }
#define GL_STORE(buf)                                                                             \
  {                                                                                               \
    _Pragma("unroll") for (int i = 0; i < 4; ++i)                                                 \
      *(v4u*)(As + (buf) * 256 * 72 + (lrow + 64 * i) * 72 + c8 * 8) = ra[i];                     \
    _Pragma("unroll") for (int i = 0; i < 2; ++i)                                                 \
      *(v4u*)(Bs + (buf) * 128 * 72 + (lrow + 64 * i) * 72 + c8 * 8) = rb[i];                     \
  }
  GL_LOAD(0);
  GL_STORE(0);
  __syncthreads();
  if (KT > 1) GL_LOAD(64);
  for (int kt = 0; kt < KT; ++kt) {
    const int cur = kt & 1;
    const u16* Ab = As + cur * 256 * 72 + (64 * wm + r) * 72 + 8 * hh;
    const u16* Bb = Bs + cur * 128 * 72 + (64 * wn + r) * 72 + 8 * hh;
#pragma unroll
    for (int ks = 0; ks < 4; ++ks) {
      __builtin_amdgcn_sched_barrier(0);
      const bf16x8 a0 = *(const bf16x8*)(Ab + ks * 16);
      const bf16x8 a1 = *(const bf16x8*)(Ab + 32 * 72 + ks * 16);
      const bf16x8 b0 = *(const bf16x8*)(Bb + ks * 16);
      const bf16x8 b1 = *(const bf16x8*)(Bb + 32 * 72 + ks * 16);
      acc[0][0] = mfma32(a0, b0, acc[0][0]);
      acc[0][1] = mfma32(a0, b1, acc[0][1]);
      acc[1][0] = mfma32(a1, b0, acc[1][0]);
      acc[1][1] = mfma32(a1, b1, acc[1][1]);
    }
    if (kt + 1 < KT) {
      GL_STORE(cur ^ 1);
      if (kt + 2 < KT) GL_LOAD((kt + 2) * 64);
    }
    __syncthreads();
  }
#undef GL_LOAD
#undef GL_STORE
}

template <int LEAN>
__device__ __forceinline__ void gemm_core256(f32x16 (&acc)[2][4], const u16* __restrict__ A, int lda,
                                             const u16* __restrict__ B, int K, unsigned char* smem) {
  u16* As = (u16*)smem;
  u16* Bs = (u16*)(smem + 73728);
  const int tid = opaque_tid(), lane = tid & 63, wave = tid >> 6;
  const int wm = wave >> 1, wn = wave & 1, r = lane & 31, hh = lane >> 5;
  const int lrow = tid >> 3, c8 = tid & 7;
  v4u ra[4], rb[4];
  const int KT = K >> 6;
#define G2_LOAD(k0)                                                                               \
  {                                                                                               \
    _Pragma("unroll") for (int i = 0; i < 4; ++i) {                                               \
      ra[i] = *(const v4u*)(A + (size_t)(lrow + 64 * i) * lda + (k0) + c8 * 8);                   \
      rb[i] = *(const v4u*)(B + (size_t)(lrow + 64 * i) * K + (k0) + c8 * 8);                     \
    }                                                                                             \
  }
#define G2_STORE(buf)                                                                             \
  {                                                                                               \
    _Pragma("unroll") for (int i = 0; i < 4; ++i) {                                               \
      *(v4u*)(As + (buf) * 256 * 72 + (lrow + 64 * i) * 72 + c8 * 8) = ra[i];                     \
      *(v4u*)(Bs + (buf) * 256 * 72 + (lrow + 64 * i) * 72 + c8 * 8) = rb[i];                     \
    }                                                                                             \
  }
  G2_LOAD(0);
  G2_STORE(0);
  __syncthreads();
  if (KT > 1) G2_LOAD(64);
  for (int kt = 0; kt < KT; ++kt) {
    const int cur = kt & 1;
    const u16* Ab = As + cur * 256 * 72 + (64 * wm + r) * 72 + 8 * hh;
    const u16* Bb = Bs + cur * 256 * 72 + (128 * wn + r) * 72 + 8 * hh;
#pragma unroll
    for (int ks = 0; ks < 4; ++ks) {
      if (LEAN) __builtin_amdgcn_sched_barrier(0);
      const bf16x8 a0 = *(const bf16x8*)(Ab + ks * 16);
      const bf16x8 a1 = *(const bf16x8*)(Ab + 32 * 72 + ks * 16);
#pragma unroll
      for (int j = 0; j < 4; ++j) {
        const bf16x8 b0 = *(const bf16x8*)(Bb + j * 32 * 72 + ks * 16);
        acc[0][j] = mfma32(a0, b0, acc[0][j]);
        acc[1][j] = mfma32(a1, b0, acc[1][j]);
      }
    }
    if (kt + 1 < KT) {
      G2_STORE(cur ^ 1);
      if (kt + 2 < KT) G2_LOAD((kt + 2) * 64);
    }
    __syncthreads();
  }
#undef G2_LOAD
#undef G2_STORE
}

namespace pg8 {
#define PG8_LAS __attribute__((address_space(3)))
typedef unsigned short bf16_t;
typedef short bf16x8 __attribute__((ext_vector_type(8)));
typedef float f32x4 __attribute__((ext_vector_type(4)));
typedef unsigned u32x4 __attribute__((ext_vector_type(4)));
constexpr int BM = 256, BK = 64, HALF = 128, HTB = HALF * BK * 2  , STAGE_BYTES = 8 * HTB, NXCD = 8, WGM = 8;

__host__ __device__ __forceinline__ int lds_byte(int r, int c) { const int st = (r >> 4) * 2 + (c >> 5), rr = r & 15, cc = c & 31, ob = rr * 64 + cc * 2; return st * 1024 + (ob ^ (((ob >> 9) & 1) << 5)); }
__host__ __device__ __forceinline__ void stage_rc(int b, int& R, int& C) { const int st = b / 1024, sb = b % 1024, swz = sb ^ (((sb >> 9) & 1) << 5); R = (st >> 1) * 16 + swz / 64; C = (st & 1) * 32 + (swz % 64) / 2; }
__host__ __device__ __forceinline__ int perm32(int rho) { const int n = rho >> 4, i = rho & 15; return 8 * (i >> 2) + 4 * n + (i & 3); }

struct Unit { int pm, pn; };
struct Gemm { const bf16_t* A; const bf16_t* Bt; int M, N, K; };

template <class Epi, class Sched, bool STAMP = false>
__device__ __forceinline__ void gemm_phase(PG8_LAS unsigned char* lds, const Gemm g, const Sched& S, const Epi& E, unsigned long long* stamps) {
    const int tid = threadIdx.x, wid = __builtin_amdgcn_readfirstlane(tid >> 6), lane = tid & 63, wr = wid >> 2, wc = wid & 3, fr = lane & 15, fq = lane >> 4;
    const int K = g.K, nt = K / BK;
    int ts_lo = 0, ts_hi = 0, nts = 0; const unsigned long long rt_entry = STAMP ? (unsigned long long)wall_clock64() : 0ull;
#define PG8_STAMP() do { if (STAMP && wid == 0 && nts < 64) { const unsigned long long _c = (unsigned long long)clock64(); \
        ts_lo = (lane == nts) ? (int)(unsigned)_c : ts_lo; ts_hi = (lane == nts) ? (int)(unsigned)(_c >> 32) : ts_hi; ++nts; } } while (0)
    PG8_STAMP();
    unsigned voffA[2], voffB[2];
#pragma unroll
    for (int i = 0; i < 2; ++i) { int R, C; stage_rc(tid * 16 + i * 8192, R, C); const int Rb = Epi::PERM ? ((R & ~31) + perm32(R & 31)) : R;
        voffA[i] = (unsigned)(R * K + C) * 2u; voffB[i] = (unsigned)(Rb * K + C) * 2u; }
    const size_t kstep = (size_t)(BK * 2);
    const size_t hstep = (size_t)HALF * K * 2;
    const size_t tstep = 2 * hstep;
    const unsigned ldsw = (unsigned)wid * 1024u;
    const int aoff = lds_byte(wr * 64 + fr, fq * 8), boff = lds_byte(wc * 32 + fr, fq * 8);
#define PG8_SA(b, h) (((b) * 2 + (h)) * HTB)
#define PG8_SB(b, h) ((4 + (b) * 2 + (h)) * HTB)
#define PG8_STAGE(bufoff, gbase, voff) do { _Pragma("unroll") for (int _i = 0; _i < 2; ++_i) \
        __builtin_amdgcn_global_load_lds((const unsigned*)((const char*)(gbase) + (voff)[_i]), (PG8_LAS unsigned*)(lds + (bufoff) + ldsw + _i * 8192), 16, 0, 0); } while (0)
#define PG8_LDA(dst, b, h) do { _Pragma("unroll") for (int m = 0; m < 4; ++m) _Pragma("unroll") for (int k = 0; k < 2; ++k) dst[m][k] = *(const PG8_LAS bf16x8*)(lds + PG8_SA(b, h) + aoff + m * 2048 + k * 1024); } while (0)
#define PG8_LDB(dst, b, h) do { _Pragma("unroll") for (int n = 0; n < 2; ++n) _Pragma("unroll") for (int k = 0; k < 2; ++k) dst[n][k] = *(const PG8_LAS bf16x8*)(lds + PG8_SB(b, h) + boff + n * 2048 + k * 1024); } while (0)
#define PG8_MMA(ai, bj, At, Bt) do { __builtin_amdgcn_s_setprio(1); _Pragma("unroll") for (int m = 0; m < 4; ++m) _Pragma("unroll") for (int n = 0; n < 2; ++n) _Pragma("unroll") for (int k = 0; k < 2; ++k) \
        acc[ai][bj][m][n] = __builtin_amdgcn_mfma_f32_16x16x32_bf16(Bt[n][k], At[m][k], acc[ai][bj][m][n], 0, 0, 0); __builtin_amdgcn_s_setprio(0); } while (0)
#define PG8_WAIT_V(n) asm volatile("s_waitcnt vmcnt(" #n ")" ::: "memory")
#define PG8_WAIT_L(n) asm volatile("s_waitcnt lgkmcnt(" #n ")" ::: "memory")
#define PG8_BAR __builtin_amdgcn_s_barrier()
#define PG8_SCHED __builtin_amdgcn_sched_barrier(0)
    Unit cur, nxt; int ui = 0;
    if (!S.next(0, cur)) return;
    f32x4 acc[2][2][4][2];
#pragma unroll
    for (int a = 0; a < 2; ++a)
#pragma unroll
        for (int b = 0; b < 2; ++b)
#pragma unroll
            for (int m = 0; m < 4; ++m)
#pragma unroll
                for (int n = 0; n < 2; ++n) acc[a][b][m][n] = (f32x4){0.f, 0.f, 0.f, 0.f};
    bf16x8 At[4][2], B0[2][2], B1[2][2];
    const char* cA = (const char*)g.A + (size_t)cur.pm * tstep; const char* cB = (const char*)g.Bt + (size_t)cur.pn * tstep;
    S.a_ready(cur);
    PG8_STAGE(PG8_SB(0, 0), cB, voffB); PG8_STAGE(PG8_SA(0, 0), cA, voffA); PG8_STAGE(PG8_SB(0, 1), cB + hstep, voffB); PG8_STAGE(PG8_SA(0, 1), cA + hstep, voffA);
    if (wr == 1) PG8_BAR;
    PG8_WAIT_V(4); PG8_BAR;
    PG8_STAGE(PG8_SB(1, 0), cB + kstep, voffB); PG8_STAGE(PG8_SA(1, 0), cA + kstep, voffA); PG8_STAGE(PG8_SB(1, 1), cB + hstep + kstep, voffB);
    PG8_WAIT_V(6); PG8_BAR;
    PG8_STAMP();
    for (;;) {
        const bool has_next = S.next(ui + 1, nxt);
        const char* nA = has_next ? (const char*)g.A + (size_t)nxt.pm * tstep : cA; const char* nB = has_next ? (const char*)g.Bt + (size_t)nxt.pn * tstep : cB;
        for (int t = 0; t < nt; t += 2) {
            const bool last = (t == nt - 2);
            const char* a1 = cA + (size_t)(t + 1) * kstep;
            const char* a2 = last ? nA : cA + (size_t)(t + 2) * kstep; const char* b2 = last ? nB : cB + (size_t)(t + 2) * kstep;
            const char* a3 = a2 + kstep; const char* b3 = b2 + kstep;
            if (last && has_next) S.a_ready(nxt);
            PG8_LDB(B0, 0, 0); PG8_SCHED; PG8_LDA(At, 0, 0); PG8_STAGE(PG8_SA(1, 1), a1 + hstep, voffA);
            PG8_WAIT_L(8); PG8_BAR; PG8_WAIT_L(0); PG8_MMA(0, 0, At, B0); PG8_BAR; PG8_SCHED;
            PG8_LDB(B1, 0, 1); PG8_STAGE(PG8_SB(0, 0), b2, voffB);
            PG8_BAR; PG8_WAIT_L(0); PG8_MMA(0, 1, At, B1); PG8_BAR;
            PG8_LDA(At, 0, 1); PG8_STAGE(PG8_SA(0, 0), a2, voffA);
            PG8_BAR; PG8_WAIT_L(0); PG8_MMA(1, 0, At, B0); PG8_BAR; PG8_SCHED;
            PG8_STAGE(PG8_SB(0, 1), b2 + hstep, voffB);
            PG8_WAIT_V(6); PG8_BAR; PG8_MMA(1, 1, At, B1); PG8_BAR;
            PG8_LDB(B0, 1, 0); PG8_SCHED; PG8_LDA(At, 1, 0); PG8_STAGE(PG8_SA(0, 1), a2 + hstep, voffA);
            PG8_WAIT_L(8); PG8_BAR; PG8_WAIT_L(0); PG8_MMA(0, 0, At, B0); PG8_BAR; PG8_SCHED;
            PG8_LDB(B1, 1, 1); PG8_STAGE(PG8_SB(1, 0), b3, voffB);
            PG8_BAR; PG8_WAIT_L(0); PG8_MMA(0, 1, At, B1); PG8_BAR;
            PG8_LDA(At, 1, 1); PG8_STAGE(PG8_SA(1, 0), a3, voffA);
            PG8_BAR; PG8_WAIT_L(0); PG8_MMA(1, 0, At, B0); PG8_BAR; PG8_SCHED;
            PG8_STAGE(PG8_SB(1, 1), b3 + hstep, voffB);
            PG8_WAIT_V(6); PG8_BAR; PG8_MMA(1, 1, At, B1); PG8_BAR;
        }
        PG8_STAMP();
        if constexpr (!Epi::AFTER_DRAIN) { E(acc, cur, wr, wc, fr, fq); S.done(cur); }
        PG8_STAMP();
        if (!has_next) break;
#pragma unroll
        for (int a = 0; a < 2; ++a)
#pragma unroll
            for (int b = 0; b < 2; ++b)
#pragma unroll
                for (int m = 0; m < 4; ++m)
#pragma unroll
                    for (int n = 0; n < 2; ++n) acc[a][b][m][n] = (f32x4){0.f, 0.f, 0.f, 0.f};
        cur = nxt; cA = nA; cB = nB; ++ui;
    }
    PG8_WAIT_V(0);
    if (wr == 0) PG8_BAR;
    PG8_BAR;
    if constexpr (Epi::AFTER_DRAIN) { E.fused(acc, cur, wr, wc, fr, fq, lds, wid, lane); S.done(cur); }
    PG8_STAMP();
    if (STAMP && wid == 0) { stamps[lane] = lane < nts ? (((unsigned long long)(unsigned)ts_hi << 32) | (unsigned)ts_lo) : 0ull;
        if (lane == 62) stamps[62] = rt_entry; if (lane == 63) stamps[63] = (unsigned long long)wall_clock64(); }
#undef PG8_STAMP
#undef PG8_SA
#undef PG8_SB
#undef PG8_STAGE
#undef PG8_LDA
#undef PG8_LDB
#undef PG8_MMA
#undef PG8_WAIT_V
#undef PG8_WAIT_L
#undef PG8_BAR
#undef PG8_SCHED
}
}

struct SegOrder {
  int seg0, seg1, slot, nb, mode;
  __device__ __forceinline__ bool next(int i, pg8::Unit& u) const {
    const int L = seg0 + slot + i * nb;
    if (L >= seg1) return false;
    if (mode == 0) {
      if (L < 1664) { const int g = L / 208, rem = L % 208; u.pn = rem >> 3; u.pm = 8 * g + (rem & 7); }
      else { const int rem = L - 1664; u.pn = rem >> 1; u.pm = 64 + (rem & 1); }
    } else if (mode == 3) {
      int j;
      if (L < 1280) { const int g = L / 160, rem = L % 160; j = rem >> 3; u.pm = 8 * g + (rem & 7); }
      else { const int rem = L - 1280; j = rem >> 1; u.pm = 64 + (rem & 1); }
      const int grp = (int)((0xCA98754310ull >> (4 * (j >> 1))) & 15ull);
      u.pn = 2 * grp + (j & 1);
    } else {
      const int per = (mode == 1) ? 96 : 32;
      const int g = L / per, rem = L % per;
      u.pn = rem >> 3; u.pm = 8 * g + (rem & 7);
    }
    return true;
  }
  __device__ __forceinline__ void a_ready(const pg8::Unit&) const {}
  __device__ __forceinline__ void done(const pg8::Unit&) const {}
};
__device__ __forceinline__ SegOrder make_order(int total, int mode) {
  SegOrder S;
  const bool xs = (gridDim.x & 7) == 0;
  const int nx = xs ? 8 : 1, xcd = xs ? (blockIdx.x & 7) : 0;
  S.nb = xs ? (gridDim.x >> 3) : gridDim.x;
  S.slot = xs ? (blockIdx.x >> 3) : blockIdx.x;
  S.seg0 = (total * xcd) / nx; S.seg1 = (total * (xcd + 1)) / nx; S.mode = mode;
  return S;
}

struct EpiS2 {
  static constexpr bool PERM = true, AFTER_DRAIN = false;
  const Params& p; const float* rope;
  __device__ __forceinline__ void operator()(const pg8::f32x4 (&acc)[2][2][4][2], const pg8::Unit& u, int wr, int wc, int fr, int fq) const {
    const int row0 = u.pm * 256;
    const bool latent = row0 < 16384;
    const int b = latent ? (row0 >> 13) : ((row0 - 16384) >> 8);
    const int keybase = latent ? (row0 & 8191) : 8192;
    const int grp = u.pn >> 1;
    const int fo0 = (u.pn & 1) * 256 + 32 * wc + 8 * fq;
    gu16* D = (gu16*)piece(p, grp);
    const gfloat* ropeg = (const gfloat*)rope;
    if (grp == P_VTA || grp == P_VTB || grp == P_VTC) {
      const int ps = perm16(fr);
#pragma unroll
      for (int ai = 0; ai < 2; ++ai)
#pragma unroll
        for (int m = 0; m < 4; ++m) {
          gu16* kp = D + (size_t)(b * 512 + fo0) * NKEY + keybase + 128 * ai + 64 * wr + 16 * m + ps;
          asm volatile("" : "+v"(kp));
#pragma unroll
          for (int bj = 0; bj < 2; ++bj)
#pragma unroll
            for (int n = 0; n < 2; ++n)
#pragma unroll
              for (int i = 0; i < 4; ++i) kp[(size_t)(128 * bj + 4 * n + i) * NKEY] = f2bf(acc[ai][bj][m][n][i]);
        }
    } else {
      const bool rot = latent && (grp == P_QA || grp == P_KA);
      const float qs = (grp == P_QA || grp == P_QC) ? 0.18033688011112042f : 1.f;
#pragma unroll
      for (int ai = 0; ai < 2; ++ai)
#pragma unroll
        for (int m = 0; m < 4; ++m) {
          const int row = row0 + 128 * ai + 64 * wr + 16 * m + fr;
          gu16* rp = D + (size_t)row * 512 + fo0;
          asm volatile("" : "+v"(rp));
          float cs[4] = {1.f, 1.f, 1.f, 1.f}, sn[4] = {0.f, 0.f, 0.f, 0.f};
          if (rot) {
            const int t = row & 8191;
            const int vv = (wc & 1) ? (t & 63) : (t >> 6);
            const v4f c01 = *(const gv4f*)(ropeg + (vv * 16 + 4 * fq) * 2);
            const v4f c23 = *(const gv4f*)(ropeg + (vv * 16 + 4 * fq) * 2 + 4);
            cs[0] = c01[0]; sn[0] = c01[1]; cs[1] = c01[2]; sn[1] = c01[3];
            cs[2] = c23[0]; sn[2] = c23[1]; cs[3] = c23[2]; sn[3] = c23[3];
          }
#pragma unroll
          for (int bj = 0; bj < 2; ++bj) {
            float o0[4], o1[4];
#pragma unroll
            for (int i = 0; i < 4; ++i) {
              const float x1 = acc[ai][bj][m][0][i], x2 = acc[ai][bj][m][1][i];
              o0[i] = (x1 * cs[i] - x2 * sn[i]) * qs;
              o1[i] = (x1 * sn[i] + x2 * cs[i]) * qs;
            }
            v4u a;
            a[0] = pk2(o0[0], o0[1]); a[1] = pk2(o0[2], o0[3]);
            a[2] = pk2(o1[0], o1[1]); a[3] = pk2(o1[2], o1[3]);
            *(GAS v4u*)(rp + 128 * bj) = a;
          }
        }
    }
  }
};

struct EpiVT {
  static constexpr bool PERM = false, AFTER_DRAIN = false;
  const Params& p;
  __device__ __forceinline__ void operator()(const pg8::f32x4 (&acc)[2][2][4][2], const pg8::Unit& u, int wr, int wc, int fr, int fq) const {
    const int grp = u.pm >> 1;
    const bool latent = u.pn < 64;
    const int b = latent ? (u.pn >> 5) : (u.pn - 64);
    const int keybase = latent ? ((u.pn & 31) * 256) : 8192;
    gu16* D = (gu16*)piece(p, grp);
    const int cq = ((fq & 1) << 1) | (fq >> 1);
#pragma unroll
    for (int ai = 0; ai < 2; ++ai)
#pragma unroll
      for (int m = 0; m < 4; ++m) {
        const int f = (u.pm & 1) * 256 + 128 * ai + 64 * wr + 16 * m + fr;
        gu16* rp = D + (size_t)(b * 512 + f) * NKEY + keybase + 32 * wc + 4 * cq;
        asm volatile("" : "+v"(rp));
#pragma unroll
        for (int bj = 0; bj < 2; ++bj)
#pragma unroll
          for (int n = 0; n < 2; ++n) {
            const pg8::f32x4 v = acc[ai][bj][m][n];
            v2u o;
            o[0] = pk2(v[0], v[1]); o[1] = pk2(v[2], v[3]);
            *(gv2u*)(rp + 128 * bj + 16 * n) = o;
          }
      }
  }
};

struct VtOrder {
  int seg0, seg1, slot, nb;
  __device__ __forceinline__ bool next(int i, pg8::Unit& u) const {
    const int L = seg0 + slot + i * nb;
    if (L >= seg1) return false;
    int j6, rt;
    if (L < 384) { const int g = L / 48, rem = L % 48; j6 = rem >> 3; rt = 8 * g + (rem & 7); }
    else { const int rem = L - 384; j6 = rem >> 1; rt = 64 + (rem & 1); }
    const int grp = (j6 >> 1) == 0 ? P_VTA : ((j6 >> 1) == 1 ? P_VTB : P_VTC);
    u.pm = 2 * grp + (j6 & 1); u.pn = rt;
    return true;
  }
  __device__ __forceinline__ void a_ready(const pg8::Unit&) const {}
  __device__ __forceinline__ void done(const pg8::Unit&) const {}
};

struct EpiS6a {
  static constexpr bool PERM = true, AFTER_DRAIN = false;
  u16* G;
  __device__ __forceinline__ void operator()(const pg8::f32x4 (&acc)[2][2][4][2], const pg8::Unit& u, int wr, int wc, int fr, int fq) const {
    gu16* Gn = (gu16*)G + (size_t)(u.pn >> 2) * R_TOT * 1024;
    const int d0 = (u.pn & 3) * 256 + 32 * wc + 8 * fq;
#pragma unroll
    for (int ai = 0; ai < 2; ++ai)
#pragma unroll
      for (int m = 0; m < 4; ++m) {
        gu16* rp = Gn + (size_t)(u.pm * 256 + 128 * ai + 64 * wr + 16 * m + fr) * 1024 + d0;
        asm volatile("" : "+v"(rp));
#pragma unroll
        for (int bj = 0; bj < 2; ++bj) {
          const pg8::f32x4 v0 = acc[ai][bj][m][0], v1 = acc[ai][bj][m][1];
          v4u o;
          o[0] = pk2(sigmoid_f(v0[0]), sigmoid_f(v0[1]));
          o[1] = pk2(sigmoid_f(v0[2]), sigmoid_f(v0[3]));
          o[2] = pk2(sigmoid_f(v1[0]), sigmoid_f(v1[1]));
          o[3] = pk2(sigmoid_f(v1[2]), sigmoid_f(v1[3]));
          *(GAS v4u*)(rp + 128 * bj) = o;
        }
      }
  }
};

struct EpiS7 {
  static constexpr bool PERM = false, AFTER_DRAIN = false;
  const float* xsrc; float* xdst; const float* gate;
  const float* mod;
  __device__ __forceinline__ void operator()(const pg8::f32x4 (&acc)[2][2][4][2], const pg8::Unit& u, int wr, int wc, int fr, int fq) const {
    const int row0 = u.pm * 256;
    const gfloat* gp = (const gfloat*)mod + which_of(row0) * 3072 + 2048 + u.pn * 256 + 32 * wc + 4 * fq;
    v4f gv[2][2];
#pragma unroll
    for (int bj = 0; bj < 2; ++bj)
#pragma unroll
      for (int n = 0; n < 2; ++n) gv[bj][n] = *(const gv4f*)(gp + 128 * bj + 16 * n);
#pragma unroll
    for (int ai = 0; ai < 2; ++ai)
#pragma unroll
      for (int m = 0; m < 4; ++m) {
        const size_t off = (size_t)(row0 + 128 * ai + 64 * wr + 16 * m + fr) * 1024 + u.pn * 256 + 32 * wc + 4 * fq;
        const gfloat* sp = (const gfloat*)xsrc + off;
        gfloat* dp = (gfloat*)xdst + off;
        asm volatile("" : "+v"(sp), "+v"(dp));
#pragma unroll
        for (int bj = 0; bj < 2; ++bj)
#pragma unroll
          for (int n = 0; n < 2; ++n) {
            const v4f xv = *(const gv4f*)(sp + 128 * bj + 16 * n);
            const pg8::f32x4 a = acc[ai][bj][m][n];
            v4f o;
#pragma unroll
            for (int i = 0; i < 4; ++i) o[i] = xv[i] + gv[bj][n][i] * a[i];
            *(gv4f*)(dp + 128 * bj + 16 * n) = o;
          }
      }
  }
};

__device__ __forceinline__ void s2_store64(const Params& p, int grp, const f32x16& a0, const f32x16& a1, int rowbase, int fb64,
                                           bool latent, int b, int keyb, int r, int hh, const float* __restrict__ rope) {
  if (grp == P_VTA || grp == P_VTB || grp == P_VTC) {
    gu16* VT = (gu16*)piece(p, grp);
#pragma unroll
    for (int j = 0; j < 2; ++j) {
      const int f = fb64 + 32 * j + r;
#pragma unroll
      for (int q = 0; q < 4; ++q) {
        const int key = keyb + 16 * (q >> 1) + 4 * (hh * 2 + (q & 1));
        v2u pk;
        if (j == 0) { pk[0] = pk2(a0[4 * q], a0[4 * q + 1]); pk[1] = pk2(a0[4 * q + 2], a0[4 * q + 3]); }
        else { pk[0] = pk2(a1[4 * q], a1[4 * q + 1]); pk[1] = pk2(a1[4 * q + 2], a1[4 * q + 3]); }
        *(gv2u*)(VT + ((size_t)(b * 512 + f)) * NKEY + key) = pk;
      }
    }
  } else {
    gu16* D = (gu16*)piece(p, grp);
    const bool rot = latent && (grp == P_QA || grp == P_KA);
    const float qs = (grp == P_QA || grp == P_QC) ? 0.18033688011112042f : 1.f;
#pragma unroll
    for (int e = 0; e < 16; ++e) {
      const int row = rowbase + (e & 3) + 8 * (e >> 2) + 4 * hh;
      float v0 = a0[e], v1 = a1[e];
      if (rot) {
        const int t = row & 8191;
        const int vv = (r < 16) ? (t >> 6) : (t & 63);
        const float cs = rope[(vv * 16 + (r & 15)) * 2], sn = rope[(vv * 16 + (r & 15)) * 2 + 1];
        const float o0 = v0 * cs - v1 * sn, o1 = v0 * sn + v1 * cs;
        v0 = o0; v1 = o1;
      }
      D[(size_t)row * 512 + fb64 + r] = f2bf(v0 * qs);
      D[(size_t)row * 512 + fb64 + 32 + r] = f2bf(v1 * qs);
    }
  }
}

__device__ __attribute__((always_inline)) void phase_s2(const Params& p, int l, unsigned char* smem) {
  const int tid = opaque_tid(), lane = tid & 63, wave = tid >> 6;
  const int wm = wave >> 1, wn = wave & 1, r = lane & 31, hh = lane >> 5;
  const u16* H = (const u16*)(p.ws + WS_H);
  const u16* WTI = (const u16*)(p.ws + WS_WT_IN);
  const float* rope = (const float*)(p.ws + WS_ROPE);
  float* G = (float*)(p.ws + WS_G);
  {
    const pg8::Gemm g{H, WTI, R_TOT, 6656, 1024};
    const SegOrder S = make_order(1320, 3);
    const EpiS2 E{p, rope};
    pg8::gemm_phase<EpiS2, SegOrder, false>((PG8_LAS unsigned char*)smem, g, S, E, nullptr);
  }
  {
    const pg8::Gemm g{WTI, H, 6656, R_TOT, 1024};
    const bool xs = (gridDim.x & 7) == 0;
    VtOrder S;
    const int nx = xs ? 8 : 1, xcd = xs ? (blockIdx.x & 7) : 0;
    S.nb = xs ? (gridDim.x >> 3) : gridDim.x;
    S.slot = xs ? (S.nb - 1 - (int)(blockIdx.x >> 3)) : blockIdx.x;
    S.seg0 = (396 * xcd) / nx; S.seg1 = (396 * (xcd + 1)) / nx;
    const EpiVT E{p};
    pg8::gemm_phase<EpiVT, VtOrder, false>((PG8_LAS unsigned char*)smem, g, S, E, nullptr);
  }
#pragma unroll 1
  for (int rt = (blockIdx.x + gridDim.x - 40) % gridDim.x; rt < 132; rt += gridDim.x) {
    const int row0 = rt * 128;
    f32x16 acc[1][2];
    acc[0][0] = zero16(); acc[0][1] = zero16();
    gemm_core<0, 1>(acc, H + (size_t)row0 * 1024, 1024, nullptr, nullptr, nullptr, nullptr, WTI + (size_t)9728 * 1024, 1024, smem);
    if (wn == 0) {
#pragma unroll
      for (int e = 0; e < 16; ++e) {
        const int row = row0 + 32 * wm + (e & 3) + 8 * (e >> 2) + 4 * hh;
        if (r < 16) G[(size_t)row * 16 + r] = acc[0][0][e];
      }
    }
  }
}

__device__ __attribute__((always_inline)) void attn_item(const Params& p, int l, int b, int h, int qgrow0, int kt0, int kt1, unsigned char* smem) {
  u16* Ks = (u16*)smem;
  u16* Vs = (u16*)(smem + 34816);
  const int tid = opaque_tid(), lane = tid & 63, wave = tid >> 6;
  const int c = wave & 1, qg = wave >> 1, r = lane & 31, hh = lane >> 5;
  u16* QA = piece(p, P_QA);
  const u16* KA = piece(p, P_KA);
  const u16* VT = piece(p, P_VTA);
  const u16* ZA = piece(p, P_ZA);
  const float lam_init = 0.8f - 0.6f * expf(-0.3f * (float)l);
  float lam;
  {
    const float* lq = p.lam_q + l * 128;
    const float* lk = p.lam_k + l * 128;
    const float s0 = wave_sum(lq[lane] * lk[lane]);
    const float s1 = wave_sum(lq[64 + lane] * lk[64 + lane]);
    lam = expf(s0) - expf(s1) + lam_init;
  }
  const int qrow = qgrow0 + qg * 32 + r;
  bf16x8 qf[4];
#pragma unroll
  for (int ks = 0; ks < 4; ++ks) qf[ks] = *(const bf16x8*)(QA + (size_t)qrow * 512 + h * 128 + c * 64 + ks * 16 + hh * 8);
  f32x16 O[4];
#pragma unroll
  for (int i = 0; i < 4; ++i) O[i] = zero16();
  float m = -1e30f, lsum = 0.f;
  const int krow_l = tid >> 4, kc16 = tid & 15;
  const int vrow_l = tid >> 3, vc8 = tid & 7;
  v4u rk[2], rv[2];
#define ATT_LOADK(kt)                                                                             \
  {                                                                                               \
    const int key0 = (kt) * 64;                                                                   \
    const int gbase = (key0 < 8192) ? (b * 8192 + key0) : (16384 + b * 256 + key0 - 8192);        \
    _Pragma("unroll") for (int i = 0; i < 2; ++i)                                                 \
      rk[i] = *(const v4u*)(KA + (size_t)(gbase + krow_l + 32 * i) * 512 + h * 128 + kc16 * 8);   \
  }
#define ATT_LOADV(kt)                                                                             \
  {                                                                                               \
    const int key0 = (kt) * 64;                                                                   \
    _Pragma("unroll") for (int i = 0; i < 2; ++i)                                                 \
      rv[i] = *(const v4u*)(VT + ((size_t)(b * 512 + h * 128 + vrow_l + 64 * i)) * NKEY + key0 + vc8 * 8); \
  }
#define ATT_STOREK(buf)                                                                           \
  {                                                                                               \
    _Pragma("unroll") for (int i = 0; i < 2; ++i)                                                 \
      *(v4u*)(Ks + (buf) * 64 * 136 + (krow_l + 32 * i) * 136 + kc16 * 8) = rk[i];                \
  }
#define ATT_STOREV(buf)                                                                           \
  {                                                                                               \
    _Pragma("unroll") for (int i = 0; i < 2; ++i)                                                 \
      *(v4u*)(Vs + (buf) * 128 * 72 + (vrow_l + 64 * i) * 72 + vc8 * 8) = rv[i];                  \
  }
#define ATT_QK(Sx, buf)                                                                           \
  {                                                                                               \
    _Pragma("unroll") for (int kk = 0; kk < 2; ++kk) {                                            \
      Sx[kk] = zero16();                                                                          \
      _Pragma("unroll") for (int ks = 0; ks < 4; ++ks) {                                          \
        const bf16x8 kf = *(const bf16x8*)(Ks + (buf) * 64 * 136 + (32 * kk + r) * 136 + c * 64 + ks * 16 + hh * 8); \
        Sx[kk] = mfma32(kf, qf[ks], Sx[kk]);                                                      \
      }                                                                                           \
    }                                                                                             \
  }
  ATT_LOADK(kt0);
  ATT_LOADV(kt0);
  ATT_STOREK(0);
  ATT_STOREV(0);
  if (kt0 + 1 < kt1) { ATT_LOADK(kt0 + 1); ATT_STOREK(1); }
  __syncthreads();
  f32x16 S[2], Sn[2];
  ATT_QK(S, 0);
  if (kt0 + 2 < kt1) ATT_LOADK(kt0 + 2);
  if (kt0 + 1 < kt1) ATT_LOADV(kt0 + 1);
  if (wave < 4) {
  for (int kt = kt0; kt < kt1; ++kt) {
    const int cur = (kt - kt0) & 1;
    if (kt + 1 < kt1) ATT_QK(Sn, cur ^ 1);
    float mx = -1e30f;
#pragma unroll
    for (int kk = 0; kk < 2; ++kk)
#pragma unroll
      for (int e = 0; e < 16; ++e) mx = fmaxf(mx, S[kk][e]);
    mx = fmaxf(mx, __shfl_xor(mx, 32, 64));
    const float mnew = fmaxf(m, mx);
    if (__builtin_amdgcn_ballot_w64(mnew > m) != 0ull) {
      const float alpha = ex2(m - mnew);
      lsum *= alpha;
#pragma unroll
      for (int i = 0; i < 4; ++i)
#pragma unroll
        for (int e = 0; e < 16; ++e) O[i][e] *= alpha;
    }
    m = mnew;
    bf16x8 pf[4];
#pragma unroll
    for (int kk = 0; kk < 2; ++kk)
#pragma unroll
      for (int s2 = 0; s2 < 2; ++s2) {
        v4u pkd;
#pragma unroll
        for (int jj = 0; jj < 4; ++jj) {
          const float p0 = ex2(S[kk][8 * s2 + 2 * jj] - mnew);
          const float p1 = ex2(S[kk][8 * s2 + 2 * jj + 1] - mnew);
          lsum += p0 + p1;
          pkd[jj] = pk2(p0, p1);
        }
        pf[2 * kk + s2] = (bf16x8)pkd;
      }
#pragma unroll
    for (int dvt = 0; dvt < 4; ++dvt)
#pragma unroll
      for (int s = 0; s < 4; ++s) {
        const bf16x8 vf = *(const bf16x8*)(Vs + cur * 128 * 72 + (32 * dvt + r) * 72 + 16 * s + 8 * hh);
        O[dvt] = mfma32(vf, pf[s], O[dvt]);
      }
    if (kt + 2 < kt1) ATT_STOREK(cur);
    if (kt + 1 < kt1) ATT_STOREV(cur ^ 1);
    if (kt + 3 < kt1) ATT_LOADK(kt + 3);
    if (kt + 2 < kt1) ATT_LOADV(kt + 2);
    __syncthreads();
    S[0] = Sn[0];
    S[1] = Sn[1];
  }
  } else {
  for (int kt = kt0; kt < kt1; ++kt) {
    const int cur = (kt - kt0) & 1;
    float mx = -1e30f;
#pragma unroll
    for (int kk = 0; kk < 2; ++kk)
#pragma unroll
      for (int e = 0; e < 16; ++e) mx = fmaxf(mx, S[kk][e]);
    mx = fmaxf(mx, __shfl_xor(mx, 32, 64));
    const float mnew = fmaxf(m, mx);
    if (__builtin_amdgcn_ballot_w64(mnew > m) != 0ull) {
      const float alpha = ex2(m - mnew);
      lsum *= alpha;
#pragma unroll
      for (int i = 0; i < 4; ++i)
#pragma unroll
        for (int e = 0; e < 16; ++e) O[i][e] *= alpha;
    }
    m = mnew;
    bf16x8 pf[4];
#pragma unroll
    for (int kk = 0; kk < 2; ++kk)
#pragma unroll
      for (int s2 = 0; s2 < 2; ++s2) {
        v4u pkd;
#pragma unroll
        for (int jj = 0; jj < 4; ++jj) {
          const float p0 = ex2(S[kk][8 * s2 + 2 * jj] - mnew);
          const float p1 = ex2(S[kk][8 * s2 + 2 * jj + 1] - mnew);
          lsum += p0 + p1;
          pkd[jj] = pk2(p0, p1);
        }
        pf[2 * kk + s2] = (bf16x8)pkd;
      }
    if (kt + 1 < kt1) ATT_QK(Sn, cur ^ 1);
#pragma unroll
    for (int dvt = 0; dvt < 4; ++dvt)
#pragma unroll
      for (int s = 0; s < 4; ++s) {
        const bf16x8 vf = *(const bf16x8*)(Vs + cur * 128 * 72 + (32 * dvt + r) * 72 + 16 * s + 8 * hh);
        O[dvt] = mfma32(vf, pf[s], O[dvt]);
      }
    if (kt + 2 < kt1) ATT_STOREK(cur);
    if (kt + 1 < kt1) ATT_STOREV(cur ^ 1);
    if (kt + 3 < kt1) ATT_LOADK(kt + 3);
    if (kt + 2 < kt1) ATT_LOADV(kt + 2);
    __syncthreads();
    S[0] = Sn[0];
    S[1] = Sn[1];
  }
  }
#undef ATT_LOADK
#undef ATT_LOADV
#undef ATT_STOREK
#undef ATT_STOREV
#undef ATT_QK
  const float ltot = lsum + __shfl_xor(lsum, 32, 64);
  const float inv = 1.f / ltot;
  float* X = (float*)smem;
  if (c == 1) {
#pragma unroll
    for (int dvt = 0; dvt < 4; ++dvt)
#pragma unroll
      for (int e = 0; e < 16; ++e) X[(qg * 128 + 32 * dvt + (e & 3) + 8 * (e >> 2) + 4 * hh) * 32 + r] = O[dvt][e] * inv;
  }
  __syncthreads();
  if (c == 0) {
    float ss = 0.f;
#pragma unroll
    for (int dvt = 0; dvt < 4; ++dvt)
#pragma unroll
      for (int e = 0; e < 16; ++e) {
        const float o = O[dvt][e] * inv - lam * X[(qg * 128 + 32 * dvt + (e & 3) + 8 * (e >> 2) + 4 * hh) * 32 + r];
        O[dvt][e] = o;
        ss += o * o;
      }
    ss += __shfl_xor(ss, 32, 64);
    const float rinv = rsqrtf(ss * (1.f / 128.f) + 1e-6f) * (1.f - lam_init);
    const float* dg = p.da_g + l * 128;
#pragma unroll
    for (int dvt = 0; dvt < 4; ++dvt)
#pragma unroll
      for (int g = 0; g < 4; ++g) {
        const int dv0 = 32 * dvt + 8 * g + 4 * hh;
        const size_t off = (size_t)qrow * 512 + h * 128 + dv0;
        const v2u z = *(const v2u*)(ZA + off);
        const float y0 = O[dvt][4 * g] * rinv * dg[dv0] * silu_f(bflo(z[0]));
        const float y1 = O[dvt][4 * g + 1] * rinv * dg[dv0 + 1] * silu_f(bfhi(z[0]));
        const float y2 = O[dvt][4 * g + 2] * rinv * dg[dv0 + 2] * silu_f(bflo(z[1]));
        const float y3 = O[dvt][4 * g + 3] * rinv * dg[dv0 + 3] * silu_f(bfhi(z[1]));
        v2u o;
        o[0] = pk2(y0, y1);
        o[1] = pk2(y2, y3);
        *(v2u*)(QA + off) = o;
      }
  }
  __syncthreads();
}

__device__ __attribute__((always_inline)) void natten_item(const Params& p, int l, int b, int rr, int qgrow, int i0, unsigned char* smem) {
  float* rp = (float*)smem;
  const int tid = opaque_tid(), lane = tid & 63, head = tid >> 6;
  const int r = lane & 31, hh = lane >> 5;
  for (int i = tid; i < 3720; i += NTHR) rp[i] = p.rpb[(size_t)l * 3720 + i];
  __syncthreads();
  u16* QC = piece(p, P_QC);
  const u16* KC = piece(p, P_KC);
  const u16* VT = piece(p, P_VTC);
  const u16* ZC = piece(p, P_ZC);
  const int rs = min(max(rr - 4, 0), 120);
  bf16x8 qf[2][4];
#pragma unroll
  for (int qt = 0; qt < 2; ++qt)
#pragma unroll
    for (int ks = 0; ks < 4; ++ks)
      qf[qt][ks] = *(const bf16x8*)(QC + (size_t)(qgrow + 32 * qt + r) * 512 + head * 64 + ks * 16 + hh * 8);
  f32x16 O[2][2];
  O[0][0] = zero16(); O[0][1] = zero16(); O[1][0] = zero16(); O[1][1] = zero16();
  float m[2] = {-1e30f, -1e30f}, lsum[2] = {0.f, 0.f};
  const float L2E = 1.4426950408889634f;
  bf16x8 kfn[2][4];
  {
    const int kgp = (i0 < 8) ? (b * 8192 + (rs + i0) * 64) : (16384 + b * 256 + (i0 - 8) * 64);
#pragma unroll
    for (int kk = 0; kk < 2; ++kk)
#pragma unroll
      for (int ks = 0; ks < 4; ++ks)
        kfn[kk][ks] = *(const bf16x8*)(KC + (size_t)(kgp + 32 * kk + r) * 512 + head * 64 + ks * 16 + hh * 8);
  }
#pragma unroll 1
  for (int i = i0; i < 12; ++i) {
    const bool local = i < 8;
    const int krow = rs + i;
    const int key0 = local ? krow * 64 : 8192 + (i - 8) * 64;
    bf16x8 kfc[2][4];
#pragma unroll
    for (int kk = 0; kk < 2; ++kk)
#pragma unroll
      for (int ks = 0; ks < 4; ++ks) kfc[kk][ks] = kfn[kk][ks];
    if (i + 1 < 12) {
      const int kg1 = (i + 1 < 8) ? (b * 8192 + (krow + 1) * 64) : (16384 + b * 256 + (i - 7) * 64);
#pragma unroll
      for (int kk = 0; kk < 2; ++kk)
#pragma unroll
        for (int ks = 0; ks < 4; ++ks)
          kfn[kk][ks] = *(const bf16x8*)(KC + (size_t)(kg1 + 32 * kk + r) * 512 + head * 64 + ks * 16 + hh * 8);
    }
    f32x16 S[2][2];
    S[0][0] = zero16(); S[0][1] = zero16(); S[1][0] = zero16(); S[1][1] = zero16();
#pragma unroll
    for (int kk = 0; kk < 2; ++kk)
#pragma unroll
      for (int ks = 0; ks < 4; ++ks) {
        S[kk][0] = mfma32(kfc[kk][ks], qf[0][ks], S[kk][0]);
        S[kk][1] = mfma32(kfc[kk][ks], qf[1][ks], S[kk][1]);
      }
    bf16x8 pf[2][4];
#pragma unroll
    for (int qt = 0; qt < 2; ++qt) {
      const int qcol = 32 * qt + r;
      const int cs = min(max(qcol - 8, 0), 48);
      const float* rprow = rp + (head * 15 + (local ? (krow - rr + 7) : 0)) * 31 + 15 - qcol;
      float mx = -1e30f;
#pragma unroll
      for (int kk = 0; kk < 2; ++kk)
#pragma unroll
        for (int e = 0; e < 16; ++e) {
          const int kcol = 32 * kk + (e & 3) + 8 * (e >> 2) + 4 * hh;
          float s = S[kk][qt][e];
          if (local) {
            const bool valid = (kcol >= cs) && (kcol < cs + 16);
            const int ci = min(max(kcol, cs), cs + 15);
            s = valid ? (s + rprow[ci] * L2E) : -1e30f;
          }
          S[kk][qt][e] = s;
          mx = fmaxf(mx, s);
        }
      mx = fmaxf(mx, __shfl_xor(mx, 32, 64));
      const float mnew = fmaxf(m[qt], mx);
      if (__builtin_amdgcn_ballot_w64(mnew > m[qt]) != 0ull) {
        const float alpha = ex2(m[qt] - mnew);
        lsum[qt] *= alpha;
#pragma unroll
        for (int dvt = 0; dvt < 2; ++dvt)
#pragma unroll
          for (int e = 0; e < 16; ++e) O[dvt][qt][e] *= alpha;
      }
      m[qt] = mnew;
#pragma unroll
      for (int kk = 0; kk < 2; ++kk)
#pragma unroll
        for (int s2 = 0; s2 < 2; ++s2) {
          v4u pkd;
#pragma unroll
          for (int jj = 0; jj < 4; ++jj) {
            const float p0 = ex2(S[kk][qt][8 * s2 + 2 * jj] - mnew);
            const float p1 = ex2(S[kk][qt][8 * s2 + 2 * jj + 1] - mnew);
            lsum[qt] += p0 + p1;
            pkd[jj] = pk2(p0, p1);
          }
          pf[qt][2 * kk + s2] = (bf16x8)pkd;
        }
    }
#pragma unroll
    for (int dvt = 0; dvt < 2; ++dvt)
#pragma unroll
      for (int s = 0; s < 4; ++s) {
        const bf16x8 vf = *(const bf16x8*)(VT + ((size_t)(b * 512 + head * 64 + 32 * dvt + r)) * NKEY + key0 + 16 * s + 8 * hh);
        O[dvt][0] = mfma32(vf, pf[0][s], O[dvt][0]);
        O[dvt][1] = mfma32(vf, pf[1][s], O[dvt][1]);
      }
  }
#pragma unroll
  for (int qt = 0; qt < 2; ++qt) {
    const float inv = 1.f / (lsum[qt] + __shfl_xor(lsum[qt], 32, 64));
    const int qrow = qgrow + 32 * qt + r;
#pragma unroll
    for (int dvt = 0; dvt < 2; ++dvt)
#pragma unroll
      for (int g = 0; g < 4; ++g) {
        const int dv0 = 32 * dvt + 8 * g + 4 * hh;
        const size_t off = (size_t)qrow * 512 + head * 64 + dv0;
        const v2u z = *(const v2u*)(ZC + off);
        v2u o;
        o[0] = pk2(O[dvt][qt][4 * g] * inv * silu_f(bflo(z[0])), O[dvt][qt][4 * g + 1] * inv * silu_f(bfhi(z[0])));
        o[1] = pk2(O[dvt][qt][4 * g + 2] * inv * silu_f(bflo(z[1])), O[dvt][qt][4 * g + 3] * inv * silu_f(bfhi(z[1])));
        *(v2u*)(QC + off) = o;
      }
  }
  __syncthreads();
}

__device__ __forceinline__ float logsigmoid_f(float x) { return fminf(x, 0.f) - log1pf(__expf(-fabsf(x))); }
__device__ __forceinline__ int chunk_grow0(int b, int P) { return P < 2 ? 16384 + b * 256 + 128 * P : b * 8192 + 128 * (P - 2); }
__device__ __forceinline__ int chunk_key0(int P) { return P < 2 ? 8192 + 128 * P : 128 * (P - 2); }

__device__ __forceinline__ void mlstm_gates(const Params& p, int l, int head, int grow0, float* lf, float* li) {
  const int tid = opaque_tid();
  if (tid < 256) {
    const int d = tid >> 7, s = tid & 127;
    const float* G = (const float*)(p.ws + WS_G) + (size_t)(grow0 + s) * 16;
    const float gi = G[d * 8 + head] + p.gate_b[l * 16 + d * 8 + head];
    const float gf = G[d * 8 + 4 + head] + p.gate_b[l * 16 + d * 8 + 4 + head];
    li[d * 128 + s] = gi;
    lf[d * 128 + s] = logsigmoid_f(gf);
  }
}

__device__ __forceinline__ void conv8(const Params& p, int l, const u16* src, int grow, int fcol, int ch0, bool hasprev,
                                      bool hasnext, float scale, float (&o)[8]) {
  const v4u zero = {0u, 0u, 0u, 0u};
  const v4u xm = hasprev ? *(const v4u*)(src + (size_t)(grow - 1) * 512 + fcol) : zero;
  const v4u x0 = *(const v4u*)(src + (size_t)grow * 512 + fcol);
  const v4u xp = hasnext ? *(const v4u*)(src + (size_t)(grow + 1) * 512 + fcol) : zero;
  const float* cw = p.conv_w + (size_t)l * 3 * 1024 + ch0;
  const float* cb = p.conv_b + (size_t)l * 1024 + ch0;
#pragma unroll
  for (int e = 0; e < 8; ++e) {
    const float a = (e & 1) ? bfhi(xm[e >> 1]) : bflo(xm[e >> 1]);
    const float bq = (e & 1) ? bfhi(x0[e >> 1]) : bflo(x0[e >> 1]);
    const float cq = (e & 1) ? bfhi(xp[e >> 1]) : bflo(xp[e >> 1]);
    const float y = a * cw[e] + bq * cw[1024 + e] + cq * cw[2048 + e] + cb[e];
    o[e] = silu_f(y) * scale;
  }
}

__device__ __attribute__((always_inline)) void mlstm_b1_item(const Params& p, int l, int b, int head, int P, unsigned char* smem) {
  u16* kwT = (u16*)smem;
  float* lf = (float*)(smem + 69632);
  float* li = lf + 256;
  float* wS = li + 256;
  const int tid = opaque_tid(), lane = tid & 63, wave = tid >> 6;
  const int r = lane & 31, hh = lane >> 5;
  const int grow0 = chunk_grow0(b, P), key0 = chunk_key0(P);
  float* BL = (float*)(p.ws + WS_BL);
  float* DN = (float*)(p.ws + WS_DN);
  u16* CST = (u16*)(p.ws + WS_H);
  bf16x8 vf[8];
  {
    const int dvt0 = wave & 3;
    const u16* VT0 = piece(p, P_VTB);
#pragma unroll
    for (int s8 = 0; s8 < 8; ++s8)
      vf[s8] = *(const bf16x8*)(VT0 + ((size_t)(b * 512 + head * 128 + 32 * dvt0 + r)) * NKEY + key0 + 16 * s8 + 8 * hh);
  }
  mlstm_gates(p, l, head, grow0, lf, li);
  __syncthreads();
  if (tid < 256) {
    const int d = tid >> 7, s = tid & 127;
    float tot = 0.f, bs = 0.f;
    for (int j = 0; j < 128; ++j) {
      const float v = lf[d * 128 + j];
      tot += v;
      if (d == 0 ? (j <= s) : (j >= s)) bs += v;
    }
    wS[d * 128 + s] = __expf(tot - bs + li[d * 128 + s]);
    if (s == 0) BL[((b * 4 + head) * 2 + d) * 66 + P] = tot;
  }
  __syncthreads();
  const u16* KB = piece(p, P_KB);
#pragma unroll 1
  for (int i = 0; i < 4; ++i) {
    const int u = tid + NTHR * i;
    const int s = u >> 4, dg = u & 15;
    const bool hasprev = !((P == 0 || P == 2) && s == 0);
    const bool hasnext = !((P == 1 || P == 65) && s == 127);
    float kc[8];
    conv8(p, l, KB, grow0 + s, head * 128 + dg * 8, 512 + head * 128 + dg * 8, hasprev, hasnext, 0.08838834764831845f, kc);
    const int ps = perm16(s);
    const float w0 = wS[s], w1 = wS[128 + s];
#pragma unroll
    for (int e = 0; e < 8; ++e) {
      kwT[(dg * 8 + e) * 136 + ps] = f2bf(kc[e] * w0);
      kwT[(128 + dg * 8 + e) * 136 + ps] = f2bf(kc[e] * w1);
    }
  }
  __syncthreads();
  {
    const int d = wave >> 2, dvt = wave & 3;
    const int chain = (b * 4 + head) * 2 + d;
    u16* dst = CST + ((size_t)(chain * 66 + P)) * 16384;
#pragma unroll
    for (int dkt = 0; dkt < 4; ++dkt) {
      f32x16 acc = zero16();
#pragma unroll
      for (int s8 = 0; s8 < 8; ++s8) {
        const bf16x8 kf = *(const bf16x8*)(kwT + (d * 128 + 32 * dkt + r) * 136 + 16 * s8 + 8 * hh);
        acc = mfma32(vf[s8], kf, acc);
      }
#pragma unroll
      for (int e = 0; e < 16; ++e) {
        const int dv = 32 * dvt + (e & 3) + 8 * (e >> 2) + 4 * hh;
        dst[dv * 128 + 32 * dkt + r] = f2bf(acc[e]);
      }
    }
  }
  if (tid < 256) {
    const int d = tid >> 7, dk = tid & 127;
    float s = 0.f;
    for (int j = 0; j < 128; ++j) s += bf2f(kwT[(d * 128 + dk) * 136 + j]);
    DN[(((b * 4 + head) * 2 + d) * 66 + P) * 128 + dk] = s;
  }
  __syncthreads();
}

__device__ __attribute__((always_inline)) void phase_b2(const Params& p) {
  const int gid = blockIdx.x * NTHR + threadIdx.x;
  const float* BL = (const float*)(p.ws + WS_BL);
  if (gid < 131072) {
    const int chain = gid >> 13, e2 = gid & 8191;
    const int d = chain & 1;
    unsigned* base = (unsigned*)(p.ws + WS_H) + (size_t)chain * 66 * 8192 + e2;
    float c0 = 0.f, c1 = 0.f;
    for (int i0 = 0; i0 < 66; i0 += 11) {
      unsigned v[11];
      float a[11];
#pragma unroll
      for (int j = 0; j < 11; ++j) {
        const int i = i0 + j;
        const int P = d == 0 ? i : (i < 2 ? 1 - i : 67 - i);
        v[j] = base[(size_t)P * 8192];
        a[j] = __expf(BL[chain * 66 + P]);
      }
#pragma unroll
      for (int j = 0; j < 11; ++j) {
        const int i = i0 + j;
        const int P = d == 0 ? i : (i < 2 ? 1 - i : 67 - i);
        base[(size_t)P * 8192] = pk2(c0, c1);
        c0 = a[j] * c0 + bflo(v[j]);
        c1 = a[j] * c1 + bfhi(v[j]);
      }
    }
  }
  if (gid < 2048) {
    const int chain = gid >> 7, dk = gid & 127;
    const int d = chain & 1;
    const float* DN = (const float*)(p.ws + WS_DN);
    float* NP = (float*)(p.ws + WS_NPREV);
    float run = 0.f;
    for (int i = 0; i < 66; ++i) {
      const int P = d == 0 ? i : (i < 2 ? 1 - i : 67 - i);
      NP[(chain * 66 + P) * 128 + dk] = run;
      run = __expf(BL[chain * 66 + P]) * run + DN[(chain * 66 + P) * 128 + dk];
    }
  }
}

__device__ __attribute__((always_inline)) void mlstm_b3_item(const Params& p, int l, int b, int head, int P, unsigned char* smem) {
  u16* qS = (u16*)smem;
  u16* kS = (u16*)(smem + 34816);
  u16* pS = (u16*)(smem + 69632);
  float* fb = (float*)(smem + 104448);
  float* lf = fb;
  float* li = fb + 256;
  float* bc = fb + 512;
  float* colsum = fb + 768;
  float* nS = fb + 1280;
  float* nq = fb + 1536;
  float* cfs = fb + 1792;
  float* hsq = fb + 2048;
  const int tid = opaque_tid(), lane = tid & 63, wave = tid >> 6;
  const int r = lane & 31, hh = lane >> 5;
  const int grow0 = chunk_grow0(b, P), key0 = chunk_key0(P);
  const int chainF = (b * 4 + head) * 2, chainB = chainF + 1;
  mlstm_gates(p, l, head, grow0, lf, li);
  __syncthreads();
  if (tid < 256) {
    const int d = tid >> 7, s = tid & 127;
    float bs = 0.f;
    for (int j = 0; j < 128; ++j) {
      const float v = lf[d * 128 + j];
      if (d == 0 ? (j <= s) : (j >= s)) bs += v;
    }
    bc[d * 128 + s] = bs;
    nS[d * 128 + s] = ((const float*)(p.ws + WS_NPREV))[((chainF + d) * 66 + P) * 128 + s];
  }
  {
    const u16* QB = piece(p, P_QB);
    const u16* KB = piece(p, P_KB);
#pragma unroll 1
    for (int i = 0; i < 4; ++i) {
      const int u = tid + NTHR * i;
      const int s = u >> 4, dg = u & 15;
      const bool hasprev = !((P == 0 || P == 2) && s == 0);
      const bool hasnext = !((P == 1 || P == 65) && s == 127);
      float o[8];
      conv8(p, l, QB, grow0 + s, head * 128 + dg * 8, head * 128 + dg * 8, hasprev, hasnext, 1.f, o);
      v4u pk;
      pk[0] = pk2(o[0], o[1]); pk[1] = pk2(o[2], o[3]); pk[2] = pk2(o[4], o[5]); pk[3] = pk2(o[6], o[7]);
      *(v4u*)(qS + s * 136 + dg * 8) = pk;
      conv8(p, l, KB, grow0 + s, head * 128 + dg * 8, 512 + head * 128 + dg * 8, hasprev, hasnext, 0.08838834764831845f, o);
      pk[0] = pk2(o[0], o[1]); pk[1] = pk2(o[2], o[3]); pk[2] = pk2(o[4], o[5]); pk[3] = pk2(o[6], o[7]);
      *(v4u*)(kS + s * 136 + dg * 8) = pk;
    }
  }
  __syncthreads();
  if (tid < 256) {
    const int d = tid >> 7, t = tid & 127;
    float s = 0.f;
    for (int k = 0; k < 128; ++k) s += nS[d * 128 + k] * bf2f(qS[t * 136 + k]);
    nq[d * 128 + t] = s;
  }
  bf16x8 vfh[8];
  {
    const u16* VT0 = piece(p, P_VTB);
#pragma unroll
    for (int s8 = 0; s8 < 8; ++s8)
      vfh[s8] = *(const bf16x8*)(VT0 + ((size_t)(b * 512 + head * 128 + 32 * (wave & 3) + r)) * NKEY + key0 + 16 * s8 + 8 * hh);
  }
  f32x16 Pf[2], Pb[2];
  {
    const int tt = wave & 3, sh = wave >> 2;
    const int t = 32 * tt + r;
    bf16x8 qf[8];
#pragma unroll
    for (int ks = 0; ks < 8; ++ks) qf[ks] = *(const bf16x8*)(qS + t * 136 + 16 * ks + 8 * hh);
    const float bFt = bc[t], bBt = bc[128 + t];
    float csf = 0.f, csb = 0.f;
#pragma unroll
    for (int st2 = 0; st2 < 2; ++st2) {
      const int stile = 2 * sh + st2;
      f32x16 S = zero16();
#pragma unroll
      for (int ks = 0; ks < 8; ++ks) {
        const bf16x8 kf = *(const bf16x8*)(kS + (32 * stile + r) * 136 + 16 * ks + 8 * hh);
        S = mfma32(kf, qf[ks], S);
      }
#pragma unroll
      for (int e = 0; e < 16; ++e) {
        const int s = 32 * stile + (e & 3) + 8 * (e >> 2) + 4 * hh;
        const float raw = S[e];
        const float pf_ = (s <= t) ? raw * __expf(bFt - bc[s] + li[s]) : 0.f;
        const float pb_ = (s >= t) ? raw * __expf(bBt - bc[128 + s] + li[128 + s]) : 0.f;
        Pf[st2][e] = pf_;
        Pb[st2][e] = pb_;
        csf += pf_;
        csb += pb_;
      }
    }
    csf += __shfl_xor(csf, 32, 64);
    csb += __shfl_xor(csb, 32, 64);
    if (hh == 0) {
      colsum[(0 * 2 + sh) * 128 + t] = csf;
      colsum[(1 * 2 + sh) * 128 + t] = csb;
    }
  }
  bf16x8 cFh[8], cBh[8];
  {
    const u16* CST0 = (const u16*)(p.ws + WS_H);
    const u16* cF0 = CST0 + ((size_t)(chainF * 66 + P)) * 16384 + (32 * (wave & 3) + r) * 128 + 8 * hh;
    const u16* cB0 = CST0 + ((size_t)(chainB * 66 + P)) * 16384 + (32 * (wave & 3) + r) * 128 + 8 * hh;
#pragma unroll
    for (int ks = 0; ks < 8; ++ks) { cFh[ks] = *(const bf16x8*)(cF0 + 16 * ks); cBh[ks] = *(const bf16x8*)(cB0 + 16 * ks); }
  }
  __syncthreads();
  {
    const int tt = wave & 3, sh = wave >> 2;
    const int t = 32 * tt + r;
    const float eF = __expf(bc[t]), eB = __expf(bc[128 + t]);
    const float denF = eF * nq[t] + colsum[0 * 128 + t] + colsum[1 * 128 + t];
    const float denB = eB * nq[128 + t] + colsum[2 * 128 + t] + colsum[3 * 128 + t];
    const float invF = 1.f / fmaxf(fabsf(denF), 1.f);
    const float invB = 1.f / fmaxf(fabsf(denB), 1.f);
    if (sh == 0 && hh == 0) {
      cfs[t] = eF * invF;
      cfs[128 + t] = eB * invB;
    }
#pragma unroll
    for (int st2 = 0; st2 < 2; ++st2) {
      const int stile = 2 * sh + st2;
#pragma unroll
      for (int g = 0; g < 4; ++g) {
        v2u pk;
        pk[0] = pk2(Pf[st2][4 * g] * invF + Pb[st2][4 * g] * invB, Pf[st2][4 * g + 1] * invF + Pb[st2][4 * g + 1] * invB);
        pk[1] = pk2(Pf[st2][4 * g + 2] * invF + Pb[st2][4 * g + 2] * invB, Pf[st2][4 * g + 3] * invF + Pb[st2][4 * g + 3] * invB);
        const int pos = 32 * stile + 16 * (g >> 1) + 4 * (hh * 2 + (g & 1));
        *(v2u*)(pS + t * 136 + pos) = pk;
      }
    }
  }
  __syncthreads();
  const int dvt = wave & 3, tp = wave >> 2;
  f32x16 hacc[2];
  {
    const u16* VT = piece(p, P_VTB);
    const u16* CST = (const u16*)(p.ws + WS_H);
    f32x16 aP[2], aF[2], aB[2];
#pragma unroll
    for (int t2 = 0; t2 < 2; ++t2) { aP[t2] = zero16(); aF[t2] = zero16(); aB[t2] = zero16(); }
#pragma unroll
    for (int s8 = 0; s8 < 8; ++s8) {
      const bf16x8 vf = vfh[s8];
#pragma unroll
      for (int t2 = 0; t2 < 2; ++t2) {
        const bf16x8 pf_ = *(const bf16x8*)(pS + (32 * (2 * tp + t2) + r) * 136 + 16 * s8 + 8 * hh);
        aP[t2] = mfma32(vf, pf_, aP[t2]);
      }
    }
    const u16* cF = CST + ((size_t)(chainF * 66 + P)) * 16384 + (32 * dvt + r) * 128 + 8 * hh;
    const u16* cB = CST + ((size_t)(chainB * 66 + P)) * 16384 + (32 * dvt + r) * 128 + 8 * hh;
#pragma unroll
    for (int ks = 0; ks < 8; ++ks) {
      const bf16x8 f1 = cFh[ks];
      const bf16x8 f2 = cBh[ks];
#pragma unroll
      for (int t2 = 0; t2 < 2; ++t2) {
        const bf16x8 qf = *(const bf16x8*)(qS + (32 * (2 * tp + t2) + r) * 136 + 16 * ks + 8 * hh);
        aF[t2] = mfma32(f1, qf, aF[t2]);
        aB[t2] = mfma32(f2, qf, aB[t2]);
      }
    }
#pragma unroll
    for (int t2 = 0; t2 < 2; ++t2) {
      const int t = 32 * (2 * tp + t2) + r;
      const float cf = cfs[t], cb = cfs[128 + t];
      float ss = 0.f;
#pragma unroll
      for (int e = 0; e < 16; ++e) {
        const float hv = aP[t2][e] + cf * aF[t2][e] + cb * aB[t2][e];
        hacc[t2][e] = hv;
        ss += hv * hv;
      }
      ss += __shfl_xor(ss, 32, 64);
      if (hh == 0) hsq[dvt * 128 + t] = ss;
    }
  }
  __syncthreads();
  {
    u16* OB = piece(p, P_OB);
    const u16* ZB = piece(p, P_ZB);
    const float* mg = p.ml_g + l * 128;
#pragma unroll
    for (int t2 = 0; t2 < 2; ++t2) {
      const int t = 32 * (2 * tp + t2) + r;
      const float rinv = rsqrtf((hsq[t] + hsq[128 + t] + hsq[256 + t] + hsq[384 + t]) * (1.f / 128.f) + 1e-6f);
#pragma unroll
      for (int g = 0; g < 4; ++g) {
        const int dv0 = 32 * dvt + 8 * g + 4 * hh;
        const size_t off = (size_t)(grow0 + t) * 512 + head * 128 + dv0;
        const v2u ov = *(const v2u*)(OB + off);
        const v2u zv = *(const v2u*)(ZB + off);
        const float y0 = sigmoid_f(bflo(ov[0])) * hacc[t2][4 * g] * rinv * mg[dv0] * silu_f(bflo(zv[0]));
        const float y1 = sigmoid_f(bfhi(ov[0])) * hacc[t2][4 * g + 1] * rinv * mg[dv0 + 1] * silu_f(bfhi(zv[0]));
        const float y2 = sigmoid_f(bflo(ov[1])) * hacc[t2][4 * g + 2] * rinv * mg[dv0 + 2] * silu_f(bflo(zv[1]));
        const float y3 = sigmoid_f(bfhi(ov[1])) * hacc[t2][4 * g + 3] * rinv * mg[dv0 + 3] * silu_f(bfhi(zv[1]));
        v2u o;
        o[0] = pk2(y0, y1);
        o[1] = pk2(y2, y3);
        *(v2u*)(OB + off) = o;
      }
    }
  }
  __syncthreads();
}

__device__ __attribute__((always_inline)) void phase_s3(const Params& p, int l, unsigned char* smem) {
  const int nActx = (l == 0) ? 16 : 0, nCctx = (l == 0) ? 8 : 0;
  if ((gridDim.x & 7) == 0) {
    const int xcd = blockIdx.x & 7, slot = blockIdx.x >> 3, nb = gridDim.x >> 3;
#pragma unroll 1
    for (int q = slot; q < 64 + (nActx >> 3); q += nb) {
      const int b = xcd >> 2, h = xcd & 3;
      if (q < 64) attn_item(p, l, b, h, b * 8192 + q * 128, 0, 132, smem);
      else attn_item(p, l, b, h, 16384 + b * 256 + (q - 64) * 128, 128, 132, smem);
    }
  } else {
#pragma unroll 1
    for (int j = blockIdx.x; j < 512 + nActx; j += gridDim.x) {
      if (j < 512) {
        const int b = j >> 8, h = (j >> 6) & 3, qb = j & 63;
        attn_item(p, l, b, h, b * 8192 + qb * 128, 0, 132, smem);
      } else {
        const int jj = j - 512;
        const int b = jj >> 3, h = (jj >> 1) & 3, qh = jj & 1;
        attn_item(p, l, b, h, 16384 + b * 256 + qh * 128, 128, 132, smem);
      }
    }
  }
#pragma unroll 1
  for (int j = (blockIdx.x + gridDim.x - 32) % gridDim.x; j < 528; j += gridDim.x) {
    const int b = j / 264, rem = j % 264, head = rem / 66, P = rem % 66;
    mlstm_b1_item(p, l, b, head, P, smem);
  }
#pragma unroll 1
  for (int j = (blockIdx.x + gridDim.x - 64) % gridDim.x; j < 256 + nCctx; j += gridDim.x) {
    if (j < 256) natten_item(p, l, j >> 7, j & 127, (j >> 7) * 8192 + (j & 127) * 64, 0, smem);
    else natten_item(p, l, (j - 256) >> 2, 0, 16384 + ((j - 256) >> 2) * 256 + ((j - 256) & 3) * 64, 8, smem);
  }
}

__device__ __attribute__((always_inline)) void h2_rows(const Params& p, int l) {
  const int tid = opaque_tid(), lane = tid & 63, wave = tid >> 6;
  u16* H2 = slotp(p, 3);
  const float* rstd = (const float*)(p.ws + WS_RSTD);
#pragma unroll 2
  for (int row = blockIdx.x * 8 + wave; row < R_TOT; row += gridDim.x * 8) {
    const float* xr = xrow(p, l, row);
    const int w = which_of(row);
    const float* gs = (const float*)(p.ws + WS_GS) + w * 1024;
    const float* sh = (const float*)(p.ws + WS_SH) + w * 1024;
    const float rs = rstd[row];
#pragma unroll
    for (int j = 0; j < 4; ++j) {
      const int k = lane * 4 + 256 * j;
      const v4f v = *(const v4f*)(xr + k);
      const v4f g = *(const v4f*)(gs + k);
      const v4f sf = *(const v4f*)(sh + k);
      v2u pk;
      pk[0] = pk2(v[0] * rs * g[0] + sf[0], v[1] * rs * g[1] + sf[1]);
      pk[1] = pk2(v[2] * rs * g[2] + sf[2], v[3] * rs * g[3] + sf[3]);
      *(v2u*)(H2 + (size_t)row * 1024 + k) = pk;
    }
  }
}

__device__ __attribute__((always_inline)) void phase_s5(const Params& p, int l, unsigned char* smem) {
  h2_rows(p, l);
  const int P0 = (l == 0) ? 0 : 2;
  const int nP = 66 - P0;
  for (int it = (blockIdx.x + gridDim.x - 96) % gridDim.x; it < 8 * nP; it += gridDim.x) {
    const int bh = it / nP, P = P0 + it % nP;
    mlstm_b3_item(p, l, bh >> 2, bh & 3, P, smem);
  }
}

__device__ __forceinline__ void s6a_tile(const Params& p, int rt, int ct, unsigned char* smem) {
  const int tid = opaque_tid(), lane = tid & 63, wave = tid >> 6;
  const int wm = wave >> 1, wn = wave & 1, r = lane & 31, hh = lane >> 5;
  const u16* H2 = slotp(p, 3);
  const u16* WTI = (const u16*)(p.ws + WS_WT_IN);
  u16* G = slotp(p, 5);
  const int row0 = rt * 256;
  f32x16 acc[2][2];
  acc[0][0] = zero16(); acc[0][1] = zero16(); acc[1][0] = zero16(); acc[1][1] = zero16();
  gemm_core<0, 2>(acc, H2 + (size_t)row0 * 1024, 1024, nullptr, nullptr, nullptr, nullptr,
                  WTI + (size_t)(6656 + ct * 128) * 1024, 1024, smem);
  u16* Gn = G + (size_t)(ct >> 3) * R_TOT * 1024;
  const int d0 = (ct & 7) * 128 + 64 * wn + r;
#pragma unroll
  for (int i = 0; i < 2; ++i)
#pragma unroll
    for (int e = 0; e < 16; ++e) {
      const int row = row0 + 64 * wm + 32 * i + (e & 3) + 8 * (e >> 2) + 4 * hh;
      gu16* rp = (gu16*)Gn + (size_t)row * 1024 + d0;
      asm volatile("" : "+v"(rp));
      rp[0] = f2bf(sigmoid_f(acc[i][0][e]));
      rp[32] = f2bf(sigmoid_f(acc[i][1][e]));
    }
}

__device__ __forceinline__ void s6a_tile256(const Params& p, int rt, int ct, unsigned char* smem) {
  const int tid = opaque_tid(), lane = tid & 63, wave = tid >> 6;
  const int wm = wave >> 1, wn = wave & 1, r = lane & 31, hh = lane >> 5;
  const u16* H2 = slotp(p, 3);
  const u16* WTI = (const u16*)(p.ws + WS_WT_IN);
  u16* G = slotp(p, 5);
  const int row0 = rt * 256;
  f32x16 acc[2][4];
#pragma unroll
  for (int i = 0; i < 2; ++i)
#pragma unroll
    for (int j = 0; j < 4; ++j) acc[i][j] = zero16();
  gemm_core256<1>(acc, H2 + (size_t)row0 * 1024, 1024, WTI + (size_t)(6656 + ct * 256) * 1024, 1024, smem);
  u16* Gn = G + (size_t)(ct >> 2) * R_TOT * 1024;
  const int d0 = (ct & 3) * 256 + 128 * wn + r;
#pragma unroll
  for (int i = 0; i < 2; ++i)
#pragma unroll
    for (int e = 0; e < 16; ++e) {
      const int row = row0 + 64 * wm + 32 * i + (e & 3) + 8 * (e >> 2) + 4 * hh;
      gu16* rp = (gu16*)Gn + (size_t)row * 1024 + d0;
      asm volatile("" : "+v"(rp));
#pragma unroll
      for (int j = 0; j < 4; ++j) {
        float v = acc[i][j][e];
        asm volatile("" : "+v"(v));
        rp[32 * j] = f2bf(sigmoid_f(v));
      }
    }
}

__device__ __attribute__((always_inline)) void phase_s6a(const Params& p, int l, unsigned char* smem) {
  {
    const pg8::Gemm g{slotp(p, 3), (const u16*)(p.ws + WS_WT_IN) + (size_t)6656 * 1024, 16384, 3072, 1024};
    const SegOrder S = make_order(768, 1);
    const EpiS6a E{slotp(p, 5)};
    pg8::gemm_phase<EpiS6a, SegOrder, false>((PG8_LAS unsigned char*)smem, g, S, E, nullptr);
  }
  if (l == 0) {
#pragma unroll 1
    for (int it = blockIdx.x; it < 48; it += gridDim.x) s6a_tile(p, 64 + (it & 1), it >> 1, smem);
  }
}

template <int MI>
__device__ __forceinline__ void s6b_tile(const Params& p, int row0, int ct, unsigned char* smem) {
  const int tid = opaque_tid(), lane = tid & 63, wave = tid >> 6;
  const int wm = wave >> 1, wn = wave & 1, r = lane & 31, hh = lane >> 5;
  const u16* WTB = (const u16*)(p.ws + WS_WT_BR);
  const u16* G = slotp(p, 5);
  u16* M = (u16*)(p.ws + WS_H);
  f32x16 tot[MI][2];
#pragma unroll
  for (int i = 0; i < MI; ++i) { tot[i][0] = zero16(); tot[i][1] = zero16(); }
#pragma unroll 1
  for (int n = 0; n < 3; ++n) {
    f32x16 ap[MI][2];
#pragma unroll
    for (int i = 0; i < MI; ++i) { ap[i][0] = zero16(); ap[i][1] = zero16(); }
    if constexpr (MI == 2)
      gemm_core_lean2(ap, slotp(p, n) + (size_t)row0 * 512, 512, WTB + (size_t)(n * 1024 + ct * 128) * 512, 512, smem);
    else
      gemm_core<0, MI>(ap, slotp(p, n) + (size_t)row0 * 512, 512, nullptr, nullptr, nullptr, nullptr,
                       WTB + (size_t)(n * 1024 + ct * 128) * 512, 512, smem);
    const u16* Gn = G + (size_t)n * R_TOT * 1024;
#pragma unroll
    for (int i = 0; i < MI; ++i)
#pragma unroll
      for (int e = 0; e < 16; ++e) {
        const int row = row0 + 32 * MI * wm + 32 * i + (e & 3) + 8 * (e >> 2) + 4 * hh;
        const gu16* rp = (const gu16*)Gn + (size_t)row * 1024 + ct * 128 + 64 * wn + r;
        asm volatile("" : "+v"(rp));
        tot[i][0][e] += bf2f(rp[0]) * ap[i][0][e];
        tot[i][1][e] += bf2f(rp[32]) * ap[i][1][e];
      }
  }
#pragma unroll
  for (int i = 0; i < MI; ++i)
#pragma unroll
    for (int e = 0; e < 16; ++e) {
      const int row = row0 + 32 * MI * wm + 32 * i + (e & 3) + 8 * (e >> 2) + 4 * hh;
      gu16* rp = (gu16*)M + (size_t)row * 1024 + ct * 128 + 64 * wn + r;
      asm volatile("" : "+v"(rp));
      rp[0] = f2bf(tot[i][0][e]);
      rp[32] = f2bf(tot[i][1][e]);
    }
}

__device__ __attribute__((always_inline)) void phase_s6b(const Params& p, int l, unsigned char* smem) {
  {
    const bool xs = (gridDim.x & 7) == 0;
    const int nb = xs ? (gridDim.x >> 3) : gridDim.x;
    const int xcd = xs ? (blockIdx.x & 7) : 0, slot = xs ? (blockIdx.x >> 3) : blockIdx.x;
    const int seg0 = xs ? 64 * xcd : 0, seg1 = xs ? 64 * (xcd + 1) : 512;
#pragma unroll 1
    for (int L = seg0 + slot; L < seg1; L += nb) {
      const int g = L >> 6, rem = L & 63, ct = rem >> 3, rt = 8 * g + (rem & 7);
      s6b_tile<2>(p, rt * 256, ct, smem);
    }
  }
  if (l == 0) {
#pragma unroll 1
    for (int it = blockIdx.x; it < 32; it += gridDim.x) s6b_tile<1>(p, 16384 + (it & 3) * 128, it >> 2, smem);
  }
}

template <int MI>
__device__ __forceinline__ void s7_tile(const Params& p, int l, int row0, int ct, unsigned char* smem) {
  const int tid = opaque_tid(), lane = tid & 63, wave = tid >> 6;
  const int wm = wave >> 1, wn = wave & 1, r = lane & 31, hh = lane >> 5;
  const u16* WTO = (const u16*)(p.ws + WS_WT_OUT);
  const u16* M = (const u16*)(p.ws + WS_H);
  const float* mod = (const float*)(p.ws + WS_MOD) + (size_t)l * 3 * 3072;
  const int w = which_of(row0);
  f32x16 acc[MI][2];
#pragma unroll
  for (int i = 0; i < MI; ++i) { acc[i][0] = zero16(); acc[i][1] = zero16(); }
  gemm_core<0, MI>(acc, M + (size_t)row0 * 1024, 1024, nullptr, nullptr, nullptr, nullptr, WTO + (size_t)(ct * 128) * 1024, 1024, smem);
  const float* xs_ = xrow(p, l, row0);
  float* xd = (row0 < 16384) ? (p.out + (size_t)row0 * 1024) : ((float*)(p.ws + WS_XC) + (size_t)(row0 - 16384) * 1024);
  const int col0 = ct * 128 + 64 * wn + r;
  const float g0 = mod[w * 3072 + 2048 + col0], g1 = mod[w * 3072 + 2048 + col0 + 32];
#pragma unroll
  for (int i = 0; i < MI; ++i)
#pragma unroll
    for (int e = 0; e < 16; ++e) {
      const size_t off = (size_t)(32 * MI * wm + 32 * i + (e & 3) + 8 * (e >> 2) + 4 * hh) * 1024 + col0;
      const gfloat* sp = (const gfloat*)xs_ + off;
      gfloat* dp = (gfloat*)xd + off;
      asm volatile("" : "+v"(sp), "+v"(dp));
      dp[0] = sp[0] + g0 * acc[i][0][e];
      dp[32] = sp[32] + g1 * acc[i][1][e];
    }
}

__device__ __attribute__((always_inline)) void phase_s7(const Params& p, int l, unsigned char* smem) {
  {
    const pg8::Gemm g{(const u16*)(p.ws + WS_H), (const u16*)(p.ws + WS_WT_OUT), 16384, 1024, 1024};
    const SegOrder S = make_order(256, 2);
    const EpiS7 E{(l == 0) ? p.x : (const float*)p.out, p.out, nullptr, (const float*)(p.ws + WS_MOD) + (size_t)l * 3 * 3072};
    pg8::gemm_phase<EpiS7, SegOrder, false>((PG8_LAS unsigned char*)smem, g, S, E, nullptr);
  }
  if (l == 0) {
#pragma unroll 1
    for (int it = blockIdx.x; it < 32; it += gridDim.x) s7_tile<1>(p, l, 16384 + (it & 3) * 128, it >> 2, smem);
  }
}

__device__ __attribute__((always_inline)) void phase_final(const Params& p) {
  const int tid = threadIdx.x, lane = tid & 63, wave = tid >> 6;
#pragma unroll 2
  for (int row = blockIdx.x * 8 + wave; row < 16384; row += gridDim.x * 8) {
    float* xr = p.out + (size_t)row * 1024;
    v4f v[4];
    float ss = 0.f;
#pragma unroll
    for (int j = 0; j < 4; ++j) {
      v[j] = *(const v4f*)(xr + lane * 4 + 256 * j);
      ss += v[j][0] * v[j][0] + v[j][1] * v[j][1] + v[j][2] * v[j][2] + v[j][3] * v[j][3];
    }
    ss = wave_sum(ss);
    const float rs = rsqrtf(ss * (1.f / 1024.f) + 1e-6f);
#pragma unroll
    for (int j = 0; j < 4; ++j) {
      const v4f g = *(const v4f*)(p.final_g + lane * 4 + 256 * j);
      v4f o;
#pragma unroll
      for (int e = 0; e < 4; ++e) o[e] = v[j][e] * rs * g[e];
      *(v4f*)(xr + lane * 4 + 256 * j) = o;
    }
  }
}

#define XB_TMO      128
#define XB_XCNT(j)  (256  + 64 * (j))
#define XB_XSUB(j)  (1280 + 64 * (j))
#define XB_XGEN(j)  (2304 + 64 * (j))
#define XB_TOP      3328
#define XB_TOPGEN   3392
#define XCD_BAR_WORDS 3456
#define XB_SPIN_CAP (1u << 18)
#define LAS __attribute__((address_space(3)))

__device__ __forceinline__ unsigned xb_ld(unsigned* p)              { return __hip_atomic_load(p, __ATOMIC_RELAXED, __HIP_MEMORY_SCOPE_AGENT); }
__device__ __forceinline__ unsigned xb_add(unsigned* p, unsigned v) { return __hip_atomic_fetch_add(p, v, __ATOMIC_RELAXED, __HIP_MEMORY_SCOPE_AGENT); }
__device__ __forceinline__ unsigned xb_xcc_id() { return (unsigned)__builtin_amdgcn_s_getreg((3 << 11) | 20) & 0xFu; }
#define XB_SPIN(cond, bar) do { unsigned _sp = 0; while (cond) { __builtin_amdgcn_s_sleep(1); \
    if ((++_sp & 255u) == 0u) { if (xb_ld(&(bar)[XB_TMO])) break; if (_sp > XB_SPIN_CAP) { atomicAdd(&(bar)[XB_TMO], 1u); break; } } } } while (0)

struct XcdBarrier {
    unsigned* bar; unsigned x;
    volatile LAS unsigned* st;
};

__device__ __forceinline__ XcdBarrier xcd_barrier_post(unsigned* bar, volatile LAS unsigned* st) {
    XcdBarrier b; b.bar = bar; b.x = xb_xcc_id(); b.st = st;
    if (threadIdx.x == 0) (void)xb_add(&bar[XB_XCNT(b.x)], 1u);
    return b;
}
__device__ __forceinline__ void xcd_barrier_complete(unsigned* bar, unsigned x, unsigned& nloc, unsigned& nx) {
    const unsigned G = gridDim.x * gridDim.y * gridDim.z;
    unsigned sum, cnt, mine, sp = 0u;
    for (;;) {
        sum = 0u; cnt = 0u; mine = 0u;
#pragma unroll
        for (unsigned j = 0; j < 16; ++j) { const unsigned c = xb_ld(&bar[XB_XCNT(j)]); sum += c; cnt += (c > 0u) ? 1u : 0u; mine = (j == x) ? c : mine; }
        if (sum == G) break;
        __builtin_amdgcn_s_sleep(1);
        if ((++sp & 255u) == 0u) { if (xb_ld(&bar[XB_TMO])) break; if (sp > XB_SPIN_CAP) { atomicAdd(&bar[XB_TMO], 1u); break; } }
    }
    nloc = mine > 0u ? mine : 1u; nx = cnt > 0u ? cnt : 1u;
}

__device__ __forceinline__ void xcd_barrier(const XcdBarrier& b) {
    asm volatile("s_waitcnt vmcnt(0)" ::: "memory");
    __syncthreads();
    if (threadIdx.x == 0) {
        unsigned* bar = b.bar;
        __builtin_amdgcn_s_waitcnt(0);
        unsigned nloc = b.st[0], nx = b.st[1];
        if (nloc == 0u) { xcd_barrier_complete(bar, b.x, nloc, nx); b.st[0] = nloc; b.st[1] = nx; }
        const unsigned old = xb_add(&bar[XB_XSUB(b.x)], 1u);
        const unsigned gen = old / nloc;
        if (old + 1u == (gen + 1u) * nloc) {
            __builtin_amdgcn_fence(__ATOMIC_RELEASE, "agent");
            asm volatile("s_waitcnt vmcnt(0)" ::: "memory");
            const unsigned og = xb_add(&bar[XB_TOP], 1u);
            const unsigned tg = og / nx;
            if (og + 1u == (tg + 1u) * nx) xb_add(&bar[XB_TOPGEN], 1u);
            else XB_SPIN(xb_ld(&bar[XB_TOPGEN]) == tg, bar);
            __builtin_amdgcn_fence(__ATOMIC_ACQUIRE, "agent");
            xb_add(&bar[XB_XGEN(b.x)], 1u);
            asm volatile("s_waitcnt vmcnt(0)" ::: "memory");
        } else {
            XB_SPIN(xb_ld(&bar[XB_XGEN(b.x)]) == gen, bar);
            __builtin_amdgcn_fence(__ATOMIC_ACQUIRE, "agent");
            asm volatile("s_waitcnt vmcnt(0)" ::: "memory");
        }
    }
    __syncthreads();
}


__global__ void __launch_bounds__(NTHR) fwd_megakernel(Params p) {
  extern __shared__ __attribute__((aligned(16))) unsigned char smem[];
  cg::grid_group grid = cg::this_grid();
  __shared__ uint4 xb_words;
  if (threadIdx.x == 0) xb_words = make_uint4(0u, 0u, 0u, 0u);
  __syncthreads();
  XcdBarrier xbar = xcd_barrier_post((unsigned*)(p.ws + WS_BAR), (volatile LAS unsigned*)&xb_words);
#define PH(k, call)                                  \
  if (p.ph_lo <= (k) && (k) < p.ph_hi) {             \
    call;                                            \
    if ((k) + 1 < p.ph_hi) { if ((k) == 0) grid.sync(); else xcd_barrier(xbar); }  \
  }
  PH(0, phase_s0(p))
  PH(1, phase_s1(p, 0, smem))
  PH(2, phase_s2(p, 0, smem))
  PH(3, phase_s3(p, 0, smem))
  PH(4, phase_b2(p))
  PH(5, phase_s5(p, 0, smem))
  PH(6, phase_s6a(p, 0, smem))
  PH(7, phase_s6b(p, 0, smem))
  PH(8, phase_s7(p, 0, smem))
  PH(9, phase_s1(p, 1, smem))
  PH(10, phase_s2(p, 1, smem))
  PH(11, phase_s3(p, 1, smem))
  PH(12, phase_b2(p))
  PH(13, phase_s5(p, 1, smem))
  PH(14, phase_s6a(p, 1, smem))
  PH(15, phase_s6b(p, 1, smem))
  PH(16, phase_s7(p, 1, smem))
  PH(17, phase_final(p))
#undef PH
}

extern "C" void kernel_launch(void* const* d_in, const int* in_sizes, int n_in, void* d_out, int out_size,
                              void* d_ws, size_t ws_size, hipStream_t stream) {
  static int grid_blocks = 0;
  if (grid_blocks == 0) {
    if (n_in != 19 || ws_size < WS_END) {
      fprintf(stderr, "kernel_launch: unexpected n_in %d or ws_size %zu (< %llu)\n", n_in, ws_size, (unsigned long long)WS_END);
      grid_blocks = -1;
      return;
    }
    int dev = 0, cus = 0, per_cu = 0;
    hipGetDevice(&dev);
    hipDeviceGetAttribute(&cus, hipDeviceAttributeMultiprocessorCount, dev);
    if (hipFuncSetAttribute((const void*)fwd_megakernel, hipFuncAttributeMaxDynamicSharedMemorySize, LDS_BYTES) != hipSuccess) {
      fprintf(stderr, "kernel_launch: hipFuncSetAttribute failed\n");
      grid_blocks = -1;
      return;
    }
    hipOccupancyMaxActiveBlocksPerMultiprocessor(&per_cu, (const void*)fwd_megakernel, NTHR, LDS_BYTES);
    if (per_cu < 1) { fprintf(stderr, "kernel_launch: occupancy query says %d blocks/CU\n", per_cu); per_cu = 1; }
    (void)hipGetLastError();
    grid_blocks = cus;
  }
  if (grid_blocks < 0) return;
  hipMemsetAsync((char*)d_ws + WS_BAR, 0, 13824 + 73728, stream);
  Params p{};
  p.x = (const float*)d_in[0]; p.c = (const float*)d_in[1]; p.ctx = (const float*)d_in[2]; p.c_ctx = (const float*)d_in[3];
  p.w_mod = (const float*)d_in[4]; p.b_mod = (const float*)d_in[5]; p.norm_g = (const float*)d_in[6]; p.w_in = (const float*)d_in[7];
  p.lam_q = (const float*)d_in[8]; p.lam_k = (const float*)d_in[9]; p.da_g = (const float*)d_in[10];
  p.conv_w = (const float*)d_in[11]; p.conv_b = (const float*)d_in[12]; p.gate_b = (const float*)d_in[13]; p.ml_g = (const float*)d_in[14];
  p.rpb = (const float*)d_in[15]; p.w_br = (const float*)d_in[16]; p.w_out = (const float*)d_in[17]; p.final_g = (const float*)d_in[18];
  p.out = (float*)d_out; p.ws = (unsigned char*)d_ws;
#if MULTI_LAUNCH
  for (int ph = 0; ph < NPHASE; ++ph) {
    p.ph_lo = ph; p.ph_hi = ph + 1;
    hipLaunchKernelGGL(fwd_megakernel, dim3(grid_blocks), dim3(NTHR), LDS_BYTES, stream, p);
  }
#else
  p.ph_lo = 0; p.ph_hi = NPHASE;
  void* args[] = {&p};
  hipError_t e = hipLaunchCooperativeKernel((void*)fwd_megakernel, dim3(grid_blocks), dim3(NTHR), args, LDS_BYTES, stream);
  if (e != hipSuccess) fprintf(stderr, "cooperative launch failed: %s (grid %d)\n", hipGetErrorString(e), grid_blocks);
#endif
}
```
